# Optimizing an MI355X kernel written in HIP

```python
import math
import jax, jax.numpy as jnp
from jax import lax
import numpy as np

D_MODEL = 1024
BATCH = 8
SEQ = 4096
DEPTH = 2

N_EVEN = (DEPTH + 1) // 2
N_ODD = DEPTH // 2
N_NORMS = 7

HALF_MIX = D_MODEL // 2
N_GROUPS = 4
GROUP_CH = HALF_MIX // N_GROUPS
CHUNK = 128
POOL_WINDOWS = (2, 4, 8, 16)
EVEN_IN = 3 * HALF_MIX

ATT_HEADS = 8
ATT_HEAD_DIM = 128
ATT_WIDTH = ATT_HEADS * ATT_HEAD_DIM
IDX_HEADS = 8
IDX_DIM = 64
DSA_TOPK = 256
QBLK = 128
ODD_IN = ATT_WIDTH + 2 * ATT_HEAD_DIM + IDX_HEADS * IDX_DIM + IDX_DIM + IDX_HEADS

N_MEM = 256
X_HEADS = 4
X_HEAD_DIM = D_MODEL // X_HEADS

D_FF = 4 * D_MODEL

ROPE_THETA = 10000.0
EPS = 1e-6

kernel_name = 'hybrid_gmlp_pool_dsa_memxattn_trunk'


def rms_norm(x, g):
    xf = x.astype(jnp.float32)
    y = xf * lax.rsqrt(jnp.mean(xf * xf, axis=-1, keepdims=True) + EPS)
    return (y * g.astype(jnp.float32)).astype(x.dtype)


def rope(x, pos):
    d = x.shape[-1]
    half = d // 2
    inv = jnp.exp(-math.log(ROPE_THETA) * (2.0 / d) * jnp.arange(half, dtype=jnp.float32))
    ang = pos.astype(jnp.float32)[..., None] * inv
    cos = jnp.cos(ang)[:, :, None, :]
    sin = jnp.sin(ang)[:, :, None, :]
    xf = x.astype(jnp.float32)
    x1, x2 = xf[..., :half], xf[..., half:]
    return jnp.concatenate([x1 * cos - x2 * sin, x2 * cos + x1 * sin], axis=-1).astype(x.dtype)


def causal_pool(xg, w):
    L = xg.shape[1]
    cs = jnp.cumsum(xg.astype(jnp.float32), axis=1)
    lagged = jnp.concatenate([jnp.zeros_like(cs[:, :w]), cs[:, :-w]], axis=1)
    count = jnp.minimum(jnp.arange(L) + 1, w).astype(jnp.float32)[None, :, None]
    return ((cs - lagged) / count - xg.astype(jnp.float32)).astype(xg.dtype)


def even_mixer(xn, w_in, sgu_g, sgu_ws, sgu_bs, pool_w, pool_scale, w_out):
    B, L, _ = xn.shape
    z = xn @ w_in
    zu, zv, zb = z[..., :HALF_MIX], z[..., HALF_MIX:2 * HALF_MIX], z[..., 2 * HALF_MIX:]
    u = jax.nn.gelu(zu)
    v = rms_norm(jax.nn.gelu(zv).reshape(B, L, N_GROUPS, GROUP_CH), sgu_g)
    nc = L // CHUNK
    v = v.reshape(B, nc, CHUNK, N_GROUPS, GROUP_CH)
    mask = jnp.tril(jnp.ones((CHUNK, CHUNK), dtype=sgu_ws.dtype))
    w_causal = sgu_ws * mask[None]
    sv = jnp.einsum('gts,bnsgc->bntgc', w_causal, v) + sgu_bs.T[None, None, :, :, None]
    a_out = u * sv.reshape(B, L, HALF_MIX)
    xb = zb.reshape(B, L, N_GROUPS, GROUP_CH)
    pooled = jnp.stack([causal_pool(xb[:, :, g], w) for g, w in enumerate(POOL_WINDOWS)], axis=2)
    b_out = (jnp.einsum('blgc,gcd->blgd', pooled, pool_w) * pool_scale).reshape(B, L, HALF_MIX)
    return jnp.concatenate([a_out, b_out], axis=-1) @ w_out


def dsa_mixer(xn, pos, w_in, w_out):
    B, L, _ = xn.shape
    z = xn @ w_in
    o1 = ATT_WIDTH
    o2 = o1 + ATT_HEAD_DIM
    o3 = o2 + ATT_HEAD_DIM
    o4 = o3 + IDX_HEADS * IDX_DIM
    o5 = o4 + IDX_DIM
    q = rope(z[..., :o1].reshape(B, L, ATT_HEADS, ATT_HEAD_DIM), pos)
    k = rope(z[..., o1:o2].reshape(B, L, 1, ATT_HEAD_DIM), pos)[:, :, 0]
    v = z[..., o2:o3]
    qi = rope(z[..., o3:o4].reshape(B, L, IDX_HEADS, IDX_DIM), pos)
    ki = rope(z[..., o4:o5].reshape(B, L, 1, IDX_DIM), pos)[:, :, 0]
    wi = z[..., o5:] * (IDX_HEADS ** -0.5)
    topk = min(DSA_TOPK, L // 4)
    nb = L // QBLK
    key_pos = jnp.arange(L)
    ki_f = ki.astype(jnp.float32)

    def blocks(a):
        return jnp.moveaxis(a.reshape((B, nb, QBLK) + a.shape[2:]), 1, 0)

    def attend(args):
        qb, qib, wib, t0 = args
        tq = t0 + jnp.arange(QBLK)
        s = jnp.einsum('bqhd,bsd->bqhs', qib.astype(jnp.float32), ki_f) * (IDX_DIM ** -0.5)
        score = jnp.einsum('bqhs,bqh->bqs', jax.nn.relu(s), wib.astype(jnp.float32))
        causal = key_pos[None, :] <= tq[:, None]
        score = jnp.where(causal[None], score, -jnp.inf)
        _, idx = lax.top_k(score, topk)
        valid = idx <= tq[None, :, None]
        ksel = jax.vmap(lambda kb, ib: kb[ib])(k, idx)
        vsel = jax.vmap(lambda vb, ib: vb[ib])(v, idx)
        logits = jnp.einsum('bqhd,bqkd->bqhk', qb.astype(jnp.float32),
                            ksel.astype(jnp.float32)) * (ATT_HEAD_DIM ** -0.5)
        logits = jnp.where(valid[:, :, None, :], logits, -jnp.inf)
        p = jax.nn.softmax(logits, axis=-1)
        return jnp.einsum('bqhk,bqkd->bqhd', p.astype(vsel.dtype), vsel)

    out = lax.map(attend, (blocks(q), blocks(qi), blocks(wi),
                           jnp.arange(nb, dtype=jnp.int32) * QBLK))
    out = jnp.moveaxis(out, 0, 1).reshape(B, L, ATT_WIDTH)
    return out @ w_out


def mem_xattn(xn, memn, wq, wkv, wo):
    B, L, _ = xn.shape
    M = memn.shape[1]
    q = (xn @ wq).reshape(B, L, X_HEADS, X_HEAD_DIM)
    kv = (memn @ wkv).reshape(B, M, 2, X_HEADS, X_HEAD_DIM)
    k, v = kv[:, :, 0], kv[:, :, 1]
    logits = jnp.einsum('bqhd,bkhd->bhqk', q.astype(jnp.float32),
                        k.astype(jnp.float32)) * (X_HEAD_DIM ** -0.5)
    p = jax.nn.softmax(logits, axis=-1)
    o = jnp.einsum('bhqk,bkhd->bqhd', p.astype(v.dtype), v).reshape(B, L, D_MODEL)
    return o @ wo


def sq_relu_mlp(xn, w1, w2):
    return jnp.square(jax.nn.relu(xn @ w1)) @ w2


def setup_inputs(seed: int = 0) -> dict:
    key = jax.random.key(seed)
    ks = jax.random.split(key, 20)
    f32 = jnp.float32

    def nrm(k, shape, fan_in):
        return jax.random.normal(k, shape, f32) * (fan_in ** -0.5)

    x = jax.random.normal(ks[0], (BATCH, SEQ, D_MODEL), f32)
    mem = jax.random.normal(ks[1], (BATCH, N_MEM, D_MODEL), f32)
    offsets = jax.random.randint(ks[2], (BATCH, 1), 0, 4096, dtype=jnp.int32)
    positions = jnp.arange(SEQ, dtype=jnp.int32)[None, :] + offsets
    norm_gains = 1.0 + 0.05 * jax.random.normal(ks[3], (DEPTH, N_NORMS, D_MODEL), f32)
    xa_wq = nrm(ks[4], (DEPTH, D_MODEL, D_MODEL), D_MODEL)
    xa_wkv = nrm(ks[5], (DEPTH, D_MODEL, 2 * D_MODEL), D_MODEL)
    xa_wo = nrm(ks[6], (DEPTH, D_MODEL, D_MODEL), D_MODEL)
    ffn_w1 = nrm(ks[7], (DEPTH, D_MODEL, D_FF), D_MODEL)
    ffn_w2 = nrm(ks[8], (DEPTH, D_FF, D_MODEL), D_FF)
    ev_w_in = nrm(ks[9], (N_EVEN, D_MODEL, EVEN_IN), D_MODEL)
    sgu_g = 1.0 + 0.05 * jax.random.normal(ks[10], (N_EVEN, N_GROUPS, GROUP_CH), f32)
    sgu_ws = nrm(ks[11], (N_EVEN, N_GROUPS, CHUNK, CHUNK), CHUNK)
    sgu_bs = 1.0 + 0.02 * jax.random.normal(ks[12], (N_EVEN, N_GROUPS, CHUNK), f32)
    pool_w = nrm(ks[13], (N_EVEN, N_GROUPS, GROUP_CH, GROUP_CH), GROUP_CH)
    pool_scale = 1.0 + 0.1 * jax.random.normal(ks[14], (N_EVEN, N_GROUPS, GROUP_CH), f32)
    ev_w_out = nrm(ks[15], (N_EVEN, D_MODEL, D_MODEL), D_MODEL)
    od_w_in = nrm(ks[16], (N_ODD, D_MODEL, ODD_IN), D_MODEL)
    od_w_out = nrm(ks[17], (N_ODD, ATT_WIDTH, D_MODEL), ATT_WIDTH)
    return {'x': x, 'mem': mem, 'positions': positions, 'norm_gains': norm_gains,
            'xa_wq': xa_wq, 'xa_wkv': xa_wkv, 'xa_wo': xa_wo,
            'ffn_w1': ffn_w1, 'ffn_w2': ffn_w2,
            'ev_w_in': ev_w_in, 'sgu_g': sgu_g, 'sgu_ws': sgu_ws, 'sgu_bs': sgu_bs,
            'pool_w': pool_w, 'pool_scale': pool_scale, 'ev_w_out': ev_w_out,
            'od_w_in': od_w_in, 'od_w_out': od_w_out}


def reference(x, mem, positions, norm_gains, xa_wq, xa_wkv, xa_wo, ffn_w1, ffn_w2,
              ev_w_in, sgu_g, sgu_ws, sgu_bs, pool_w, pool_scale, ev_w_out,
              od_w_in, od_w_out):
    h = x
    for i in range(DEPTH):
        g = norm_gains[i]
        hn = rms_norm(h, g[0])
        if i % 2 == 0:
            e = i // 2
            y = even_mixer(hn, ev_w_in[e], sgu_g[e], sgu_ws[e], sgu_bs[e],
                           pool_w[e], pool_scale[e], ev_w_out[e])
        else:
            o = i // 2
            y = dsa_mixer(hn, positions, od_w_in[o], od_w_out[o])
        h = h + rms_norm(y, g[1])
        memn = rms_norm(mem, g[6])
        y = mem_xattn(rms_norm(h, g[2]), memn, xa_wq[i], xa_wkv[i], xa_wo[i])
        h = h + rms_norm(y, g[3])
        y = sq_relu_mlp(rms_norm(h, g[4]), ffn_w1[i], ffn_w2[i])
        h = h + rms_norm(y, g[5])
    return h
```

```cpp
#include <hip/hip_runtime.h>
#include <hip/hip_cooperative_groups.h>
#include <cstdio>
#include <cstdint>
namespace cg = cooperative_groups;

#ifndef ONE_LAUNCH
#define ONE_LAUNCH 0
#endif

typedef unsigned short u16;
typedef short bf16x8 __attribute__((ext_vector_type(8)));
typedef float f32x4 __attribute__((ext_vector_type(4)));

constexpr int NT = 512;
constexpr int NB = 8, SEQ = 4096, T = NB * SEQ, DM = 1024, NMEM = 256, DFF = 4096;
constexpr int EVEN_IN = 1536, ODD_IN = 1864, ZP1 = 2048;
constexpr float EPS = 1e-6f;

constexpr size_t MiB = 1u << 20;
constexpr size_t WS_ROPE = 66 * MiB;
constexpr size_t WS_MEMN = 82 * MiB;
constexpr size_t WS_KV   = 90 * MiB;
constexpr size_t WS_HN   = 122 * MiB;
constexpr size_t WS_Y    = 186 * MiB;
constexpr size_t WS_Z    = 250 * MiB;
constexpr size_t WS_MIX  = 378 * MiB;
constexpr size_t WS_Q    = 442 * MiB;
constexpr size_t WS_HID  = 250 * MiB;
constexpr size_t WS_END  = 506 * MiB;

struct Params {
    const float* x; const float* mem; const int* pos; const float* gains;
    const float* wq; const float* wkv; const float* wo; const float* w1; const float* w2;
    const float* ev_w_in; const float* sgu_g; const float* sgu_ws; const float* sgu_bs;
    const float* pool_w; const float* pool_scale; const float* ev_w_out;
    const float* od_w_in; const float* od_w_out;
    float* out; unsigned char* ws;
    int ph_lo, ph_hi;
};

__device__ __forceinline__ u16 f2bf(float f) { unsigned u = __float_as_uint(f); return (u16)((u + 0x7fffu + ((u >> 16) & 1u)) >> 16); }
__device__ __forceinline__ float bf2f(u16 h) { return __uint_as_float(((unsigned)h) << 16); }
__device__ __forceinline__ float bflo(unsigned w) { return __uint_as_float(w << 16); }
__device__ __forceinline__ float bfhi(unsigned w) { return __uint_as_float(w & 0xffff0000u); }
__device__ __forceinline__ unsigned pk2(float lo, float hi) { return (unsigned)f2bf(lo) | ((unsigned)f2bf(hi) << 16); }
__device__ __forceinline__ float wsum(float v) {
#pragma unroll
    for (int o = 32; o > 0; o >>= 1) v += __shfl_xor(v, o);
    return v;
}
__device__ __forceinline__ float wmax(float v) {
#pragma unroll
    for (int o = 32; o > 0; o >>= 1) v = fmaxf(v, __shfl_xor(v, o));
    return v;
}
__device__ __forceinline__ float gelu_tanh(float x) { return 0.5f * x * (1.f + tanhf(0.7978845608028654f * (x + 0.044715f * x * x * x))); }
#define WAVE_SYNC() asm volatile("s_waitcnt lgkmcnt(0)" ::: "memory")

__device__ void rmsnorm_rows(const float* in, const float* g, u16* out, int rows) {
    const int lane = threadIdx.x & 63, gw = (blockIdx.x * NT + threadIdx.x) >> 6, ngw = (gridDim.x * NT) >> 6;
    for (int r = gw; r < rows; r += ngw) {
        const float4* xr = (const float4*)(in + (size_t)r * DM);
        float4 v[4]; float ss = 0.f;
#pragma unroll
        for (int j = 0; j < 4; ++j) { v[j] = xr[lane + 64 * j]; ss += v[j].x * v[j].x + v[j].y * v[j].y + v[j].z * v[j].z + v[j].w * v[j].w; }
        ss = wsum(ss);
        const float rstd = rsqrtf(ss * (1.f / DM) + EPS);
#pragma unroll
        for (int j = 0; j < 4; ++j) {
            const float4 gg = ((const float4*)g)[lane + 64 * j];
            uint2 o; o.x = pk2(v[j].x * rstd * gg.x, v[j].y * rstd * gg.y); o.y = pk2(v[j].z * rstd * gg.z, v[j].w * rstd * gg.w);
            ((uint2*)(out + (size_t)r * DM))[lane + 64 * j] = o;
        }
    }
}
__device__ void postnorm_rows(const float* hin, const u16* y, const float* gpost, float* hout, const float* gnext, u16* hn) {
    const int lane = threadIdx.x & 63, gw = (blockIdx.x * NT + threadIdx.x) >> 6, ngw = (gridDim.x * NT) >> 6;
    for (int r = gw; r < T; r += ngw) {
        float yv[16], hv[16]; float ss = 0.f;
#pragma unroll
        for (int j = 0; j < 2; ++j) {
            const uint4 w = *(const uint4*)(y + (size_t)r * DM + j * 512 + lane * 8);
            yv[j * 8 + 0] = bflo(w.x); yv[j * 8 + 1] = bfhi(w.x); yv[j * 8 + 2] = bflo(w.y); yv[j * 8 + 3] = bfhi(w.y);
            yv[j * 8 + 4] = bflo(w.z); yv[j * 8 + 5] = bfhi(w.z); yv[j * 8 + 6] = bflo(w.w); yv[j * 8 + 7] = bfhi(w.w);
        }
#pragma unroll
        for (int i = 0; i < 16; ++i) ss += yv[i] * yv[i];
        ss = wsum(ss);
        const float rstd = rsqrtf(ss * (1.f / DM) + EPS);
        float s2 = 0.f;
#pragma unroll
        for (int j = 0; j < 2; ++j) {
            const size_t off = (size_t)r * DM + j * 512 + lane * 8;
            const float4 h0 = *(const float4*)(hin + off), h1 = *(const float4*)(hin + off + 4);
            const float4 g0 = *(const float4*)(gpost + j * 512 + lane * 8), g1 = *(const float4*)(gpost + j * 512 + lane * 8 + 4);
            hv[j * 8 + 0] = h0.x + yv[j * 8 + 0] * rstd * g0.x; hv[j * 8 + 1] = h0.y + yv[j * 8 + 1] * rstd * g0.y;
            hv[j * 8 + 2] = h0.z + yv[j * 8 + 2] * rstd * g0.z; hv[j * 8 + 3] = h0.w + yv[j * 8 + 3] * rstd * g0.w;
            hv[j * 8 + 4] = h1.x + yv[j * 8 + 4] * rstd * g1.x; hv[j * 8 + 5] = h1.y + yv[j * 8 + 5] * rstd * g1.y;
            hv[j * 8 + 6] = h1.z + yv[j * 8 + 6] * rstd * g1.z; hv[j * 8 + 7] = h1.w + yv[j * 8 + 7] * rstd * g1.w;
            *(float4*)(hout + off) = make_float4(hv[j * 8 + 0], hv[j * 8 + 1], hv[j * 8 + 2], hv[j * 8 + 3]);
            *(float4*)(hout + off + 4) = make_float4(hv[j * 8 + 4], hv[j * 8 + 5], hv[j * 8 + 6], hv[j * 8 + 7]);
        }
        if (gnext) {
#pragma unroll
            for (int i = 0; i < 16; ++i) s2 += hv[i] * hv[i];
            s2 = wsum(s2);
            const float r2 = rsqrtf(s2 * (1.f / DM) + EPS);
#pragma unroll
            for (int j = 0; j < 2; ++j) {
                const float4 g0 = *(const float4*)(gnext + j * 512 + lane * 8), g1 = *(const float4*)(gnext + j * 512 + lane * 8 + 4);
                uint4 o;
                o.x = pk2(hv[j * 8 + 0] * r2 * g0.x, hv[j * 8 + 1] * r2 * g0.y); o.y = pk2(hv[j * 8 + 2] * r2 * g0.z, hv[j * 8 + 3] * r2 * g0.w);
                o.z = pk2(hv[j * 8 + 4] * r2 * g1.x, hv[j * 8 + 5] * r2 * g1.y); o.w = pk2(hv[j * 8 + 6] * r2 * g1.z, hv[j * 8 + 7] * r2 * g1.w);
                *(uint4*)(hn + (size_t)r * DM + j * 512 + lane * 8) = o;
            }
        }
    }
}

constexpr int LDT = 40;
__device__ void gemm_phase(const u16* A, int lda, const float* Bw, int N, int K, int M, u16* C, int ldc, int epi, unsigned char* smem) {
    u16* As = (u16*)smem; u16* Bs = As + 128 * LDT;
    const int tid = threadIdx.x, lane = tid & 63, wid = tid >> 6, wm = wid >> 2, wn = wid & 3;
    const int tilesN = (N + 127) / 128, tilesM = M / 128, total = tilesM * tilesN;
    for (int tile = blockIdx.x; tile < total; tile += gridDim.x) {
        const int tn = tile % tilesN, tm = tile / tilesN;
        f32x4 acc[4][2];
#pragma unroll
        for (int m = 0; m < 4; ++m)
#pragma unroll
            for (int n = 0; n < 2; ++n) acc[m][n] = (f32x4){0.f, 0.f, 0.f, 0.f};
        const int arow = tid >> 2, akc = (tid & 3) * 8;
        const int bk = tid >> 4, bnc = (tid & 15) * 8, bn0 = tn * 128 + bnc;
        for (int k0 = 0; k0 < K; k0 += 32) {
            const uint4 av = *(const uint4*)(A + (size_t)(tm * 128 + arow) * lda + k0 + akc);
            float bv[8];
            const float* bp = Bw + (size_t)(k0 + bk) * N + bn0;
            if (bn0 + 8 <= N) {
                const float4 b0 = *(const float4*)bp, b1 = *(const float4*)(bp + 4);
                bv[0] = b0.x; bv[1] = b0.y; bv[2] = b0.z; bv[3] = b0.w; bv[4] = b1.x; bv[5] = b1.y; bv[6] = b1.z; bv[7] = b1.w;
            } else {
#pragma unroll
                for (int j = 0; j < 8; ++j) bv[j] = (bn0 + j < N) ? bp[j] : 0.f;
            }
            __syncthreads();
            *(uint4*)(As + arow * LDT + akc) = av;
#pragma unroll
            for (int j = 0; j < 8; ++j) Bs[(bnc + j) * LDT + bk] = f2bf(bv[j]);
            __syncthreads();
            bf16x8 af[4], bfr[2];
#pragma unroll
            for (int m = 0; m < 4; ++m) af[m] = *(const bf16x8*)(As + (wm * 64 + m * 16 + (lane & 15)) * LDT + (lane >> 4) * 8);
#pragma unroll
            for (int n = 0; n < 2; ++n) bfr[n] = *(const bf16x8*)(Bs + (wn * 32 + n * 16 + (lane & 15)) * LDT + (lane >> 4) * 8);
#pragma unroll
            for (int m = 0; m < 4; ++m)
#pragma unroll
                for (int n = 0; n < 2; ++n) acc[m][n] = __builtin_amdgcn_mfma_f32_16x16x32_bf16(bfr[n], af[m], acc[m][n], 0, 0, 0);
        }
#pragma unroll
        for (int m = 0; m < 4; ++m)
#pragma unroll
            for (int n = 0; n < 2; ++n) {
                const int row = tm * 128 + wm * 64 + m * 16 + (lane & 15), col = tn * 128 + wn * 32 + n * 16 + 4 * (lane >> 4);
                if (col < N) {
                    f32x4 v = acc[m][n];
                    if (epi == 1) {
#pragma unroll
                        for (int r = 0; r < 4; ++r) { const float t = fmaxf(v[r], 0.f); v[r] = t * t; }
                    }
                    uint2 o; o.x = pk2(v[0], v[1]); o.y = pk2(v[2], v[3]);
                    *(uint2*)(C + (size_t)row * ldc + col) = o;
                }
            }
    }
}

__device__ void mixer_a_unit(const Params& p, int unit, unsigned char* smem) {
    float* Vs = (float*)smem; float* Ws = Vs + 128 * 128;
    const u16* Z = (const u16*)(p.ws + WS_Z); u16* MIX = (u16*)(p.ws + WS_MIX);
    const int tid = threadIdx.x, lane = tid & 63, wid = tid >> 6;
    const int g = unit & 3, bn = unit >> 2;
    const size_t row0 = (size_t)bn * 128;
    __syncthreads();
    for (int s = wid; s < 128; s += 8) {
        const unsigned w = *(const unsigned*)(Z + (row0 + s) * EVEN_IN + 512 + g * 128 + lane * 2);
        const float a = gelu_tanh(bflo(w)), b = gelu_tanh(bfhi(w));
        const float ss = wsum(a * a + b * b);
        const float rstd = rsqrtf(ss * (1.f / 128.f) + EPS);
        Vs[s * 128 + lane * 2] = a * rstd * p.sgu_g[g * 128 + lane * 2];
        Vs[s * 128 + lane * 2 + 1] = b * rstd * p.sgu_g[g * 128 + lane * 2 + 1];
    }
    for (int i = tid; i < 128 * 128; i += NT) { const int t = i >> 7, s = i & 127; Ws[i] = (s <= t) ? p.sgu_ws[(size_t)g * 16384 + i] : 0.f; }
    __syncthreads();
    const int t = tid >> 2, c0 = (tid & 3) * 32;
    float acc[32];
#pragma unroll
    for (int j = 0; j < 32; ++j) acc[j] = 0.f;
    for (int s = 0; s <= t; ++s) {
        const float w = Ws[t * 128 + s];
#pragma unroll
        for (int q = 0; q < 8; ++q) {
            const float4 v = *(const float4*)(Vs + s * 128 + c0 + q * 4);
            acc[q * 4 + 0] += w * v.x; acc[q * 4 + 1] += w * v.y; acc[q * 4 + 2] += w * v.z; acc[q * 4 + 3] += w * v.w;
        }
    }
    const float bias = p.sgu_bs[g * 128 + t];
    const u16* zu = Z + (row0 + t) * EVEN_IN + g * 128 + c0;
    u16* o = MIX + (row0 + t) * DM + g * 128 + c0;
#pragma unroll
    for (int q = 0; q < 4; ++q) {
        const uint4 uw = *(const uint4*)(zu + q * 8);
        uint4 ow;
        ow.x = pk2(gelu_tanh(bflo(uw.x)) * (acc[q * 8 + 0] + bias), gelu_tanh(bfhi(uw.x)) * (acc[q * 8 + 1] + bias));
        ow.y = pk2(gelu_tanh(bflo(uw.y)) * (acc[q * 8 + 2] + bias), gelu_tanh(bfhi(uw.y)) * (acc[q * 8 + 3] + bias));
        ow.z = pk2(gelu_tanh(bflo(uw.z)) * (acc[q * 8 + 4] + bias), gelu_tanh(bfhi(uw.z)) * (acc[q * 8 + 5] + bias));
        ow.w = pk2(gelu_tanh(bflo(uw.w)) * (acc[q * 8 + 6] + bias), gelu_tanh(bfhi(uw.w)) * (acc[q * 8 + 7] + bias));
        *(uint4*)(o + q * 8) = ow;
    }
}
__device__ void mixer_b_unit(const Params& p, int unit, unsigned char* smem) {
    float* Xs = (float*)smem; float* Ps = Xs + 144 * 128;
    const u16* Z = (const u16*)(p.ws + WS_Z); u16* MIX = (u16*)(p.ws + WS_MIX);
    const int tid = threadIdx.x;
    const int g = unit & 3, bn = unit >> 2, n = bn & 31;
    const size_t row0 = (size_t)bn * 128;
    const int w = 2 << g;
    __syncthreads();
    for (int i = tid; i < 144 * 64; i += NT) {
        const int r = i >> 6, c2 = (i & 63) * 2; const int tt = n * 128 - 16 + r;
        float a = 0.f, b = 0.f;
        if (tt >= 0) { const unsigned wv = *(const unsigned*)(Z + (row0 - 16 + r) * EVEN_IN + 1024 + g * 128 + c2); a = bflo(wv); b = bfhi(wv); }
        Xs[r * 128 + c2] = a; Xs[r * 128 + c2 + 1] = b;
    }
    __syncthreads();
    for (int i = tid; i < 128 * 128; i += NT) {
        const int t = i >> 7, c = i & 127; const int tt = n * 128 + t;
        const int cnt = (tt + 1 < w) ? (tt + 1) : w;
        float s = 0.f;
        for (int k = 0; k < cnt; ++k) s += Xs[(16 + t - k) * 128 + c];
        Ps[i] = s / (float)cnt - Xs[(16 + t) * 128 + c];
    }
    __syncthreads();
    const int t = tid >> 2, d0 = (tid & 3) * 32;
    float acc[32];
#pragma unroll
    for (int j = 0; j < 32; ++j) acc[j] = 0.f;
    const float* pw = p.pool_w + (size_t)g * 16384;
    for (int c = 0; c < 128; ++c) {
        const float pv = Ps[t * 128 + c];
#pragma unroll
        for (int q = 0; q < 8; ++q) {
            const float4 v = *(const float4*)(pw + c * 128 + d0 + q * 4);
            acc[q * 4 + 0] += pv * v.x; acc[q * 4 + 1] += pv * v.y; acc[q * 4 + 2] += pv * v.z; acc[q * 4 + 3] += pv * v.w;
        }
    }
    u16* o = MIX + (row0 + t) * DM + 512 + g * 128 + d0;
    const float* sc = p.pool_scale + g * 128 + d0;
#pragma unroll
    for (int q = 0; q < 4; ++q) {
        uint4 ow;
        ow.x = pk2(acc[q * 8 + 0] * sc[q * 8 + 0], acc[q * 8 + 1] * sc[q * 8 + 1]);
        ow.y = pk2(acc[q * 8 + 2] * sc[q * 8 + 2], acc[q * 8 + 3] * sc[q * 8 + 3]);
        ow.z = pk2(acc[q * 8 + 4] * sc[q * 8 + 4], acc[q * 8 + 5] * sc[q * 8 + 5]);
        ow.w = pk2(acc[q * 8 + 6] * sc[q * 8 + 6], acc[q * 8 + 7] * sc[q * 8 + 7]);
        *(uint4*)(o + q * 8) = ow;
    }
}

__device__ void xattn_phase(const Params& p, int layer, unsigned char* smem) {
    const int tid = threadIdx.x, lane = tid & 63, wid = tid >> 6;
    float* qs = (float*)smem + wid * 512; float* ps = qs + 256;
    const u16* Q = (const u16*)(p.ws + WS_Q); const u16* KV = (const u16*)(p.ws + WS_KV) + (size_t)layer * 2048 * 2048;
    u16* MIX = (u16*)(p.ws + WS_MIX);
    const int gw = (blockIdx.x * NT + tid) >> 6, ngw = (gridDim.x * NT) >> 6;
    for (int it = gw; it < T * 4; it += ngw) {
        const int m = it >> 2, h = it & 3, b = m >> 12;
        WAVE_SYNC();
        { const uint2 w = *(const uint2*)(Q + (size_t)m * DM + h * 256 + lane * 4);
          qs[lane * 4 + 0] = bflo(w.x); qs[lane * 4 + 1] = bfhi(w.x); qs[lane * 4 + 2] = bflo(w.y); qs[lane * 4 + 3] = bfhi(w.y); }
        WAVE_SYNC();
        float lg[4];
#pragma unroll
        for (int i = 0; i < 4; ++i) {
            const u16* kr = KV + (size_t)(b * 256 + lane + 64 * i) * 2048 + h * 256;
            float a = 0.f;
            for (int c = 0; c < 32; ++c) {
                const uint4 kv = *(const uint4*)(kr + c * 8);
                const float4 q0 = *(const float4*)(qs + c * 8), q1 = *(const float4*)(qs + c * 8 + 4);
                a += q0.x * bflo(kv.x) + q0.y * bfhi(kv.x) + q0.z * bflo(kv.y) + q0.w * bfhi(kv.y)
                   + q1.x * bflo(kv.z) + q1.y * bfhi(kv.z) + q1.z * bflo(kv.w) + q1.w * bfhi(kv.w);
            }
            lg[i] = a * 0.0625f;
        }
        const float mx = wmax(fmaxf(fmaxf(lg[0], lg[1]), fmaxf(lg[2], lg[3])));
        float e[4], s = 0.f;
#pragma unroll
        for (int i = 0; i < 4; ++i) { e[i] = __expf(lg[i] - mx); s += e[i]; }
        s = wsum(s);
        const float inv = 1.f / s;
#pragma unroll
        for (int i = 0; i < 4; ++i) ps[lane + 64 * i] = e[i] * inv;
        WAVE_SYNC();
        float o0 = 0.f, o1 = 0.f, o2 = 0.f, o3 = 0.f;
        const u16* vb = KV + (size_t)(b * 256) * 2048 + 1024 + h * 256 + lane * 4;
        for (int k = 0; k < 256; ++k) {
            const float pk = ps[k];
            const uint2 vv = *(const uint2*)(vb + (size_t)k * 2048);
            o0 += pk * bflo(vv.x); o1 += pk * bfhi(vv.x); o2 += pk * bflo(vv.y); o3 += pk * bfhi(vv.y);
        }
        uint2 ow; ow.x = pk2(o0, o1); ow.y = pk2(o2, o3);
        *(uint2*)(MIX + (size_t)m * DM + h * 256 + lane * 4) = ow;
    }
}

__device__ void rope_phase(const Params& p) {
    u16* Z = (u16*)(p.ws + WS_Z); const float2* rope = (const float2*)(p.ws + WS_ROPE);
    const size_t gt = (size_t)blockIdx.x * NT + threadIdx.x, gs = (size_t)gridDim.x * NT;
    for (size_t i = gt; i < (size_t)T * 872; i += gs) {
        const int m = (int)(i / 872), pr = (int)(i % 872);
        u16* zr = Z + (size_t)m * ZP1;
        if (pr >= 864) { const int h = pr - 864; zr[1856 + h] = f2bf(bf2f(zr[1856 + h]) * 0.35355339059327373f); continue; }
        int c1, c2, j;
        if (pr < 512) { const int hd = pr >> 6; j = pr & 63; c1 = hd * 128 + j; c2 = c1 + 64; }
        else if (pr < 576) { j = pr - 512; c1 = 1024 + j; c2 = c1 + 64; }
        else if (pr < 832) { const int pp = pr - 576, hd = pp >> 5; const int jj = pp & 31; j = 2 * jj; c1 = 1280 + hd * 64 + jj; c2 = c1 + 32; }
        else { const int jj = pr - 832; j = 2 * jj; c1 = 1792 + jj; c2 = c1 + 32; }
        const float2 cs = rope[(size_t)m * 64 + j];
        const float x1 = bf2f(zr[c1]), x2 = bf2f(zr[c2]);
        zr[c1] = f2bf(x1 * cs.x - x2 * cs.y); zr[c2] = f2bf(x2 * cs.x + x1 * cs.y);
    }
}

constexpr int DSA_WAVE_LDS = 19 * 1024;
__device__ void dsa_phase(const Params& p, unsigned char* smem) {
    const int tid = threadIdx.x, lane = tid & 63, wid = tid >> 6;
    unsigned char* wb = smem + wid * DSA_WAVE_LDS;
    unsigned* sck = (unsigned*)wb; float* pl = (float*)wb; float* qf = (float*)(wb + 8192);
    float* qif = (float*)(wb + 16384); u16* idx = (u16*)(wb + 16384);
    unsigned* hist = (unsigned*)(wb + 18432);
    const u16* Z = (const u16*)(p.ws + WS_Z); u16* MIX = (u16*)(p.ws + WS_MIX);
    const int gw = (blockIdx.x * NT + tid) >> 6, ngw = (gridDim.x * NT) >> 6;
    const unsigned long long lt_mask = (lane == 0) ? 0ull : (~0ull >> (64 - lane));
    for (int m = gw; m < T; m += ngw) {
        const int b = m >> 12, t = m & 4095, n = t + 1;
        const u16* zq = Z + (size_t)m * ZP1;
        const size_t brow = (size_t)b * SEQ;
        int count;
        WAVE_SYNC();
        if (n <= 256) {
            count = n;
            for (int j = lane; j < n; j += 64) idx[j] = (u16)j;
        } else {
            count = 256;
            { const uint4 w = *(const uint4*)(zq + 1280 + lane * 8);
              qif[lane * 8 + 0] = bflo(w.x); qif[lane * 8 + 1] = bfhi(w.x); qif[lane * 8 + 2] = bflo(w.y); qif[lane * 8 + 3] = bfhi(w.y);
              qif[lane * 8 + 4] = bflo(w.z); qif[lane * 8 + 5] = bfhi(w.z); qif[lane * 8 + 6] = bflo(w.w); qif[lane * 8 + 7] = bfhi(w.w); }
            float wi[8];
            { const uint4 w = *(const uint4*)(zq + 1856);
              wi[0] = bflo(w.x); wi[1] = bfhi(w.x); wi[2] = bflo(w.y); wi[3] = bfhi(w.y); wi[4] = bflo(w.z); wi[5] = bfhi(w.z); wi[6] = bflo(w.w); wi[7] = bfhi(w.w); }
            WAVE_SYNC();
            for (int s = lane; s < n; s += 64) {
                const u16* kr = Z + (brow + s) * ZP1 + 1792;
                float kf[64];
#pragma unroll
                for (int c = 0; c < 8; ++c) {
                    const uint4 w = *(const uint4*)(kr + c * 8);
                    kf[c * 8 + 0] = bflo(w.x); kf[c * 8 + 1] = bfhi(w.x); kf[c * 8 + 2] = bflo(w.y); kf[c * 8 + 3] = bfhi(w.y);
                    kf[c * 8 + 4] = bflo(w.z); kf[c * 8 + 5] = bfhi(w.z); kf[c * 8 + 6] = bflo(w.w); kf[c * 8 + 7] = bfhi(w.w);
                }
                float sc = 0.f;
#pragma unroll
                for (int h = 0; h < 8; ++h) {
                    float d = 0.f;
#pragma unroll
                    for (int c = 0; c < 16; ++c) {
                        const float4 q = *(const float4*)(qif + h * 64 + c * 4);
                        d += q.x * kf[c * 4 + 0] + q.y * kf[c * 4 + 1] + q.z * kf[c * 4 + 2] + q.w * kf[c * 4 + 3];
                    }
                    sc += fmaxf(d * 0.125f, 0.f) * wi[h];
                }
                unsigned u = __float_as_uint(sc);
                u = (u & 0x80000000u) ? ~u : (u | 0x80000000u);
                sck[s] = u;
            }
            WAVE_SYNC();
            unsigned prefix = 0u, mask = 0u; int want = 256;
            for (int pass = 0; pass < 4; ++pass) {
                const int shift = 24 - 8 * pass;
                hist[lane * 4 + 0] = 0u; hist[lane * 4 + 1] = 0u; hist[lane * 4 + 2] = 0u; hist[lane * 4 + 3] = 0u;
                WAVE_SYNC();
                for (int s = lane; s < n; s += 64) { const unsigned k = sck[s]; if ((k & mask) == prefix) atomicAdd(&hist[(k >> shift) & 255u], 1u); }
                WAVE_SYNC();
                const int c0 = (int)hist[lane * 4 + 0], c1 = (int)hist[lane * 4 + 1], c2 = (int)hist[lane * 4 + 2], c3 = (int)hist[lane * 4 + 3];
                const int tot = c0 + c1 + c2 + c3;
                int S = tot;
#pragma unroll
                for (int o = 1; o < 64; o <<= 1) { const int v = __shfl_down(S, o); if (lane + o < 64) S += v; }
                const int above = S - tot;
                const bool ok = (above < want) && (want <= S);
                int dig = 0, nw = 0;
                if (ok) {
                    int cum = above;
                    if (cum + c3 >= want) { dig = lane * 4 + 3; nw = want - cum; }
                    else { cum += c3;
                        if (cum + c2 >= want) { dig = lane * 4 + 2; nw = want - cum; }
                        else { cum += c2;
                            if (cum + c1 >= want) { dig = lane * 4 + 1; nw = want - cum; }
                            else { cum += c1; dig = lane * 4; nw = want - cum; } } }
                }
                const unsigned long long bal = __ballot(ok);
                const int src = (int)__ffsll((long long)bal) - 1;
                dig = __shfl(dig, src); nw = __shfl(nw, src);
                prefix |= ((unsigned)dig) << shift; mask |= 255u << shift; want = nw;
                WAVE_SYNC();
            }
            int base = 0, eqt = 0;
            for (int s0 = 0; s0 < n; s0 += 64) {
                const int s = s0 + lane; const bool in = s < n;
                const unsigned k = in ? sck[s] : 0u;
                const bool gt = in && (k > prefix), eq = in && (k == prefix);
                const unsigned long long beq = __ballot(eq);
                const int rank = eqt + __popcll(beq & lt_mask);
                const bool take = gt || (eq && rank < want);
                const unsigned long long bt = __ballot(take);
                const int pos = base + __popcll(bt & lt_mask);
                if (take && pos < 256) idx[pos] = (u16)s;
                base += __popcll(bt); eqt += __popcll(beq);
            }
        }
        WAVE_SYNC();
        { const uint4 w0 = *(const uint4*)(zq + lane * 16), w1 = *(const uint4*)(zq + lane * 16 + 8);
          float* q = qf + lane * 16;
          q[0] = bflo(w0.x); q[1] = bfhi(w0.x); q[2] = bflo(w0.y); q[3] = bfhi(w0.y); q[4] = bflo(w0.z); q[5] = bfhi(w0.z); q[6] = bflo(w0.w); q[7] = bfhi(w0.w);
          q[8] = bflo(w1.x); q[9] = bfhi(w1.x); q[10] = bflo(w1.y); q[11] = bfhi(w1.y); q[12] = bflo(w1.z); q[13] = bfhi(w1.z); q[14] = bflo(w1.w); q[15] = bfhi(w1.w); }
        WAVE_SYNC();
        float lg[4][8];
#pragma unroll
        for (int i = 0; i < 4; ++i) {
            const int j = lane + 64 * i; const bool valid = j < count;
            const int ki = valid ? (int)idx[j] : 0;
            const u16* kr = Z + (brow + ki) * ZP1 + 1024;
            float a[8];
#pragma unroll
            for (int h = 0; h < 8; ++h) a[h] = 0.f;
            for (int c = 0; c < 16; ++c) {
                const uint4 w = *(const uint4*)(kr + c * 8);
                const float k0 = bflo(w.x), k1 = bfhi(w.x), k2 = bflo(w.y), k3 = bfhi(w.y), k4 = bflo(w.z), k5 = bfhi(w.z), k6 = bflo(w.w), k7 = bfhi(w.w);
#pragma unroll
                for (int h = 0; h < 8; ++h) {
                    const float4 q0 = *(const float4*)(qf + h * 128 + c * 8), q1 = *(const float4*)(qf + h * 128 + c * 8 + 4);
                    a[h] += q0.x * k0 + q0.y * k1 + q0.z * k2 + q0.w * k3 + q1.x * k4 + q1.y * k5 + q1.z * k6 + q1.w * k7;
                }
            }
#pragma unroll
            for (int h = 0; h < 8; ++h) lg[i][h] = valid ? a[h] * 0.08838834764831845f : -INFINITY;
        }
#pragma unroll
        for (int h = 0; h < 8; ++h) {
            const float mx = wmax(fmaxf(fmaxf(lg[0][h], lg[1][h]), fmaxf(lg[2][h], lg[3][h])));
            float e0 = __expf(lg[0][h] - mx), e1 = __expf(lg[1][h] - mx), e2 = __expf(lg[2][h] - mx), e3 = __expf(lg[3][h] - mx);
            const float inv = 1.f / wsum(e0 + e1 + e2 + e3);
            pl[h * 256 + lane] = e0 * inv; pl[h * 256 + lane + 64] = e1 * inv; pl[h * 256 + lane + 128] = e2 * inv; pl[h * 256 + lane + 192] = e3 * inv;
        }
        WAVE_SYNC();
        float o[8][2];
#pragma unroll
        for (int h = 0; h < 8; ++h) { o[h][0] = 0.f; o[h][1] = 0.f; }
        for (int j = 0; j < count; ++j) {
            const int vi = (int)idx[j];
            const unsigned vv = *(const unsigned*)(Z + (brow + vi) * ZP1 + 1152 + lane * 2);
            const float v0 = bflo(vv), v1 = bfhi(vv);
#pragma unroll
            for (int h = 0; h < 8; ++h) { const float pj = pl[h * 256 + j]; o[h][0] += pj * v0; o[h][1] += pj * v1; }
        }
#pragma unroll
        for (int h = 0; h < 8; ++h) *(unsigned*)(MIX + (size_t)m * DM + h * 128 + lane * 2) = pk2(o[h][0], o[h][1]);
    }
}

constexpr int NPHASE = 26;
constexpr int LDS_BYTES = 8 * DSA_WAVE_LDS;
template <int SEL> __device__ __forceinline__ void run_phase(const Params& p, int ph, unsigned char* smem) {
#define ON(k) (SEL < 0 || SEL == (k))
    u16* HN = (u16*)(p.ws + WS_HN); u16* Y = (u16*)(p.ws + WS_Y); u16* Z = (u16*)(p.ws + WS_Z); u16* MIX = (u16*)(p.ws + WS_MIX);
    u16* Qb = (u16*)(p.ws + WS_Q); u16* HID = (u16*)(p.ws + WS_HID); u16* MEMN = (u16*)(p.ws + WS_MEMN); u16* KV = (u16*)(p.ws + WS_KV);
    if (ON(0) && ph == 0) {
        float2* rope = (float2*)(p.ws + WS_ROPE);
        const int gt = blockIdx.x * NT + threadIdx.x, gs = gridDim.x * NT;
        for (int i = gt; i < T * 64; i += gs) {
            const int m = i >> 6, j = i & 63;
            const float inv = expf(-0.14391156831212787f * (float)j);
            const float ang = (float)p.pos[m] * inv;
            rope[i] = make_float2(cosf(ang), sinf(ang));
        }
        rmsnorm_rows(p.mem, p.gains + (0 * 7 + 6) * DM, MEMN, 2048);
        rmsnorm_rows(p.mem, p.gains + (1 * 7 + 6) * DM, MEMN + (size_t)2048 * DM, 2048);
        rmsnorm_rows(p.x, p.gains + 0, HN, T);
        return;
    }
    if (ON(1) && ph == 1) {
        gemm_phase(MEMN, DM, p.wkv, 2048, DM, 2048, KV, 2048, 0, smem);
        gemm_phase(MEMN + (size_t)2048 * DM, DM, p.wkv + (size_t)DM * 2048, 2048, DM, 2048, KV + (size_t)2048 * 2048, 2048, 0, smem);
        return;
    }
    const int l = (ph - 2) / 12, s = (ph - 2) % 12;
    const float* g = p.gains + (size_t)l * 7 * DM;
    switch (s) {
    case 0: if (ON(2)) { if (l == 0) gemm_phase(HN, DM, p.ev_w_in, EVEN_IN, DM, T, Z, EVEN_IN, 0, smem);
            else gemm_phase(HN, DM, p.od_w_in, ODD_IN, DM, T, Z, ZP1, 0, smem); }
            break;
    case 1: if (l == 0) { if (ON(3)) { for (int u = blockIdx.x; u < 2048; u += gridDim.x) { if (u < 1024) mixer_a_unit(p, u, smem); else mixer_b_unit(p, u - 1024, smem); } } }
            else { if (ON(4)) rope_phase(p); }
            break;
    case 2: if (ON(5)) { if (l == 1) dsa_phase(p, smem); } break;
    case 3: if (ON(2)) gemm_phase(MIX, DM, l == 0 ? p.ev_w_out : p.od_w_out, DM, DM, T, Y, DM, 0, smem); break;
    case 4: if (ON(6)) postnorm_rows(l == 0 ? p.x : p.out, Y, g + 1 * DM, p.out, g + 2 * DM, HN); break;
    case 5: if (ON(2)) gemm_phase(HN, DM, p.wq + (size_t)l * DM * DM, DM, DM, T, Qb, DM, 0, smem); break;
    case 6: if (ON(7)) xattn_phase(p, l, smem); break;
    case 7: if (ON(2)) gemm_phase(MIX, DM, p.wo + (size_t)l * DM * DM, DM, DM, T, Y, DM, 0, smem); break;
    case 8: if (ON(6)) postnorm_rows(p.out, Y, g + 3 * DM, p.out, g + 4 * DM, HN); break;
    case 9: if (ON(2)) gemm_phase(HN, DM, p.w1 + (size_t)l * DM * DFF, DFF, DM, T, HID, DFF, 1, smem); break;
    case 10: if (ON(2)) gemm_phase(HID, DFF, p.w2 + (size_t)l * DFF * DM, DM, DFF, T, Y, DM, 0, smem); break;
    case 11: if (ON(6)) postnorm_rows(p.out, Y, g + 5 * DM, p.out, l == 0 ? (p.gains + (size_t)7 * DM) : nullptr, HN); break;
    }
#undef ON
}
__host__ __device__ constexpr int phase_kind(int ph) {
    if (ph == 0) return 0; if (ph == 1) return 1;
    const int l = (ph - 2) / 12, s = (ph - 2) % 12;
    return (s == 0 || s == 3 || s == 5 || s == 7 || s == 9 || s == 10) ? 2 : (s == 1 ? (l == 0 ? 3 : 4) : (s == 2 ? 5 : (s == 6 ? 7 : 6)));
}

template <int SEL> __global__ void __launch_bounds__(NT) fwd_kernel(Params p) {
    extern __shared__ __attribute__((aligned(16))) unsigned char smem[];
#if ONE_LAUNCH
    cg::grid_group grid = cg::this_grid();
#endif
    for (int ph = p.ph_lo; ph < p.ph_hi; ++ph) {
        run_phase<SEL>(p, ph, smem);
#if ONE_LAUNCH
        if (ph + 1 < p.ph_hi) grid.sync();
#endif
    }
}

extern "C" void kernel_launch(void* const* d_in, const int* in_sizes, int n_in, void* d_out, int out_size, void* d_ws, size_t ws_size, hipStream_t stream) {
    static int inited = 0, cus = 256;
    if (!inited) {
        inited = 1;
        if (ws_size < WS_END) fprintf(stderr, "kernel_launch: workspace too small: %zu < %zu\n", ws_size, (size_t)WS_END);
        int dev = 0; (void)hipGetDevice(&dev); (void)hipDeviceGetAttribute(&cus, hipDeviceAttributeMultiprocessorCount, dev);
#if ONE_LAUNCH
        (void)hipFuncSetAttribute((const void*)fwd_kernel<-1>, hipFuncAttributeMaxDynamicSharedMemorySize, LDS_BYTES);
#else
        (void)hipFuncSetAttribute((const void*)fwd_kernel<0>, hipFuncAttributeMaxDynamicSharedMemorySize, LDS_BYTES);
        (void)hipFuncSetAttribute((const void*)fwd_kernel<1>, hipFuncAttributeMaxDynamicSharedMemorySize, LDS_BYTES);
        (void)hipFuncSetAttribute((const void*)fwd_kernel<2>, hipFuncAttributeMaxDynamicSharedMemorySize, LDS_BYTES);
        (void)hipFuncSetAttribute((const void*)fwd_kernel<3>, hipFuncAttributeMaxDynamicSharedMemorySize, LDS_BYTES);
        (void)hipFuncSetAttribute((const void*)fwd_kernel<4>, hipFuncAttributeMaxDynamicSharedMemorySize, LDS_BYTES);
        (void)hipFuncSetAttribute((const void*)fwd_kernel<5>, hipFuncAttributeMaxDynamicSharedMemorySize, LDS_BYTES);
        (void)hipFuncSetAttribute((const void*)fwd_kernel<6>, hipFuncAttributeMaxDynamicSharedMemorySize, LDS_BYTES);
        (void)hipFuncSetAttribute((const void*)fwd_kernel<7>, hipFuncAttributeMaxDynamicSharedMemorySize, LDS_BYTES);
#endif
        (void)hipGetLastError();
    }
    Params p{};
    p.x = (const float*)d_in[0]; p.mem = (const float*)d_in[1]; p.pos = (const int*)d_in[2]; p.gains = (const float*)d_in[3];
    p.wq = (const float*)d_in[4]; p.wkv = (const float*)d_in[5]; p.wo = (const float*)d_in[6]; p.w1 = (const float*)d_in[7]; p.w2 = (const float*)d_in[8];
    p.ev_w_in = (const float*)d_in[9]; p.sgu_g = (const float*)d_in[10]; p.sgu_ws = (const float*)d_in[11]; p.sgu_bs = (const float*)d_in[12];
    p.pool_w = (const float*)d_in[13]; p.pool_scale = (const float*)d_in[14]; p.ev_w_out = (const float*)d_in[15];
    p.od_w_in = (const float*)d_in[16]; p.od_w_out = (const float*)d_in[17];
    p.out = (float*)d_out; p.ws = (unsigned char*)d_ws;
#if ONE_LAUNCH
    p.ph_lo = 0; p.ph_hi = NPHASE;
    void* args[] = {&p};
    hipError_t e = hipLaunchCooperativeKernel((const void*)fwd_kernel<-1>, dim3(cus), dim3(NT), args, LDS_BYTES, stream);
    if (e != hipSuccess) fprintf(stderr, "cooperative launch failed: %s\n", hipGetErrorString(e));
#else
    for (int ph = 0; ph < NPHASE; ++ph) {
        if (ph == 2 + 2) continue;
        p.ph_lo = ph; p.ph_hi = ph + 1;
        switch (phase_kind(ph)) {
        case 0: hipLaunchKernelGGL(fwd_kernel<0>, dim3(cus * 4), dim3(NT), LDS_BYTES, stream, p); break;
        case 1: hipLaunchKernelGGL(fwd_kernel<1>, dim3(cus * 4), dim3(NT), LDS_BYTES, stream, p); break;
        case 2: hipLaunchKernelGGL(fwd_kernel<2>, dim3(cus * 4), dim3(NT), LDS_BYTES, stream, p); break;
        case 3: hipLaunchKernelGGL(fwd_kernel<3>, dim3(cus * 4), dim3(NT), LDS_BYTES, stream, p); break;
        case 4: hipLaunchKernelGGL(fwd_kernel<4>, dim3(cus * 4), dim3(NT), LDS_BYTES, stream, p); break;
        case 5: hipLaunchKernelGGL(fwd_kernel<5>, dim3(cus * 4), dim3(NT), LDS_BYTES, stream, p); break;
        case 6: hipLaunchKernelGGL(fwd_kernel<6>, dim3(cus * 4), dim3(NT), LDS_BYTES, stream, p); break;
        default: hipLaunchKernelGGL(fwd_kernel<7>, dim3(cus * 4), dim3(NT), LDS_BYTES, stream, p); break;
        }
    }
#endif
}
```

```cpp
#include <hip/hip_runtime.h>
#include <hip/hip_cooperative_groups.h>
#include <cstdio>
#include <cstdint>
namespace cg = cooperative_groups;


#ifndef DUP_PH
#define DUP_PH -1
#endif
#define DSA_DUP 0
#define EXTRA_BARRIERS 0
typedef unsigned short u16;
typedef short bf16x8 __attribute__((ext_vector_type(8)));
typedef float f32x4 __attribute__((ext_vector_type(4)));

constexpr int NT = 512;
constexpr int NB = 8, SEQ = 4096, T = NB * SEQ, DM = 1024, NMEM = 256, DFF = 4096;
constexpr int EVEN_IN = 1536, ODD_IN = 1864, ZP1 = 2048;
constexpr float EPS = 1e-6f;

constexpr size_t MiB = 1u << 20;
constexpr size_t WS_WKV = 2 * MiB, WS_WQ = 10 * MiB, WS_WO = 14 * MiB, WS_W1 = 18 * MiB, WS_W2 = 34 * MiB;
constexpr size_t WS_EVIN = 50 * MiB, WS_EVOUT = 53 * MiB, WS_ODIN = 55 * MiB, WS_ODOUT = 59 * MiB;
constexpr size_t WS_WC = 61 * MiB, WS_PWT = 61 * MiB + 131072;
constexpr size_t WS_RS = 62 * MiB;
constexpr size_t WS_ROPE = 66 * MiB;
constexpr size_t WS_MEMN = 82 * MiB;
constexpr size_t WS_KV   = 90 * MiB;
constexpr size_t WS_HN   = 122 * MiB;
constexpr size_t WS_Y    = 186 * MiB;
constexpr size_t WS_Z    = 250 * MiB;
constexpr size_t WS_MIX  = 378 * MiB;
constexpr size_t WS_Q    = 442 * MiB;
constexpr size_t WS_KB = 442 * MiB, WS_VB = 450 * MiB, WS_KI = 458 * MiB;
constexpr size_t WS_BT1 = 442 * MiB, WS_BT2 = 458 * MiB;
constexpr size_t WS_HID  = 250 * MiB;
constexpr size_t WS_END  = 506 * MiB;

constexpr int DSA_WAVE_LDS = 19 * 1024;
constexpr int NPHASE = 27;
constexpr int LDS_CTL_OFF = 8 * DSA_WAVE_LDS;
constexpr int LDS_BYTES = LDS_CTL_OFF + 64;

struct Params {
    const float* x; const float* mem; const int* pos; const float* gains;
    const float* wq; const float* wkv; const float* wo; const float* w1; const float* w2;
    const float* ev_w_in; const float* sgu_g; const float* sgu_ws; const float* sgu_bs;
    const float* pool_w; const float* pool_scale; const float* ev_w_out;
    const float* od_w_in; const float* od_w_out;
    float* out; unsigned char* ws;
};

#if defined(__HIP_DEVICE_COMPILE__)
__device__ __forceinline__ u16 f2bf(float f) { unsigned u = __float_as_uint(f); return (u16)((u + 0x7fffu + ((u >> 16) & 1u)) >> 16); }
__device__ __forceinline__ float bf2f(u16 h) { return __uint_as_float(((unsigned)h) << 16); }
__device__ __forceinline__ float bflo(unsigned w) { return __uint_as_float(w << 16); }
__device__ __forceinline__ float bfhi(unsigned w) { return __uint_as_float(w & 0xffff0000u); }
__device__ __forceinline__ unsigned pk2hw(float lo, float hi) { unsigned r; asm("v_cvt_pk_bf16_f32 %0, %1, %2" : "=v"(r) : "v"(lo), "v"(hi)); return r; }
__device__ __forceinline__ unsigned pk2(float lo, float hi) { return (unsigned)f2bf(lo) | ((unsigned)f2bf(hi) << 16); }
__device__ __forceinline__ float wsum(float v) {
#pragma unroll
    for (int o = 32; o > 0; o >>= 1) v += __shfl_xor(v, o);
    return v;
}
__device__ __forceinline__ float rsum16(float v) {
    v += __int_as_float(__builtin_amdgcn_update_dpp(0, __float_as_int(v), 0xB1, 0xf, 0xf, true));
    v += __int_as_float(__builtin_amdgcn_update_dpp(0, __float_as_int(v), 0x4E, 0xf, 0xf, true));
    v += __int_as_float(__builtin_amdgcn_update_dpp(0, __float_as_int(v), 0x141, 0xf, 0xf, true));
    v += __int_as_float(__builtin_amdgcn_update_dpp(0, __float_as_int(v), 0x140, 0xf, 0xf, true));
    return v;
}
__device__ __forceinline__ float wmax(float v) {
#pragma unroll
    for (int o = 32; o > 0; o >>= 1) v = fmaxf(v, __shfl_xor(v, o));
    return v;
}
__device__ __forceinline__ float gelu_tanh(float x) { return 0.5f * x * (1.f + tanhf(0.7978845608028654f * (x + 0.044715f * x * x * x))); }
__device__ __forceinline__ int tid_opaque() { int t = threadIdx.x; asm volatile("" : "+v"(t)); return t; }
#ifndef LAS3
#define LAS3 __attribute__((address_space(3)))
#endif
#define WAVE_SYNC() asm volatile("s_waitcnt lgkmcnt(0)" ::: "memory")

__device__ __forceinline__ void rmsnorm_rows(const float* in, const float* g, u16* out, int rows) {
    const int tid = tid_opaque(), lane = tid & 63, gw = (blockIdx.x * NT + tid) >> 6, ngw = (gridDim.x * NT) >> 6;
    for (int r = gw; r < rows; r += ngw) {
        const float4* xr = (const float4*)(in + (size_t)r * DM);
        float4 v[4]; float ss = 0.f;
#pragma unroll
        for (int j = 0; j < 4; ++j) { v[j] = xr[lane + 64 * j]; ss += v[j].x * v[j].x + v[j].y * v[j].y + v[j].z * v[j].z + v[j].w * v[j].w; }
        ss = wsum(ss);
        const float rstd = rsqrtf(ss * (1.f / DM) + EPS);
#pragma unroll
        for (int j = 0; j < 4; ++j) {
            const float4 gg = ((const float4*)g)[lane + 64 * j];
            uint2 o; o.x = pk2(v[j].x * rstd * gg.x, v[j].y * rstd * gg.y); o.y = pk2(v[j].z * rstd * gg.z, v[j].w * rstd * gg.w);
            ((uint2*)(out + (size_t)r * DM))[lane + 64 * j] = o;
        }
    }
}
__device__ __forceinline__ void cast_rows(const float* in, u16* hb, float* rs) {
    const int tid = tid_opaque(), lane = tid & 63, gw = (blockIdx.x * NT + tid) >> 6, ngw = (gridDim.x * NT) >> 6;
    for (int r = gw; r < T; r += ngw) {
        const float4* xr = (const float4*)(in + (size_t)r * DM);
        float4 v[4]; float ss = 0.f;
#pragma unroll
        for (int j = 0; j < 4; ++j) { v[j] = xr[lane + 64 * j]; ss += v[j].x * v[j].x + v[j].y * v[j].y + v[j].z * v[j].z + v[j].w * v[j].w; }
        ss = wsum(ss);
#pragma unroll
        for (int j = 0; j < 4; ++j) { uint2 o; o.x = pk2(v[j].x, v[j].y); o.y = pk2(v[j].z, v[j].w); ((uint2*)(hb + (size_t)r * DM))[lane + 64 * j] = o; }
        if (lane == 0) rs[r] = rsqrtf(ss * (1.f / DM) + EPS);
    }
}
template <bool FINAL> __device__ __forceinline__ void postnorm_rows(u16* hb, const u16* y, const float* gpost, float* rs, float* fout) {
    const int tid = tid_opaque(), lane = tid & 63, gw = (blockIdx.x * NT + tid) >> 6, ngw = (gridDim.x * NT) >> 6;
    for (int r0 = gw; r0 < T; r0 += 2 * ngw) {
        const bool two = r0 + ngw < T; const int r1 = two ? r0 + ngw : r0;
        uint4 yw[2][2], hw[2][2];
#pragma unroll
        for (int q = 0; q < 2; ++q) { const size_t ro = (size_t)(q ? r1 : r0) * DM + lane * 8;
#pragma unroll
            for (int j = 0; j < 2; ++j) { yw[q][j] = *(const uint4*)(y + ro + j * 512); hw[q][j] = *(const uint4*)(hb + ro + j * 512); } }
        float4 g0[2], g1[2];
#pragma unroll
        for (int j = 0; j < 2; ++j) { g0[j] = *(const float4*)(gpost + j * 512 + lane * 8); g1[j] = *(const float4*)(gpost + j * 512 + lane * 8 + 4); }
#pragma unroll
        for (int q = 0; q < 2; ++q) {
            if (q == 1 && !two) break;
            const int r = q ? r1 : r0;
            float yv[16], hv[16]; float ss = 0.f;
#pragma unroll
            for (int j = 0; j < 2; ++j) {
                const uint4 w = yw[q][j], h4 = hw[q][j];
                yv[j * 8 + 0] = bflo(w.x); yv[j * 8 + 1] = bfhi(w.x); yv[j * 8 + 2] = bflo(w.y); yv[j * 8 + 3] = bfhi(w.y);
                yv[j * 8 + 4] = bflo(w.z); yv[j * 8 + 5] = bfhi(w.z); yv[j * 8 + 6] = bflo(w.w); yv[j * 8 + 7] = bfhi(w.w);
                hv[j * 8 + 0] = bflo(h4.x); hv[j * 8 + 1] = bfhi(h4.x); hv[j * 8 + 2] = bflo(h4.y); hv[j * 8 + 3] = bfhi(h4.y);
                hv[j * 8 + 4] = bflo(h4.z); hv[j * 8 + 5] = bfhi(h4.z); hv[j * 8 + 6] = bflo(h4.w); hv[j * 8 + 7] = bfhi(h4.w);
            }
#pragma unroll
            for (int i = 0; i < 16; ++i) ss += yv[i] * yv[i];
            ss = wsum(ss);
            const float rstd = rsqrtf(ss * (1.f / DM) + EPS);
            float s2 = 0.f;
#pragma unroll
            for (int j = 0; j < 2; ++j) {
                hv[j * 8 + 0] += yv[j * 8 + 0] * rstd * g0[j].x; hv[j * 8 + 1] += yv[j * 8 + 1] * rstd * g0[j].y; hv[j * 8 + 2] += yv[j * 8 + 2] * rstd * g0[j].z; hv[j * 8 + 3] += yv[j * 8 + 3] * rstd * g0[j].w;
                hv[j * 8 + 4] += yv[j * 8 + 4] * rstd * g1[j].x; hv[j * 8 + 5] += yv[j * 8 + 5] * rstd * g1[j].y; hv[j * 8 + 6] += yv[j * 8 + 6] * rstd * g1[j].z; hv[j * 8 + 7] += yv[j * 8 + 7] * rstd * g1[j].w;
                if constexpr (FINAL) {
                    float* o = fout + (size_t)r * DM + j * 512 + lane * 8;
                    *(float4*)o = make_float4(hv[j * 8 + 0], hv[j * 8 + 1], hv[j * 8 + 2], hv[j * 8 + 3]);
                    *(float4*)(o + 4) = make_float4(hv[j * 8 + 4], hv[j * 8 + 5], hv[j * 8 + 6], hv[j * 8 + 7]);
                } else {
                    uint4 o;
                    o.x = pk2(hv[j * 8 + 0], hv[j * 8 + 1]); o.y = pk2(hv[j * 8 + 2], hv[j * 8 + 3]); o.z = pk2(hv[j * 8 + 4], hv[j * 8 + 5]); o.w = pk2(hv[j * 8 + 6], hv[j * 8 + 7]);
                    *(uint4*)(hb + (size_t)r * DM + j * 512 + lane * 8) = o;
                }
            }
            if constexpr (!FINAL) {
#pragma unroll
                for (int i = 0; i < 16; ++i) s2 += hv[i] * hv[i];
                s2 = wsum(s2);
                if (lane == 0) rs[r] = rsqrtf(s2 * (1.f / DM) + EPS);
            }
        }
    }
}

namespace pg8 {
#define PG8_LAS __attribute__((address_space(3)))
typedef unsigned short bf16_t;
typedef short bf16x8 __attribute__((ext_vector_type(8)));
typedef float f32x4 __attribute__((ext_vector_type(4)));
typedef unsigned u32x4 __attribute__((ext_vector_type(4)));
typedef int i32x4 __attribute__((ext_vector_type(4)));
typedef int i32x8 __attribute__((ext_vector_type(8)));
constexpr int BM = 256, BK = 64, HALF = 128, HTB = HALF * BK * 2  , STAGE_BYTES = 8 * HTB, NXCD = 8, WGM = 8;

__host__ __device__ __forceinline__ int lds_byte(int r, int c) { const int st = (r >> 4) * 2 + (c >> 5), rr = r & 15, cc = c & 31, ob = rr * 64 + cc * 2; return st * 1024 + (ob ^ (((ob >> 9) & 1) << 5)); }
__host__ __device__ __forceinline__ void stage_rc(int b, int& R, int& C) { const int st = b / 1024, sb = b % 1024, swz = sb ^ (((sb >> 9) & 1) << 5); R = (st >> 1) * 16 + swz / 64; C = (st & 1) * 32 + (swz % 64) / 2; }
__host__ __device__ __forceinline__ int perm32(int rho) { const int n = rho >> 4, i = rho & 15; return 8 * (i >> 2) + 4 * n + (i & 3); }

struct Unit { int pm, pn; long aoff, boff, coff; };
struct Gemm { const bf16_t* A; const bf16_t* Bt; int M, N, K, lda, ldb; };

struct StaticOrder {
    int nM, nN, nwg, G, c;
    __host__ __device__ void init(int M, int N, int G_, int c_) { nM = M / BM; nN = N / BM; nwg = nM * nN; G = G_; c = c_; }
    __host__ __device__ bool next(int i, Unit& u) const {
        const long L = (long)i * G + c; if (L >= nwg) return false;
        int wgid = (int)L; { const int q = nwg / NXCD, r = nwg % NXCD, xcd = wgid % NXCD, off = wgid / NXCD; wgid = (xcd < r ? xcd * (q + 1) : r * (q + 1) + (xcd - r) * q) + off; }
        const int nig = WGM * nN, gid = wgid / nig, fm = gid * WGM, gsz = (nM - fm) < WGM ? (nM - fm) : WGM;
        u.pm = fm + ((wgid % nig) % gsz); u.pn = (wgid % nig) / gsz; u.aoff = 0; u.boff = 0; u.coff = 0; return true;
    }
    __device__ __forceinline__ void a_ready(const Unit&) const {}
    __device__ __forceinline__ void done(const Unit&) const {}
};
__device__ __forceinline__ unsigned cvt_pk_bf16(float lo, float hi) { unsigned r; asm volatile("v_cvt_pk_bf16_f32 %0, %1, %2" : "=v"(r) : "v"(lo), "v"(hi)); return r; }
template <class Epi, class Sched, bool ALIGN_EPI = false, bool SP2 = false, bool F8 = false>
__device__ __forceinline__ void gemm_phase(PG8_LAS unsigned char* lds, const Gemm g, const Sched& S, const Epi& E) {
    const int tid = tid_opaque(), wid = __builtin_amdgcn_readfirstlane(tid >> 6), lane = tid & 63, wr = wid >> 2, wc = wid & 3, fr = lane & 15, fq = lane >> 4;
    const int K = g.K, nt = K / BK;
    unsigned voffA[2], voffB[2];
#pragma unroll
    for (int i = 0; i < 2; ++i) { int R, C; stage_rc(tid * 16 + i * 8192, R, C); const int Rb = Epi::PERM ? ((R & ~31) + perm32(R & 31)) : R;
        voffA[i] = (unsigned)(R * g.lda + C) * 2u; voffB[i] = (unsigned)(Rb * g.ldb + C) * 2u; }
    const size_t kstep = (size_t)(BK * 2);
    const size_t hstepA = (size_t)HALF * g.lda * 2, hstepB = (size_t)HALF * g.ldb * 2;
    const size_t tstepA = 2 * hstepA, tstepB = 2 * hstepB;
    const unsigned ldsw = (unsigned)wid * 1024u;
    const int aoff = lds_byte(wr * 64 + fr, fq * 8), boff = lds_byte(wc * 32 + fr, fq * 8);
#define PG8_SA(b, h) (((b) * 2 + (h)) * HTB)
#define PG8_SB(b, h) ((4 + (b) * 2 + (h)) * HTB)
#define PG8_STAGE(bufoff, gbase, voff) do { _Pragma("unroll") for (int _i = 0; _i < 2; ++_i) \
        __builtin_amdgcn_global_load_lds((const unsigned*)((const char*)(gbase) + (voff)[_i]), (PG8_LAS unsigned*)(lds + (bufoff) + ldsw + _i * 8192), 16, 0, 0); } while (0)
#define PG8_LDA(dst, b, h) do { _Pragma("unroll") for (int m = 0; m < 4; ++m) _Pragma("unroll") for (int k = 0; k < 2; ++k) dst[m][k] = *(const PG8_LAS bf16x8*)(lds + PG8_SA(b, h) + aoff + m * 2048 + k * 1024); } while (0)
#define PG8_LDB(dst, b, h) do { _Pragma("unroll") for (int n = 0; n < 2; ++n) _Pragma("unroll") for (int k = 0; k < 2; ++k) dst[n][k] = *(const PG8_LAS bf16x8*)(lds + PG8_SB(b, h) + boff + n * 2048 + k * 1024); } while (0)
#define PG8_MMA(ai, bj, At, Bt) do { __builtin_amdgcn_s_setprio(1); _Pragma("unroll") for (int m = 0; m < 4; ++m) _Pragma("unroll") for (int n = 0; n < 2; ++n) { \
        if constexpr (F8) { const i32x8 b8_ = __builtin_shufflevector((i32x4)Bt[n][0], (i32x4)Bt[n][1], 0, 1, 2, 3, 4, 5, 6, 7), a8_ = __builtin_shufflevector((i32x4)At[m][0], (i32x4)At[m][1], 0, 1, 2, 3, 4, 5, 6, 7); \
                            asm volatile("v_mfma_f32_16x16x128_f8f6f4 %0, %1, %2, %0" : "+v"(acc[ai][bj][m][n]) : "v"(b8_), "v"(a8_)); } \
        else { _Pragma("unroll") for (int k = 0; k < 2; ++k) acc[ai][bj][m][n] = __builtin_amdgcn_mfma_f32_16x16x32_bf16(Bt[n][k], At[m][k], acc[ai][bj][m][n], 0, 0, 0); } } \
        __builtin_amdgcn_s_setprio(0); } while (0)
#define PG8_WAIT_V(n) asm volatile("s_waitcnt vmcnt(" #n ")" ::: "memory")
#define PG8_WAIT_L(n) asm volatile("s_waitcnt lgkmcnt(" #n ")" ::: "memory")
#define PG8_BAR __builtin_amdgcn_s_barrier()
#define PG8_SCHED __builtin_amdgcn_sched_barrier(0)
    Unit cur, nxt; int ui = 0;
    if (!S.next(0, cur)) return;
    f32x4 acc[2][2][4][2];
#pragma unroll
    for (int a = 0; a < 2; ++a)
#pragma unroll
        for (int b = 0; b < 2; ++b)
#pragma unroll
            for (int m = 0; m < 4; ++m)
#pragma unroll
                for (int n = 0; n < 2; ++n) acc[a][b][m][n] = (f32x4){0.f, 0.f, 0.f, 0.f};
    bf16x8 At[4][2], B0[2][2], B1[2][2];
    const char* cA = (const char*)g.A + (size_t)cur.pm * tstepA + cur.aoff * 2; const char* cB = (const char*)g.Bt + (size_t)cur.pn * tstepB + cur.boff * 2;
    S.a_ready(cur);
    if constexpr (SP2) {
        PG8_STAGE(PG8_SB(0, 0), cB, voffB); PG8_STAGE(PG8_SB(0, 1), cB + hstepB, voffB); PG8_STAGE(PG8_SA(0, 0), cA, voffA); PG8_STAGE(PG8_SA(0, 1), cA + hstepA, voffA);
        if (wr == 1) PG8_BAR;
        PG8_WAIT_V(2); PG8_BAR;
        PG8_STAGE(PG8_SB(1, 0), cB + kstep, voffB); PG8_STAGE(PG8_SA(1, 0), cA + kstep, voffA); PG8_STAGE(PG8_SB(1, 1), cB + hstepB + kstep, voffB);
        PG8_WAIT_V(6); PG8_BAR;
    } else {
        PG8_STAGE(PG8_SB(0, 0), cB, voffB); PG8_STAGE(PG8_SA(0, 0), cA, voffA); PG8_STAGE(PG8_SB(0, 1), cB + hstepB, voffB); PG8_STAGE(PG8_SA(0, 1), cA + hstepA, voffA);
        if (wr == 1) PG8_BAR;
        PG8_WAIT_V(4); PG8_BAR;
        PG8_STAGE(PG8_SB(1, 0), cB + kstep, voffB); PG8_STAGE(PG8_SA(1, 0), cA + kstep, voffA); PG8_STAGE(PG8_SB(1, 1), cB + hstepB + kstep, voffB);
        PG8_WAIT_V(6); PG8_BAR;
    }
    for (;;) {
        const bool has_next = S.next(ui + 1, nxt);
        const char* nA = has_next ? (const char*)g.A + (size_t)nxt.pm * tstepA + nxt.aoff * 2 : cA; const char* nB = has_next ? (const char*)g.Bt + (size_t)nxt.pn * tstepB + nxt.boff * 2 : cB;
        for (int t = 0; t < nt; t += 2) {
            const bool last = (t == nt - 2);
            const char* a1 = cA + (size_t)(t + 1) * kstep;
            const char* a2 = last ? nA : cA + (size_t)(t + 2) * kstep; const char* b2 = last ? nB : cB + (size_t)(t + 2) * kstep;
            const char* a3 = a2 + kstep; const char* b3 = b2 + kstep;
            if (last && has_next) S.a_ready(nxt);
            if constexpr (SP2) {
            PG8_LDB(B0, 0, 0); PG8_LDB(B1, 0, 1); PG8_SCHED; PG8_LDA(At, 0, 0); PG8_STAGE(PG8_SA(1, 1), a1 + hstepA, voffA);
            PG8_WAIT_V(8); PG8_WAIT_L(0); PG8_BAR; PG8_MMA(0, 0, At, B0); PG8_MMA(0, 1, At, B1); PG8_BAR; PG8_SCHED;
            PG8_LDA(At, 0, 1); PG8_STAGE(PG8_SB(0, 0), b2, voffB); PG8_STAGE(PG8_SB(0, 1), b2 + hstepB, voffB); PG8_STAGE(PG8_SA(0, 0), a2, voffA);
            PG8_WAIT_V(8); PG8_WAIT_L(0); PG8_BAR; PG8_MMA(1, 0, At, B0); PG8_MMA(1, 1, At, B1); PG8_BAR; PG8_SCHED;
            PG8_LDB(B0, 1, 0); PG8_LDB(B1, 1, 1); PG8_SCHED; PG8_LDA(At, 1, 0); PG8_STAGE(PG8_SA(0, 1), a2 + hstepA, voffA);
            PG8_WAIT_V(8); PG8_WAIT_L(0); PG8_BAR; PG8_MMA(0, 0, At, B0); PG8_MMA(0, 1, At, B1); PG8_BAR; PG8_SCHED;
            PG8_LDA(At, 1, 1); PG8_STAGE(PG8_SB(1, 0), b3, voffB); PG8_STAGE(PG8_SB(1, 1), b3 + hstepB, voffB); PG8_STAGE(PG8_SA(1, 0), a3, voffA);
            PG8_WAIT_V(8); PG8_WAIT_L(0); PG8_BAR; PG8_MMA(1, 0, At, B0); PG8_MMA(1, 1, At, B1); PG8_BAR; PG8_SCHED;
            } else {
            PG8_LDB(B0, 0, 0); PG8_SCHED; PG8_LDA(At, 0, 0); PG8_STAGE(PG8_SA(1, 1), a1 + hstepA, voffA);
            PG8_WAIT_L(8); PG8_BAR; PG8_WAIT_L(0); PG8_MMA(0, 0, At, B0); PG8_BAR; PG8_SCHED;
            PG8_LDB(B1, 0, 1); PG8_STAGE(PG8_SB(0, 0), b2, voffB);
            PG8_BAR; PG8_WAIT_L(0); PG8_MMA(0, 1, At, B1); PG8_BAR;
            PG8_LDA(At, 0, 1); PG8_STAGE(PG8_SA(0, 0), a2, voffA);
            PG8_BAR; PG8_WAIT_L(0); PG8_MMA(1, 0, At, B0); PG8_BAR; PG8_SCHED;
            PG8_STAGE(PG8_SB(0, 1), b2 + hstepB, voffB);
            PG8_WAIT_V(6); PG8_BAR; PG8_MMA(1, 1, At, B1); PG8_BAR;
            PG8_LDB(B0, 1, 0); PG8_SCHED; PG8_LDA(At, 1, 0); PG8_STAGE(PG8_SA(0, 1), a2 + hstepA, voffA);
            PG8_WAIT_L(8); PG8_BAR; PG8_WAIT_L(0); PG8_MMA(0, 0, At, B0); PG8_BAR; PG8_SCHED;
            PG8_LDB(B1, 1, 1); PG8_STAGE(PG8_SB(1, 0), b3, voffB);
            PG8_BAR; PG8_WAIT_L(0); PG8_MMA(0, 1, At, B1); PG8_BAR;
            PG8_LDA(At, 1, 1); PG8_STAGE(PG8_SA(1, 0), a3, voffA);
            PG8_BAR; PG8_WAIT_L(0); PG8_MMA(1, 0, At, B0); PG8_BAR; PG8_SCHED;
            PG8_STAGE(PG8_SB(1, 1), b3 + hstepB, voffB);
            PG8_WAIT_V(6); PG8_BAR; PG8_MMA(1, 1, At, B1); PG8_BAR;
            }
        }
        if constexpr (F8) asm volatile("s_nop 15\n\ts_nop 15\n\ts_nop 15\n\ts_nop 15" ::: "memory");
        if constexpr (ALIGN_EPI) { if (wr == 0) PG8_BAR; }
        if constexpr (!Epi::AFTER_DRAIN) { E(acc, cur, wr, wc, fr, fq); S.done(cur); }
        if (!has_next) break;
#pragma unroll
        for (int a = 0; a < 2; ++a)
#pragma unroll
            for (int b = 0; b < 2; ++b)
#pragma unroll
                for (int m = 0; m < 4; ++m)
#pragma unroll
                    for (int n = 0; n < 2; ++n) acc[a][b][m][n] = (f32x4){0.f, 0.f, 0.f, 0.f};
        cur = nxt; cA = nA; cB = nB; ++ui;
        if constexpr (ALIGN_EPI) { if (wr == 1) PG8_BAR; }
    }
    PG8_WAIT_V(0);
    if constexpr (!ALIGN_EPI) { if (wr == 0) PG8_BAR; }
    PG8_BAR;
    if constexpr (Epi::AFTER_DRAIN) { E.fused(acc, cur, wr, wc, fr, fq, lds, wid, lane); S.done(cur); }
#undef PG8_SA
#undef PG8_SB
#undef PG8_STAGE
#undef PG8_LDA
#undef PG8_LDB
#undef PG8_MMA
#undef PG8_WAIT_V
#undef PG8_WAIT_L
#undef PG8_BAR
#undef PG8_SCHED
}
}

struct EpiStore {
    static constexpr bool PERM = true, AFTER_DRAIN = false;
    u16* O; int ldc; int act; const float* rs;
    float osc = 1.f;
    __device__ __forceinline__ void operator()(const pg8::f32x4 (&acc)[2][2][4][2], const pg8::Unit& u, int wr, int wc, int fr, int fq) const {
        int fr_ = fr, fq_ = fq; asm volatile("" : "+v"(fr_), "+v"(fq_));
        const int row0 = u.pm * 256 + wr * 64 + fr_;
        u16* base = O + u.coff + (size_t)(u.pm * 256) * ldc + u.pn * 256;
        const int loff0 = (wr * 64 + fr_) * ldc + wc * 32 + 8 * fq_;
#pragma unroll
        for (int ai = 0; ai < 2; ++ai)
#pragma unroll
            for (int m = 0; m < 4; ++m) { u16* rowp = base + (loff0 + (ai * 128 + m * 16) * ldc);
                const float rsc = rs ? rs[row0 + ai * 128 + m * 16] : osc;
#pragma unroll
                for (int bj = 0; bj < 2; ++bj) { pg8::f32x4 v0 = acc[ai][bj][m][0] * rsc, v1 = acc[ai][bj][m][1] * rsc;
                    if (act == 1) {
#pragma unroll
                        for (int r = 0; r < 4; ++r) { const float a = fmaxf(v0[r], 0.f), b = fmaxf(v1[r], 0.f); v0[r] = a * a; v1[r] = b * b; }
                    }
                    pg8::u32x4 w; w.x = pg8::cvt_pk_bf16(v0[0], v0[1]); w.y = pg8::cvt_pk_bf16(v0[2], v0[3]); w.z = pg8::cvt_pk_bf16(v1[0], v1[1]); w.w = pg8::cvt_pk_bf16(v1[2], v1[3]);
                    *(pg8::u32x4*)(rowp + bj * 128) = w; } }
    }
};
struct EpiStoreF8 {
    static constexpr bool PERM = true, AFTER_DRAIN = false;
    unsigned char* O; int ldc; const float* rs;
    __device__ __forceinline__ void operator()(const pg8::f32x4 (&acc)[2][2][4][2], const pg8::Unit& u, int wr, int wc, int fr, int fq) const {
        int fr_ = fr, fq_ = fq; asm volatile("" : "+v"(fr_), "+v"(fq_));
        const int row0 = u.pm * 256 + wr * 64 + fr_;
        unsigned char* base = O + (size_t)(u.pm * 256) * ldc + u.pn * 256;
        const int loff0 = (wr * 64 + fr_) * ldc + wc * 32 + 8 * fq_;
#pragma unroll
        for (int ai = 0; ai < 2; ++ai)
#pragma unroll
            for (int m = 0; m < 4; ++m) { unsigned char* rowp = base + (loff0 + (ai * 128 + m * 16) * ldc);
                const float rsc = rs[row0 + ai * 128 + m * 16] * 2.8284271247461903f;
#pragma unroll
                for (int bj = 0; bj < 2; ++bj) { pg8::f32x4 v0 = acc[ai][bj][m][0] * rsc, v1 = acc[ai][bj][m][1] * rsc;
#pragma unroll
                    for (int r = 0; r < 4; ++r) { const float a = fmaxf(v0[r], 0.f), b = fmaxf(v1[r], 0.f); v0[r] = fminf(a * a, 448.f); v1[r] = fminf(b * b, 448.f); }
                    int lo8 = __builtin_amdgcn_cvt_pk_fp8_f32(v0[0], v0[1], 0, false); lo8 = __builtin_amdgcn_cvt_pk_fp8_f32(v0[2], v0[3], lo8, true);
                    int hi8 = __builtin_amdgcn_cvt_pk_fp8_f32(v1[0], v1[1], 0, false); hi8 = __builtin_amdgcn_cvt_pk_fp8_f32(v1[2], v1[3], hi8, true);
                    uint2 w; w.x = (unsigned)lo8; w.y = (unsigned)hi8;
                    *(uint2*)(rowp + bj * 128) = w; } }
    }
};
template <int TYPE> struct PreOrder {
    int G, c, l;
    __device__ __forceinline__ bool next(int i, pg8::Unit& u) const {
        const int id = i * G + c; if (id >= 128) return false;
        const int pt = id & 3, h = (id >> 2) & 3, b = id >> 4;
        if (TYPE == 0) { u.pm = 0; u.pn = pt; u.aoff = (long)l * 2048 * 2048 + (long)(b * 256) * 2048 + h * 256; u.boff = (long)l * DM * DM + h * 256;
                         u.coff = ((long)b * 1024 + h * 256) * 1024; }
        else { u.pm = pt; u.pn = 0; u.aoff = (long)l * DM * DM + h * 256; u.boff = (long)l * 2048 * 2048 + (long)(b * 256) * 2048 + 1024 + h * 256;
               u.coff = (long)b * 1024 * 1024 + h * 256; }
        return true;
    }
    __device__ __forceinline__ void a_ready(const pg8::Unit&) const {}
    __device__ __forceinline__ void done(const pg8::Unit&) const {}
};
struct KvOrder {
    int G, c;
    __device__ __forceinline__ bool next(int i, pg8::Unit& u) const {
        const int id = i * G + c; if (id >= 128) return false;
        const int l = id >> 6, r = id & 63;
        u.pm = r >> 3; u.pn = r & 7; u.aoff = (long)l * 2048 * DM; u.boff = (long)l * 2048 * DM; u.coff = (long)l * 2048 * 2048; return true;
    }
    __device__ __forceinline__ void a_ready(const pg8::Unit&) const {}
    __device__ __forceinline__ void done(const pg8::Unit&) const {}
};
struct BatchBOrder : pg8::StaticOrder {
    __device__ __forceinline__ bool next(int i, pg8::Unit& u) const { if (!pg8::StaticOrder::next(i, u)) return false; u.boff = (long)(u.pm >> 4) * (1024 * 1024); return true; }
};
struct EpiSoftmax {
    static constexpr bool PERM = true, AFTER_DRAIN = false;
    u16* O; int ldc; const float* rs; PG8_LAS float* xl;
    __device__ __forceinline__ void operator()(pg8::f32x4 (&acc)[2][2][4][2], const pg8::Unit& u, int wr, int wc, int fr, int fq) const {
        int fr_ = fr, fq_ = fq; asm volatile("" : "+v"(fr_), "+v"(fq_));
        const int row0 = u.pm * 256 + wr * 64 + fr_;
        u16* base = O + (size_t)(u.pm * 256) * ldc + u.pn * 256;
        const int loff0 = (wr * 64 + fr_) * ldc + wc * 32 + 8 * fq_;
        float mown[2][4];
#pragma unroll
        for (int ai = 0; ai < 2; ++ai)
#pragma unroll
            for (int m = 0; m < 4; ++m) {
                const float rsc = rs[row0 + ai * 128 + m * 16] * (0.0625f * 1.4426950408889634f);
                float mx = -INFINITY;
#pragma unroll
                for (int bj = 0; bj < 2; ++bj)
#pragma unroll
                    for (int n = 0; n < 2; ++n) { acc[ai][bj][m][n] = acc[ai][bj][m][n] * rsc;
#pragma unroll
                        for (int r = 0; r < 4; ++r) mx = fmaxf(mx, acc[ai][bj][m][n][r]); }
                mx = fmaxf(mx, __shfl_xor(mx, 16)); mx = fmaxf(mx, __shfl_xor(mx, 32));
                float l = 0.f;
#pragma unroll
                for (int bj = 0; bj < 2; ++bj)
#pragma unroll
                    for (int n = 0; n < 2; ++n)
#pragma unroll
                        for (int r = 0; r < 4; ++r) { const float e = __builtin_amdgcn_exp2f(acc[ai][bj][m][n][r] - mx); acc[ai][bj][m][n][r] = e; l += e; }
                l += __shfl_xor(l, 16); l += __shfl_xor(l, 32);
                mown[ai][m] = mx;
                if (fq_ == 0) { PG8_LAS float* x = xl + ((ai * 128 + wr * 64 + m * 16 + fr_) * 4 + wc) * 2; x[0] = mx; x[1] = l; }
            }
        asm volatile("s_waitcnt lgkmcnt(0)" ::: "memory"); __builtin_amdgcn_s_barrier(); asm volatile("" ::: "memory");
#pragma unroll
        for (int ai = 0; ai < 2; ++ai)
#pragma unroll
            for (int m = 0; m < 4; ++m) {
                const PG8_LAS pg8::f32x4* x = (const PG8_LAS pg8::f32x4*)(xl + (ai * 128 + wr * 64 + m * 16 + fr_) * 8);
                const pg8::f32x4 x0 = x[0], x1 = x[1];
                const float M = fmaxf(fmaxf(x0[0], x0[2]), fmaxf(x1[0], x1[2]));
                const float L = x0[1] * __builtin_amdgcn_exp2f(x0[0] - M) + x0[3] * __builtin_amdgcn_exp2f(x0[2] - M) + x1[1] * __builtin_amdgcn_exp2f(x1[0] - M) + x1[3] * __builtin_amdgcn_exp2f(x1[2] - M);
                const float f = __builtin_amdgcn_exp2f(mown[ai][m] - M) / L;
                u16* rowp = base + (loff0 + (ai * 128 + m * 16) * ldc);
#pragma unroll
                for (int bj = 0; bj < 2; ++bj) { const pg8::f32x4 v0 = acc[ai][bj][m][0] * f, v1 = acc[ai][bj][m][1] * f;
                    pg8::u32x4 w; w.x = pg8::cvt_pk_bf16(v0[0], v0[1]); w.y = pg8::cvt_pk_bf16(v0[2], v0[3]); w.z = pg8::cvt_pk_bf16(v1[0], v1[1]); w.w = pg8::cvt_pk_bf16(v1[2], v1[3]);
                    *(pg8::u32x4*)(rowp + bj * 128) = w; }
            }
    }
};
struct EpiRope {
    static constexpr bool PERM = true, AFTER_DRAIN = false;
    u16* Z; u16* KB; u16* VB; u16* KI; const float* rs; const float2* rope;
    __device__ __forceinline__ void operator()(const pg8::f32x4 (&acc)[2][2][4][2], const pg8::Unit& u, int wr, int wc, int fr, int fq) const {
        int fr_ = fr, fq_ = fq; asm volatile("" : "+v"(fr_), "+v"(fq_));
#pragma unroll
        for (int ai = 0; ai < 2; ++ai)
#pragma unroll
            for (int m = 0; m < 4; ++m) {
                const int row = u.pm * 256 + ai * 128 + wr * 64 + m * 16 + fr_;
                const float rsc = rs[row];
#pragma unroll
                for (int bj = 0; bj < 2; ++bj) {
                    const int col = u.pn * 256 + bj * 128 + wc * 32 + 8 * fq_;
                    const pg8::f32x4 a0 = acc[ai][bj][m][0] * rsc, a1 = acc[ai][bj][m][1] * rsc;
                    float v[8] = {a0[0], a0[1], a0[2], a0[3], a1[0], a1[1], a1[2], a1[3]};
                    const bool is_v = (u.pn == 4 && bj == 1), is_tail = (u.pn == 7) && (bj == 1 || wc >= 2);
                    if (!is_v && !is_tail) {
                        const bool small = u.pn >= 5;
                        const int lc = small ? (col & 63) : (col & 127), i0 = lc >> 1;
                        const float2* tp = rope + (size_t)row * 64 + (small ? 2 * i0 : i0);
#pragma unroll
                        for (int e = 0; e < 4; ++e) {
                            const float2 cs = tp[small ? 2 * e : e];
                            const float x1 = v[2 * e], x2 = v[2 * e + 1];
                            v[2 * e] = x1 * cs.x - x2 * cs.y; v[2 * e + 1] = x2 * cs.x + x1 * cs.y;
                        }
                    }
                    pg8::u32x4 w; w.x = pg8::cvt_pk_bf16(v[0], v[1]); w.y = pg8::cvt_pk_bf16(v[2], v[3]); w.z = pg8::cvt_pk_bf16(v[4], v[5]); w.w = pg8::cvt_pk_bf16(v[6], v[7]);
                    if (u.pn < 4 || u.pn == 5 || u.pn == 6) *(pg8::u32x4*)(Z + (size_t)row * ZP1 + col) = w;
                    else if (u.pn == 4) { if (bj == 0) *(pg8::u32x4*)(KB + (size_t)row * 128 + (col - 1024)) = w; else *(pg8::u32x4*)(VB + (size_t)row * 128 + (col - 1152)) = w; }
                    else {
                        if (bj == 0 && wc < 2) { const int d = col - 1792, s = row & 4095, bb = row >> 12;
                            *(pg8::u32x4*)(KI + ((size_t)bb * 128 + (s >> 5)) * 2048 + ((d >> 4) * 2 + ((d >> 3) & 1)) * 256 + (s & 31) * 8) = w; }
                        else if (bj == 0 && wc == 2 && fq_ == 0) {
                            pg8::u32x4 ww; ww.x = pg8::cvt_pk_bf16(v[0] * 0.35355339059327373f, v[1] * 0.35355339059327373f); ww.y = pg8::cvt_pk_bf16(v[2] * 0.35355339059327373f, v[3] * 0.35355339059327373f);
                            ww.z = pg8::cvt_pk_bf16(v[4] * 0.35355339059327373f, v[5] * 0.35355339059327373f); ww.w = pg8::cvt_pk_bf16(v[6] * 0.35355339059327373f, v[7] * 0.35355339059327373f);
                            *(pg8::u32x4*)(Z + (size_t)row * ZP1 + 1856) = ww; }
                    }
                }
            }
    }
};
__device__ __forceinline__ void gemm8(const u16* A, const u16* Bt, int M, int N, int K, u16* C, int ldc, int act, const float* rs, unsigned char* smem) {
    pg8::Gemm g{A, Bt, M, N, K, K, K}; pg8::StaticOrder S; S.init(M, N, (int)gridDim.x, (int)blockIdx.x);
    EpiStore E{C, ldc, act, rs};
    pg8::gemm_phase<EpiStore, pg8::StaticOrder, true, true>((PG8_LAS unsigned char*)smem, g, S, E);
}

__device__ __forceinline__ int rope_col_perm(int n) {
    if (n < 1152) { const int d = n & 127; return (n & ~127) + 2 * (d & 63) + (d >> 6); }
    if (n < 1280 || n >= 1856) return n;
    const int d = (n - 1280) & 63; return n - d + 2 * (d & 31) + (d >> 5);
}
template <bool ROPE_PERM = false, bool F8 = false>
__device__ __forceinline__ void transpose_item(const float* W, int K, int N, u16* WT, LAS3 unsigned char* scr, int item, int lane, int nblk, const float* gain) {
    const int kb = item / nblk, nb = item % nblk, k0 = 64 * kb, n0 = 64 * nb;
    { const int kr = lane >> 4; int n = n0 + (lane & 15) * 4; if (n + 3 >= N) n = 0;
      const float* src = W + (size_t)(k0 + kr) * N + n;
#pragma unroll 1
      for (int i = 0; i < 16; ++i) { __builtin_amdgcn_global_load_lds((const unsigned*)src, (LAS3 unsigned*)(scr + i * 1040), 16, 0, 0); src += (size_t)4 * N; } }
    const int c = lane & 7;
    float gk[8];
#pragma unroll
    for (int e = 0; e < 8; ++e) gk[e] = F8 ? 256.f : (gain ? gain[k0 + 8 * c + e] : 1.f);
    asm volatile("s_waitcnt vmcnt(0)" ::: "memory");
#pragma unroll
    for (int j = 0; j < 8; ++j) { const int nn = (lane >> 3) + 8 * j;
        const LAS3 float* s = (const LAS3 float*)(scr + (2 * c) * 1040 + nn * 4);
        float v[8];
#pragma unroll
        for (int e = 0; e < 8; ++e) v[e] = *(const LAS3 float*)((const LAS3 unsigned char*)s + (e >> 2) * 1040 + (e & 3) * 256) * gk[e];
        if constexpr (F8) {
            int lo8 = __builtin_amdgcn_cvt_pk_fp8_f32(v[0], v[1], 0, false); lo8 = __builtin_amdgcn_cvt_pk_fp8_f32(v[2], v[3], lo8, true);
            int hi8 = __builtin_amdgcn_cvt_pk_fp8_f32(v[4], v[5], 0, false); hi8 = __builtin_amdgcn_cvt_pk_fp8_f32(v[6], v[7], hi8, true);
            uint2 o8; o8.x = (unsigned)lo8; o8.y = (unsigned)hi8;
            *(uint2*)((unsigned char*)WT + (size_t)(n0 + nn) * K + k0 + 8 * c) = o8;
        } else {
        uint4 o; o.x = pk2(v[0], v[1]); o.y = pk2(v[2], v[3]); o.z = pk2(v[4], v[5]); o.w = pk2(v[6], v[7]);
        if (n0 + nn >= N) o = make_uint4(0u, 0u, 0u, 0u);
        *(uint4*)(WT + (size_t)(ROPE_PERM ? rope_col_perm(n0 + nn) : (n0 + nn)) * K + k0 + 8 * c) = o; } }
    WAVE_SYNC();
}
__device__ __forceinline__ void weight_cast(const float* W, int K, int N, u16* out, const float* gain) {
    const int tid = tid_opaque(); const size_t gt = (size_t)blockIdx.x * NT + tid, gs = (size_t)gridDim.x * NT, tot = (size_t)K * N / 4;
    for (size_t i = gt; i < tot; i += gs) {
        const float4 v = ((const float4*)W)[i]; const float gk = gain[(i * 4) / N];
        uint2 o; o.x = pk2(v.x * gk, v.y * gk); o.y = pk2(v.z * gk, v.w * gk);
        ((uint2*)out)[i] = o;
    }
}
template <bool ROPE_PERM = false, bool F8 = false>
__device__ __forceinline__ void weight_prep(const float* W, int K, int N, int Npad, u16* WT, unsigned char* smem, const float* gain = nullptr) {
    const int tid = tid_opaque(), lane = tid & 63, wid = tid >> 6, gw = (blockIdx.x * NT + tid) >> 6, ngw = (gridDim.x * NT) >> 6;
    LAS3 unsigned char* scr = (LAS3 unsigned char*)smem + wid * 16640;
    const int nblk = Npad / 64, items = (K / 64) * nblk;
    for (int it = gw; it < items; it += ngw) transpose_item<ROPE_PERM, F8>(W, K, N, WT, scr, it, lane, nblk, gain);
}

typedef float f32x16 __attribute__((ext_vector_type(16)));
typedef short s16x4 __attribute__((ext_vector_type(4)));
typedef unsigned u32x4v __attribute__((ext_vector_type(4)));
constexpr int XK_PITCH = 528, XV_PITCH = 576;
__device__ __forceinline__ s16x4 lds_tr16(unsigned addr) {
    return __builtin_bit_cast(s16x4, __builtin_amdgcn_ds_read_tr16_b64_v4i16((LAS3 s16x4*)(uintptr_t)addr));
}

__device__ __forceinline__ float gelu_fast(float x) {
    const float u = 0.7978845608028654f * (x + 0.044715f * x * x * x);
    return x * __builtin_amdgcn_rcpf(1.f + __builtin_amdgcn_exp2f(-2.8853900817779268f * u));
}
constexpr int MV_PITCH = 320, MP_PITCH = 272;
__device__ __forceinline__ void mixer_a_all(const Params& p, unsigned char* smem) {
    const int tid = tid_opaque(), lane = tid & 63, wid = __builtin_amdgcn_readfirstlane(tid >> 6), r32 = lane & 31, hi = lane >> 5, l15 = lane & 15, g4 = lane >> 4;
    LAS3 unsigned char* lds = (LAS3 unsigned char*)smem;
    const unsigned lds0 = (unsigned)(uintptr_t)lds;
    const u16* Z = (const u16*)(p.ws + WS_Z); u16* MIX = (u16*)(p.ws + WS_MIX);
    const int ct = wid & 3, tb0 = wid >> 2;
    int unit = blockIdx.x;
    if (unit >= 1024) return;
    u32x4v vraw[4];
#pragma unroll
    for (int i = 0; i < 4; ++i) vraw[i] = *(const u32x4v*)(Z + ((size_t)(unit >> 2) * 128 + wid * 16 + 4 * i + g4) * EVEN_IN + 512 + (unit & 3) * 128 + l15 * 8);
    int gcur = -1;
    bf16x8 wfr[2][8]; float4 ga, gb; float biasj[2];
#pragma unroll 1
    for (; unit < 1024; unit += gridDim.x) {
    const int g = unit & 3, bn = unit >> 2;
    const size_t row0 = (size_t)bn * 128;
    if (g != gcur) {
        gcur = g;
        const u16* Wc = (const u16*)(p.ws + WS_WC) + (size_t)g * 16384;
#pragma unroll
        for (int j = 0; j < 2; ++j)
#pragma unroll
            for (int ks = 0; ks < 8; ++ks) wfr[j][ks] = *(const bf16x8*)(Wc + (32 * (tb0 + 2 * j) + r32) * 128 + 16 * ks + 8 * hi);
        ga = *(const float4*)(p.sgu_g + g * 128 + l15 * 8); gb = *(const float4*)(p.sgu_g + g * 128 + l15 * 8 + 4);
#pragma unroll
        for (int j = 0; j < 2; ++j) biasj[j] = p.sgu_bs[g * 128 + 32 * (tb0 + 2 * j) + r32];
    }
    uint2 uraw[2][4];
#pragma unroll
    for (int j = 0; j < 2; ++j) {
        const int t = 32 * (tb0 + 2 * j) + r32;
#pragma unroll
        for (int rq = 0; rq < 4; ++rq) uraw[j][rq] = *(const uint2*)(Z + (row0 + t) * EVEN_IN + g * 128 + 32 * ct + 4 * hi + 8 * rq);
    }
    __syncthreads();
    {
#pragma unroll
        for (int i = 0; i < 4; ++i) {
            const int s = wid * 16 + 4 * i + g4;
            const u32x4v w = vraw[i];
            const float a0 = gelu_fast(bflo(w.x)), a1 = gelu_fast(bfhi(w.x)), a2 = gelu_fast(bflo(w.y)), a3 = gelu_fast(bfhi(w.y)),
                        a4 = gelu_fast(bflo(w.z)), a5 = gelu_fast(bfhi(w.z)), a6 = gelu_fast(bflo(w.w)), a7 = gelu_fast(bfhi(w.w));
            const float rstd = rsqrtf(rsum16(a0 * a0 + a1 * a1 + a2 * a2 + a3 * a3 + a4 * a4 + a5 * a5 + a6 * a6 + a7 * a7) * (1.f / 128.f) + EPS);
            u32x4v o;
            o.x = pk2hw(a0 * rstd * ga.x, a1 * rstd * ga.y); o.y = pk2hw(a2 * rstd * ga.z, a3 * rstd * ga.w);
            o.z = pk2hw(a4 * rstd * gb.x, a5 * rstd * gb.y); o.w = pk2hw(a6 * rstd * gb.z, a7 * rstd * gb.w);
            *(LAS3 u32x4v*)(lds + s * MV_PITCH + l15 * 16) = o;
        }
    }
    { const int un = unit + (int)gridDim.x;
      if (un < 1024) {
#pragma unroll
          for (int i = 0; i < 4; ++i) vraw[i] = *(const u32x4v*)(Z + ((size_t)(un >> 2) * 128 + wid * 16 + 4 * i + g4) * EVEN_IN + 512 + (un & 3) * 128 + l15 * 8);
      } }
    __syncthreads();
    f32x16 acc[2];
#pragma unroll
    for (int j = 0; j < 2; ++j)
#pragma unroll
        for (int r = 0; r < 16; ++r) acc[j][r] = 0.f;
    const unsigned va = lds0 + (8 * hi + (l15 >> 2)) * MV_PITCH + (32 * ct + 16 * (g4 & 1) + 4 * (l15 & 3)) * 2;
#pragma unroll
    for (int ks = 0; ks < 8; ++ks) {
        const s16x4 lo = lds_tr16(va + 16 * ks * MV_PITCH), hh = lds_tr16(va + (16 * ks + 4) * MV_PITCH);
        const bf16x8 vf = (bf16x8){lo[0], lo[1], lo[2], lo[3], hh[0], hh[1], hh[2], hh[3]};
#pragma unroll
        for (int j = 0; j < 2; ++j) acc[j] = __builtin_amdgcn_mfma_f32_32x32x16_bf16(vf, wfr[j][ks], acc[j], 0, 0, 0);
    }
#pragma unroll
    for (int j = 0; j < 2; ++j) {
        const int t = 32 * (tb0 + 2 * j) + r32;
        const float bias = biasj[j];
        u16* o = MIX + (row0 + t) * DM + g * 128 + 32 * ct + 4 * hi;
#pragma unroll
        for (int rq = 0; rq < 4; ++rq) {
            const uint2 uw = uraw[j][rq];
            uint2 ow;
            ow.x = pk2(gelu_fast(bflo(uw.x)) * (acc[j][4 * rq + 0] + bias), gelu_fast(bfhi(uw.x)) * (acc[j][4 * rq + 1] + bias));
            ow.y = pk2(gelu_fast(bflo(uw.y)) * (acc[j][4 * rq + 2] + bias), gelu_fast(bfhi(uw.y)) * (acc[j][4 * rq + 3] + bias));
            *(uint2*)(o + 8 * rq) = ow;
        }
    }
    }
}
__device__ __forceinline__ void mixer_b_all(const Params& p, unsigned char* smem) {
    const int tid = tid_opaque(), lane = tid & 63, wid = __builtin_amdgcn_readfirstlane(tid >> 6), r32 = lane & 31, hi = lane >> 5;
    LAS3 unsigned char* lds = (LAS3 unsigned char*)smem;
    LAS3 unsigned char* Ps = lds + 144 * 256;
    const u16* Z = (const u16*)(p.ws + WS_Z); u16* MIX = (u16*)(p.ws + WS_MIX);
    const int dt = wid & 3, tb0 = wid >> 2;
    int unit = (int)blockIdx.x;
    while (unit < 1024) unit += (int)gridDim.x;
    unit -= 1024;
    if (unit >= 1024) return;
    u32x4v hraw[5];
#define MIXB_LOAD_HALO(UN) { const int g_ = (UN) & 3, bn_ = (UN) >> 2, n_ = bn_ & 31; \
        _Pragma("unroll") for (int i = 0; i < 5; ++i) { \
            const int idx = tid + NT * i, r = idx >> 4, c16 = idx & 15; const int tt = n_ * 128 - 16 + r; \
            hraw[i] = (u32x4v){0u, 0u, 0u, 0u}; \
            if (idx < 144 * 16 && tt >= 0) hraw[i] = *(const u32x4v*)(Z + ((size_t)bn_ * 128 - 16 + r) * EVEN_IN + 1024 + g_ * 128 + c16 * 8); } }
    MIXB_LOAD_HALO(unit)
    int gcur = -1;
    bf16x8 pfr[8]; float4 psc[4];
#pragma unroll 1
    for (; unit < 1024; unit += gridDim.x) {
    const int g = unit & 3, bn = unit >> 2, n = bn & 31;
    const size_t row0 = (size_t)bn * 128;
    const int w = 2 << g;
    if (g != gcur) {
        gcur = g;
        const u16* pwT = (const u16*)(p.ws + WS_PWT) + (size_t)g * 16384;
#pragma unroll
        for (int ks = 0; ks < 8; ++ks) pfr[ks] = *(const bf16x8*)(pwT + (32 * dt + r32) * 128 + 16 * ks + 8 * hi);
#pragma unroll
        for (int rq = 0; rq < 4; ++rq) psc[rq] = *(const float4*)(p.pool_scale + g * 128 + 32 * dt + 4 * hi + 8 * rq);
    }
    __syncthreads();
#pragma unroll
    for (int i = 0; i < 5; ++i) {
        const int idx = tid + NT * i, r = idx >> 4, c16 = idx & 15;
        if (idx < 144 * 16) *(LAS3 u32x4v*)(lds + r * 256 + c16 * 16) = hraw[i];
    }
    { const int un = unit + (int)gridDim.x; if (un < 1024) MIXB_LOAD_HALO(un) }
    __syncthreads();
#pragma unroll
    for (int i = 0; i < 4; ++i) {
        const int idx = tid + NT * i, t = idx >> 4, c16 = idx & 15; const int tt = n * 128 + t;
        const int cnt = (tt + 1 < w) ? (tt + 1) : w;
        float s[8];
#pragma unroll
        for (int e = 0; e < 8; ++e) s[e] = 0.f;
        u32x4v x0 = (u32x4v){0u, 0u, 0u, 0u};
        for (int k = 0; k < w; ++k) {
            const u32x4v v = *(const LAS3 u32x4v*)(lds + (16 + t - k) * 256 + c16 * 16);
            if (k == 0) x0 = v;
            s[0] += bflo(v.x); s[1] += bfhi(v.x); s[2] += bflo(v.y); s[3] += bfhi(v.y); s[4] += bflo(v.z); s[5] += bfhi(v.z); s[6] += bflo(v.w); s[7] += bfhi(v.w);
        }
        const float ic = 1.f / (float)cnt;
        u32x4v o;
        o.x = pk2(s[0] * ic - bflo(x0.x), s[1] * ic - bfhi(x0.x)); o.y = pk2(s[2] * ic - bflo(x0.y), s[3] * ic - bfhi(x0.y));
        o.z = pk2(s[4] * ic - bflo(x0.z), s[5] * ic - bfhi(x0.z)); o.w = pk2(s[6] * ic - bflo(x0.w), s[7] * ic - bfhi(x0.w));
        *(LAS3 u32x4v*)(Ps + t * MP_PITCH + c16 * 16) = o;
    }
    __syncthreads();
    f32x16 acc[2];
#pragma unroll
    for (int j = 0; j < 2; ++j)
#pragma unroll
        for (int r = 0; r < 16; ++r) acc[j][r] = 0.f;
#pragma unroll
    for (int ks = 0; ks < 8; ++ks)
#pragma unroll
        for (int j = 0; j < 2; ++j) {
            const bf16x8 bfrag = *(const LAS3 bf16x8*)(Ps + (32 * (tb0 + 2 * j) + r32) * MP_PITCH + (16 * ks + 8 * hi) * 2);
            acc[j] = __builtin_amdgcn_mfma_f32_32x32x16_bf16(pfr[ks], bfrag, acc[j], 0, 0, 0);
        }
#pragma unroll
    for (int j = 0; j < 2; ++j) {
        const int t = 32 * (tb0 + 2 * j) + r32;
        u16* o = MIX + (row0 + t) * DM + 512 + g * 128 + 32 * dt + 4 * hi;
#pragma unroll
        for (int rq = 0; rq < 4; ++rq) {
            const float4 s4 = psc[rq];
            uint2 ow; ow.x = pk2(acc[j][4 * rq + 0] * s4.x, acc[j][4 * rq + 1] * s4.y); ow.y = pk2(acc[j][4 * rq + 2] * s4.z, acc[j][4 * rq + 3] * s4.w);
            *(uint2*)(o + 8 * rq) = ow;
        }
    }
    }
#undef MIXB_LOAD_HALO
}

__device__ __forceinline__ void xattn_phase(const Params& p, int layer, unsigned char* smem) {
    LAS3 unsigned char* lds = (LAS3 unsigned char*)smem;
    const unsigned lds0 = (unsigned)(uintptr_t)lds;
    const u16* Q = (const u16*)(p.ws + WS_Q); const u16* KV = (const u16*)(p.ws + WS_KV) + (size_t)layer * 2048 * 2048;
    u16* MIX = (u16*)(p.ws + WS_MIX);
    for (int unit = blockIdx.x; unit < 512; unit += gridDim.x) {
        int tid = threadIdx.x; asm volatile("" : "+v"(tid));
        const int lane = tid & 63, wid = tid >> 6, r32 = lane & 31, hi = lane >> 5;
        const int qb = unit & 15, h = (unit >> 4) & 3, b = unit >> 6;
        const int m0 = b * SEQ + qb * 256 + wid * 32;
        bf16x8 qf[8];
        const u16* qrow = Q + (size_t)(m0 + r32) * DM + h * 256 + hi * 8;
#pragma unroll
        for (int ks = 0; ks < 8; ++ks) qf[ks] = *(const bf16x8*)(qrow + ks * 16);
        __syncthreads();
#pragma unroll 4
        for (int i = 0; i < 16; ++i) { const int idx = tid + 512 * i, key = idx >> 5, c = idx & 31;
            const u32x4v v = *(const u32x4v*)(KV + (size_t)(b * 256 + key) * 2048 + h * 256 + c * 8);
            *(LAS3 u32x4v*)(lds + key * XK_PITCH + c * 16) = v; }
        __syncthreads();
        f32x16 st[8];
#pragma unroll
        for (int kt = 0; kt < 8; ++kt)
#pragma unroll
            for (int r = 0; r < 16; ++r) st[kt][r] = 0.f;
#pragma unroll
        for (int dh = 0; dh < 2; ++dh) {
            if (dh == 1) {
                asm volatile("" ::: "memory");
#pragma unroll
                for (int ks = 0; ks < 8; ++ks) qf[ks] = *(const bf16x8*)(qrow + 128 + ks * 16);
            }
#pragma unroll
            for (int ks = 0; ks < 8; ++ks)
#pragma unroll
                for (int kt = 0; kt < 8; ++kt) {
                    const bf16x8 kf = *(const LAS3 bf16x8*)(lds + (32 * kt + r32) * XK_PITCH + (2 * (dh * 8 + ks) + hi) * 16);
                    st[kt] = __builtin_amdgcn_mfma_f32_32x32x16_bf16(kf, qf[ks], st[kt], 0, 0, 0);
                }
            asm volatile("" ::: "memory");
        }
        float mx = -INFINITY;
#pragma unroll
        for (int kt = 0; kt < 8; ++kt)
#pragma unroll
            for (int r = 0; r < 16; ++r) mx = fmaxf(mx, st[kt][r]);
        mx = fmaxf(mx, __shfl_xor(mx, 32));
        const float cs = 0.0625f * 1.4426950408889634f;
        float sum = 0.f; unsigned pk[8][8];
#pragma unroll
        for (int kt = 0; kt < 8; ++kt)
#pragma unroll
            for (int r = 0; r < 8; ++r) {
                const float p0 = exp2f((st[kt][2 * r] - mx) * cs), p1 = exp2f((st[kt][2 * r + 1] - mx) * cs);
                sum += p0 + p1; pk[kt][r] = pk2(p0, p1);
            }
        sum += __shfl_xor(sum, 32);
        const float inv = 1.f / sum;
        __syncthreads();
#pragma unroll 4
        for (int i = 0; i < 16; ++i) { const int idx = tid + 512 * i, key = idx >> 5, c = idx & 31;
            const u32x4v v = *(const u32x4v*)(KV + (size_t)(b * 256 + key) * 2048 + 1024 + h * 256 + c * 8);
            *(LAS3 u32x4v*)(lds + key * XV_PITCH + c * 16) = v; }
        __syncthreads();
        const unsigned vbase = lds0 + (4 * hi + ((lane & 15) >> 2)) * XV_PITCH + (2 * ((lane >> 4) & 1) + ((lane & 3) >> 1)) * 16 + 8 * (lane & 1);
#pragma unroll
        for (int half = 0; half < 2; ++half) {
            f32x16 o[4];
#pragma unroll
            for (int dt = 0; dt < 4; ++dt)
#pragma unroll
                for (int r = 0; r < 16; ++r) o[dt][r] = 0.f;
#pragma unroll
            for (int kt = 0; kt < 8; ++kt)
#pragma unroll
                for (int s = 0; s < 2; ++s) {
                    bf16x8 pf;
                    { const unsigned w0 = pk[kt][4 * s + 0], w1 = pk[kt][4 * s + 1], w2 = pk[kt][4 * s + 2], w3 = pk[kt][4 * s + 3];
                      pf[0] = (short)(w0 & 0xffff); pf[1] = (short)(w0 >> 16); pf[2] = (short)(w1 & 0xffff); pf[3] = (short)(w1 >> 16);
                      pf[4] = (short)(w2 & 0xffff); pf[5] = (short)(w2 >> 16); pf[6] = (short)(w3 & 0xffff); pf[7] = (short)(w3 >> 16); }
#pragma unroll
                    for (int dt = 0; dt < 4; ++dt) {
                        const unsigned a1 = vbase + (32 * kt + 16 * s) * XV_PITCH + (half * 4 + dt) * 64;
                        const s16x4 lo = lds_tr16(a1), hh = lds_tr16(a1 + 8 * XV_PITCH);
                        const bf16x8 vf = (bf16x8){lo[0], lo[1], lo[2], lo[3], hh[0], hh[1], hh[2], hh[3]};
                        o[dt] = __builtin_amdgcn_mfma_f32_32x32x16_bf16(vf, pf, o[dt], 0, 0, 0);
                    }
                }
            u16* orow = MIX + (size_t)(m0 + r32) * DM + h * 256 + 4 * hi;
#pragma unroll
            for (int dt = 0; dt < 4; ++dt)
#pragma unroll
                for (int rq = 0; rq < 4; ++rq) {
                    uint2 w; w.x = pk2(o[dt][4 * rq + 0] * inv, o[dt][4 * rq + 1] * inv); w.y = pk2(o[dt][4 * rq + 2] * inv, o[dt][4 * rq + 3] * inv);
                    *(uint2*)(orow + 32 * (half * 4 + dt) + 8 * rq) = w;
                }
        }
    }
}

__device__ __forceinline__ void rope_phase(const Params& p) {
    const int tid = tid_opaque(), lane = tid & 63, gw = (blockIdx.x * NT + tid) >> 6, ngw = (gridDim.x * NT) >> 6;
    u16* Z = (u16*)(p.ws + WS_Z); const float2* rope = (const float2*)(p.ws + WS_ROPE);
    u16* KB = (u16*)(p.ws + WS_KB); u16* VB = (u16*)(p.ws + WS_VB); u16* KI = (u16*)(p.ws + WS_KI);
    for (int m = gw; m < T; m += ngw) {
        u16* zr = Z + (size_t)m * ZP1;
        const float2 cs = rope[(size_t)m * 64 + lane];
#pragma unroll
        for (int hd = 0; hd < 8; ++hd) {
            const float x1 = bf2f(zr[hd * 128 + lane]), x2 = bf2f(zr[hd * 128 + 64 + lane]);
            zr[hd * 128 + lane] = f2bf(x1 * cs.x - x2 * cs.y); zr[hd * 128 + 64 + lane] = f2bf(x2 * cs.x + x1 * cs.y);
        }
        { const float x1 = bf2f(zr[1024 + lane]), x2 = bf2f(zr[1088 + lane]);
          KB[(size_t)m * 128 + lane] = f2bf(x1 * cs.x - x2 * cs.y); KB[(size_t)m * 128 + 64 + lane] = f2bf(x2 * cs.x + x1 * cs.y); }
        *(unsigned*)(VB + (size_t)m * 128 + 2 * lane) = *(const unsigned*)(zr + 1152 + 2 * lane);
#pragma unroll
        for (int i = 0; i < 4; ++i) {
            const int pp = lane + 64 * i, hd = pp >> 5, jj = pp & 31;
            const float2 c2 = rope[(size_t)m * 64 + 2 * jj];
            const float x1 = bf2f(zr[1280 + hd * 64 + jj]), x2 = bf2f(zr[1280 + hd * 64 + 32 + jj]);
            zr[1280 + hd * 64 + jj] = f2bf(x1 * c2.x - x2 * c2.y); zr[1280 + hd * 64 + 32 + jj] = f2bf(x2 * c2.x + x1 * c2.y);
        }
        if (lane < 32) {
            const float2 c2 = rope[(size_t)m * 64 + 2 * lane];
            const float x1 = bf2f(zr[1792 + lane]), x2 = bf2f(zr[1824 + lane]);
            const int s = m & 4095, bb = m >> 12;
            u16* kt = KI + ((size_t)bb * 128 + (s >> 5)) * 2048 + (s & 31) * 8;
            const int d1 = lane, d2 = lane + 32;
            kt[((d1 >> 4) * 2 + ((d1 >> 3) & 1)) * 256 + (d1 & 7)] = f2bf(x1 * c2.x - x2 * c2.y);
            kt[((d2 >> 4) * 2 + ((d2 >> 3) & 1)) * 256 + (d2 & 7)] = f2bf(x2 * c2.x + x1 * c2.y);
        }
        if (lane < 8) zr[1856 + lane] = f2bf(bf2f(zr[1856 + lane]) * 0.35355339059327373f);
    }
}

typedef float f32x4v __attribute__((ext_vector_type(4)));
constexpr int VB_PITCH = 288, KB_PITCH = 272, CAND_CAP = 256, NBIN = 512;
__device__ __forceinline__ int score_bin(float sc) { const int b = (int)floorf(sc * 64.f) + 256; return b < 0 ? 0 : (b > 511 ? 511 : b); }
__device__ __forceinline__ unsigned minkey_for_bin(int B) {
    if (B <= 0) return 0u;
    const unsigned f = __float_as_uint((float)(B - 256) * 0.015625f);
    return (f & 0x80000000u) ? ~f : (f | 0x80000000u);
}
#define ZERO_HIST(h, ln) do { _Pragma("unroll") for (int z_ = 0; z_ < 8; ++z_) (h)[(ln) * 8 + z_] = 0u; } while (0)
__device__ __forceinline__ int wave_iscan(int v) {
    v += __builtin_amdgcn_update_dpp(0, v, 0x111, 0xf, 0xf, false);
    v += __builtin_amdgcn_update_dpp(0, v, 0x112, 0xf, 0xf, false);
    v += __builtin_amdgcn_update_dpp(0, v, 0x114, 0xf, 0xf, false);
    v += __builtin_amdgcn_update_dpp(0, v, 0x118, 0xf, 0xf, false);
    v += __builtin_amdgcn_update_dpp(0, v, 0x142, 0xa, 0xf, false);
    v += __builtin_amdgcn_update_dpp(0, v, 0x143, 0xc, 0xf, false);
    return v;
}
__device__ __forceinline__ float relu_i(float x) { const int b = __float_as_int(x); return __int_as_float(b > 0 ? b : 0); }
__device__ __forceinline__ void dsa_phase(const Params& p, unsigned char* smem) {
    LAS3 unsigned char* lds = (LAS3 unsigned char*)smem;
    const u16* Z = (const u16*)(p.ws + WS_Z); u16* MIX = (u16*)(p.ws + WS_MIX);
    const u16* KB = (const u16*)(p.ws + WS_KB); const u16* VB = (const u16*)(p.ws + WS_VB); const u16* KI = (const u16*)(p.ws + WS_KI);
    { const int t0_ = tid_opaque(); LAS3 unsigned* h0 = (LAS3 unsigned*)(lds + 131072 + (t0_ >> 6) * 3072 + 512);
      ZERO_HIST(h0, t0_ & 63);
      if (t0_ < 2) ((LAS3 unsigned*)(lds + LDS_CTL_OFF))[12 + t0_] = 0u; }
    __syncthreads();
    unsigned gtarget = 0u;
#define GROUP_BARRIER() do { gtarget += 4u; asm volatile("s_waitcnt lgkmcnt(0)" ::: "memory");                                                        \
        if (lane == 0) __hip_atomic_fetch_add(gctr, 1u, __ATOMIC_RELAXED, __HIP_MEMORY_SCOPE_WORKGROUP);                                                 \
        while (__hip_atomic_load(gctr, __ATOMIC_RELAXED, __HIP_MEMORY_SCOPE_WORKGROUP) < gtarget) __builtin_amdgcn_s_sleep(1);                            \
        asm volatile("" ::: "memory"); } while (0)
    const int cntU = (4096 - (int)blockIdx.x + (int)gridDim.x - 1) / (int)gridDim.x;
    for (int it = 0; it < cntU; ++it) {
        const int tid = tid_opaque(), lane = tid & 63, wid = __builtin_amdgcn_readfirstlane(tid >> 6);
        const int grp = wid >> 2, gw = wid & 3;
        const int U = (int)blockIdx.x + (grp ? cntU - 1 - it : it) * (int)gridDim.x;
        LAS3 unsigned* gctr = (LAS3 unsigned*)(lds + LDS_CTL_OFF) + 12 + grp;
        const int r32 = lane & 31, hi = lane >> 5, l15 = lane & 15, g4 = lane >> 4;
        LAS3 unsigned* sck_all = (LAS3 unsigned*)lds;
        LAS3 unsigned* sck = sck_all + wid * 4096;
        LAS3 unsigned char* aux = lds + 131072 + wid * 3072;
        LAS3 u16* idx = (LAS3 u16*)aux; LAS3 unsigned* hist = (LAS3 unsigned*)(aux + 512); LAS3 u16* cand = (LAS3 u16*)(aux + 2560);
        LAS3 unsigned char* vbuf = (LAS3 unsigned char*)sck;
        const unsigned vb0 = (unsigned)(uintptr_t)vbuf + (4 * g4 + (l15 >> 2)) * VB_PITCH + 8 * (l15 & 3);
        const unsigned long long lt_mask = (lane == 0) ? 0ull : (~0ull >> (64 - lane));
        const int uj = U >> 8, uc = U & 255, b = uc & 7, uy = uc >> 3;
        const int t0 = 8 * (32 * uj + ((uj & 1) ? 31 - uy : uy));
        const int t0g = t0 + 4 * grp;
        const size_t brow = (size_t)b * SEQ;
        bf16x8 qif[4]; uint2 wqw[4];
        {   const int tq0 = (t0g >= 256) ? t0g : 256;
            const u16* zr = Z + (brow + tq0 + (r32 >> 3)) * ZP1 + 1280 + (r32 & 7) * 64 + 8 * hi;
#pragma unroll
            for (int ks = 0; ks < 4; ++ks) qif[ks] = *(const bf16x8*)(zr + 16 * ks);
#pragma unroll
            for (int qq = 0; qq < 4; ++qq) wqw[qq] = *(const uint2*)(Z + (brow + tq0 + qq) * ZP1 + 1856 + 4 * hi);
        }
        GROUP_BARRIER();
        if (t0 >= 256) {
            float wq[16];
#pragma unroll
            for (int qq = 0; qq < 4; ++qq) {
                const uint2 w = wqw[qq];
                wq[4 * qq + 0] = 0.125f * bflo(w.x); wq[4 * qq + 1] = 0.125f * bfhi(w.x);
                wq[4 * qq + 2] = 0.125f * bflo(w.y); wq[4 * qq + 3] = 0.125f * bfhi(w.y);
            }
            const int ntile = (t0g + 4 + 31) >> 5;
            bf16x8 kif[4], kn1[4];
            {
                const u16* kr = KI + ((size_t)b * 128 + gw) * 2048 + hi * 256 + r32 * 8;
#pragma unroll
                for (int ks = 0; ks < 4; ++ks) kif[ks] = *(const bf16x8*)(kr + 512 * ks);
                const int kt1 = (gw + 4 < ntile) ? gw + 4 : gw;
                const u16* kr1 = KI + ((size_t)b * 128 + kt1) * 2048 + hi * 256 + r32 * 8;
#pragma unroll
                for (int ks = 0; ks < 4; ++ks) kn1[ks] = *(const bf16x8*)(kr1 + 512 * ks);
            }
            for (int kt = gw; kt < ntile; kt += 4) {
                bf16x8 kin[4];
                { const int ktn = (kt + 8 < ntile) ? kt + 8 : kt;
                  const u16* kr = KI + ((size_t)b * 128 + ktn) * 2048 + hi * 256 + r32 * 8;
#pragma unroll
                  for (int ks = 0; ks < 4; ++ks) kin[ks] = *(const bf16x8*)(kr + 512 * ks); }
                f32x16 c0;
#pragma unroll
                for (int r = 0; r < 16; ++r) c0[r] = 0.f;
#pragma unroll
                for (int ks = 0; ks < 4; ++ks) c0 = __builtin_amdgcn_mfma_f32_32x32x16_bf16(qif[ks], kif[ks], c0, 0, 0, 0);
#pragma unroll
                for (int pr = 0; pr < 2; ++pr) {
                    float pa = 0.f, pb = 0.f;
#pragma unroll
                    for (int e = 0; e < 4; ++e) { pa = fmaf(relu_i(c0[8 * pr + e]), wq[8 * pr + e], pa); pb = fmaf(relu_i(c0[8 * pr + 4 + e]), wq[8 * pr + 4 + e], pb); }
                    const auto rr = __builtin_amdgcn_permlane32_swap(__float_as_uint(pa), __float_as_uint(pb), false, false);
                    const float sc = (__uint_as_float(rr[0]) + __uint_as_float(rr[1])) + 0.0f;
                    unsigned u = __float_as_uint(sc);
                    u = (u & 0x80000000u) ? ~u : (u | 0x80000000u);
                    const int qg = 2 * pr + hi;
                    sck_all[(4 * grp + qg) * 4096 + 32 * kt + r32] = u;
                    if (32 * kt + 31 <= t0g || 32 * kt + r32 <= t0g + qg)
                        __hip_atomic_fetch_add((LAS3 unsigned*)(lds + 131072 + (4 * grp + qg) * 3072 + 512) + score_bin(sc), 1u, __ATOMIC_RELAXED, __HIP_MEMORY_SCOPE_WORKGROUP);
                }
#pragma unroll
                for (int ks = 0; ks < 4; ++ks) { kif[ks] = kn1[ks]; kn1[ks] = kin[ks]; }
            }
        }
        GROUP_BARRIER();
        const int t = t0 + wid, n = t + 1;
        const size_t m = brow + t;
        bf16x8 qf[4];
#pragma unroll
        for (int ks = 0; ks < 4; ++ks) {
            qf[ks] = (bf16x8){0, 0, 0, 0, 0, 0, 0, 0};
            if (l15 < 8) qf[ks] = *(const bf16x8*)(Z + m * ZP1 + l15 * 128 + 32 * ks + 8 * g4);
        }
        int count;
        for (int rep_t = 0; rep_t < (DSA_DUP == 2 ? 2 : 1); ++rep_t)
        if (n <= 256) {
            count = n;
            for (int j = lane; j < 256; j += 64) idx[j] = (u16)(j < n ? j : 0);
        } else {
            count = 256;
            int bdig, bwant, bcnt;
            {
                int cb_[8]; int tot = 0;
                { const u32x4v h0v = *(const LAS3 u32x4v*)(hist + lane * 8), h1v = *(const LAS3 u32x4v*)(hist + lane * 8 + 4);
                  cb_[0] = (int)h0v.x; cb_[1] = (int)h0v.y; cb_[2] = (int)h0v.z; cb_[3] = (int)h0v.w; cb_[4] = (int)h1v.x; cb_[5] = (int)h1v.y; cb_[6] = (int)h1v.z; cb_[7] = (int)h1v.w; }
#pragma unroll
                for (int z = 0; z < 8; ++z) tot += cb_[z];
                const int P_ = wave_iscan(tot);
                const int S = __builtin_amdgcn_readlane(P_, 63) - P_ + tot;
                const int above = S - tot;
                const bool ok = (above < 256) && (256 <= S);
                int dig = 0, nw = 0, hb = 0;
                if (ok) {
                    int cum = above; bool found = false;
#pragma unroll
                    for (int z = 7; z >= 0; --z) { if (!found) { if (cum + cb_[z] >= 256) { dig = lane * 8 + z; nw = 256 - cum; hb = cb_[z]; found = true; } else cum += cb_[z]; } }
                }
                const unsigned long long bal = __ballot(ok);
                const int src = (int)__ffsll((long long)bal) - 1;
                bdig = __shfl(dig, src); bwant = __shfl(nw, src); bcnt = __shfl(hb, src);
            }
            if (bcnt == bwant || bcnt <= CAND_CAP) {
                const int tb = (bcnt == bwant) ? bdig : bdig + 1;
                const unsigned klo = minkey_for_bin(tb), khi = minkey_for_bin(bdig);
                const bool any_take = tb < NBIN, want_cand = tb != bdig;
                LAS3 unsigned long long* tmask = (LAS3 unsigned long long*)hist; LAS3 unsigned long long* cmask = tmask + 64;
                const int ntrip = (n + 255) >> 8;
                const unsigned klo_ = any_take ? klo : 0xffffffffu, khi_ = want_cand ? khi : klo_;
                const int nfull = n >> 8;
                for (int it = 0; it < nfull; ++it) {
                    const u32x4v k4 = *(const LAS3 u32x4v*)(sck + 256 * it + 4 * lane);
                    unsigned long long bt[4], bc[4];
#pragma unroll
                    for (int e = 0; e < 4; ++e) { bt[e] = __builtin_amdgcn_ballot_w64(k4[e] >= klo_); bc[e] = __builtin_amdgcn_ballot_w64(k4[e] >= khi_) & ~bt[e]; }
                    if (lane == 0) {
#pragma unroll
                        for (int e = 0; e < 4; ++e) { tmask[4 * it + e] = bt[e]; cmask[4 * it + e] = bc[e]; }
                    }
                }
                if (nfull < ntrip) {
                    const int it = nfull;
                    const u32x4v k4 = *(const LAS3 u32x4v*)(sck + 256 * it + 4 * lane);
                    unsigned long long bt[4], bc[4];
#pragma unroll
                    for (int e = 0; e < 4; ++e) { const bool in = 256 * it + 4 * lane + e < n;
                        bt[e] = __builtin_amdgcn_ballot_w64(in && k4[e] >= klo_); bc[e] = __builtin_amdgcn_ballot_w64(in && k4[e] >= khi_) & ~bt[e]; }
                    if (lane == 0) {
#pragma unroll
                        for (int e = 0; e < 4; ++e) { tmask[4 * it + e] = bt[e]; cmask[4 * it + e] = bc[e]; }
                    }
                }
                WAVE_SYNC();
                int base;
                {
                    const bool hasw = lane < 4 * ntrip;
                    unsigned long long tw = hasw ? tmask[lane] : 0ull, cw = hasw ? cmask[lane] : 0ull;
                    const int key0 = 256 * (lane >> 2) + (lane & 3);
                    int ct = __popcll(tw), cc = __popcll(cw);
                    const int st_ = wave_iscan(ct), sc_ = wave_iscan(cc);
                    base = __builtin_amdgcn_readlane(st_, 63);
                    int pt = st_ - ct, pc = sc_ - cc;
                    while (tw) { const int bb = __builtin_ctzll(tw); tw &= tw - 1; if (pt < 256) idx[pt] = (u16)(key0 + 4 * bb); ++pt; }
                    while (cw) { const int bb = __builtin_ctzll(cw); cw &= cw - 1; if (pc < CAND_CAP) cand[pc] = (u16)(key0 + 4 * bb); ++pc; }
                }
                if (tb != bdig) {
                    WAVE_SYNC();
                    if (bcnt <= 64) {
                        const bool in = lane < bcnt;
                        const int si = in ? (int)cand[lane] : 0; const unsigned kk = in ? sck[si] : 0u;
                        int rank = 0;
                        for (int j = 0; j < bcnt; ++j) {
                            const unsigned kj = (unsigned)__builtin_amdgcn_readlane((int)kk, j); const int sj = __builtin_amdgcn_readlane(si, j);
                            rank += (kj > kk || (kj == kk && sj < si)) ? 1 : 0;
                        }
                        const bool take = in && (rank < bwant);
                        const unsigned long long bt = __ballot(take);
                        const int pos = base + __popcll(bt & lt_mask);
                        if (take && pos < 256) idx[pos] = (u16)si;
                        base += __popcll(bt);
                    } else
                    for (int i0 = 0; i0 < bcnt; i0 += 64) {
                        const int i = i0 + lane; const bool in = i < bcnt;
                        const int si = in ? (int)cand[i] : 0; const unsigned kk = sck[si];
                        int rank = 0;
                        for (int j = 0; j < bcnt; ++j) { const int sj = (int)cand[j]; const unsigned kj = sck[sj]; rank += (kj > kk || (kj == kk && sj < si)) ? 1 : 0; }
                        const bool take = in && (rank < bwant);
                        const unsigned long long bt = __ballot(take);
                        const int pos = base + __popcll(bt & lt_mask);
                        if (take && pos < 256) idx[pos] = (u16)si;
                        base += __popcll(bt);
                    }
                }
            } else {
            unsigned prefix = 0u, mask = 0u; int want = 256;
            for (int pass = 0; pass < 4; ++pass) {
                const int shift = 24 - 8 * pass;
                hist[lane * 4 + 0] = 0u; hist[lane * 4 + 1] = 0u; hist[lane * 4 + 2] = 0u; hist[lane * 4 + 3] = 0u;
                WAVE_SYNC();
                for (int s = lane; s < n; s += 64) { const unsigned k = sck[s]; if ((k & mask) == prefix) __hip_atomic_fetch_add(&hist[(k >> shift) & 255u], 1u, __ATOMIC_RELAXED, __HIP_MEMORY_SCOPE_WORKGROUP); }
                WAVE_SYNC();
                const int c0 = (int)hist[lane * 4 + 0], c1 = (int)hist[lane * 4 + 1], c2 = (int)hist[lane * 4 + 2], c3 = (int)hist[lane * 4 + 3];
                const int tot = c0 + c1 + c2 + c3;
                int S = tot;
#pragma unroll
                for (int o = 1; o < 64; o <<= 1) { const int v = __shfl_down(S, o); if (lane + o < 64) S += v; }
                const int above = S - tot;
                const bool ok = (above < want) && (want <= S);
                int dig = 0, nw = 0;
                if (ok) {
                    int cum = above;
                    if (cum + c3 >= want) { dig = lane * 4 + 3; nw = want - cum; }
                    else { cum += c3;
                        if (cum + c2 >= want) { dig = lane * 4 + 2; nw = want - cum; }
                        else { cum += c2;
                            if (cum + c1 >= want) { dig = lane * 4 + 1; nw = want - cum; }
                            else { cum += c1; dig = lane * 4; nw = want - cum; } } }
                }
                const unsigned long long bal = __ballot(ok);
                const int src = (int)__ffsll((long long)bal) - 1;
                dig = __shfl(dig, src); nw = __shfl(nw, src);
                prefix |= ((unsigned)dig) << shift; mask |= 255u << shift; want = nw;
                WAVE_SYNC();
            }
            int base = 0, eqt = 0;
            for (int s0 = 0; s0 < n; s0 += 64) {
                const int s = s0 + lane; const bool in = s < n;
                const unsigned k = in ? sck[s] : 0u;
                const bool gt = in && (k > prefix), eq = in && (k == prefix);
                const unsigned long long beq = __ballot(eq);
                const int rank = eqt + __popcll(beq & lt_mask);
                const bool take = gt || (eq && rank < want);
                const unsigned long long bt = __ballot(take);
                const int pos = base + __popcll(bt & lt_mask);
                if (take && pos < 256) idx[pos] = (u16)s;
                base += __popcll(bt); eqt += __popcll(beq);
            }
            }
            WAVE_SYNC();
            if (rep_t == (DSA_DUP == 2 ? 1 : 0)) { ZERO_HIST(hist, lane); }
        }
        WAVE_SYNC();
        for (int rep_a = 0; rep_a < (DSA_DUP == 3 ? 2 : 1); ++rep_a) {
        f32x4v st[16];
#pragma unroll
        for (int kt = 0; kt < 16; ++kt) st[kt] = (f32x4v){0.f, 0.f, 0.f, 0.f};
        f32x4v ot[8];
#pragma unroll
        for (int dt = 0; dt < 8; ++dt) ot[dt] = (f32x4v){0.f, 0.f, 0.f, 0.f};
        const float lsc = 0.08838834764831845f * 1.4426950408889634f;
        float inv;
#define DSA_GATHER(REG, SRC, C)                                                                                     \
        { const u32x4v iv = *(const LAS3 u32x4v*)(idx + 32 * (C) + 8 * g4);                                         \
          _Pragma("unroll") for (int i = 0; i < 8; ++i) {                                                           \
              const int ki = (int)((iv[i >> 1] >> (16 * (i & 1))) & 0xffffu);                                       \
              REG[i] = *(const u32x4v*)(SRC + (brow + ki) * 128 + l15 * 8); } }
#define DSA_KCHUNK(REG, C)                                                                                          \
        { WAVE_SYNC();                                                                                              \
          _Pragma("unroll") for (int i = 0; i < 8; ++i) *(LAS3 u32x4v*)(vbuf + (8 * g4 + i) * KB_PITCH + l15 * 16) = REG[i]; \
          WAVE_SYNC();                                                                                              \
          _Pragma("unroll") for (int a = 0; a < 2; ++a)                                                             \
          _Pragma("unroll") for (int ks = 0; ks < 4; ++ks) {                                                        \
              const bf16x8 kf = *(const LAS3 bf16x8*)(vbuf + (16 * a + l15) * KB_PITCH + (32 * ks + 8 * g4) * 2);   \
              st[2 * (C) + a] = __builtin_amdgcn_mfma_f32_16x16x32_bf16(kf, qf[ks], st[2 * (C) + a], 0, 0, 0); } }
#define DSA_VCHUNK(REG, C)                                                                                          \
        { WAVE_SYNC();                                                                                              \
          _Pragma("unroll") for (int i = 0; i < 8; ++i) *(LAS3 u32x4v*)(vbuf + (8 * g4 + i) * VB_PITCH + l15 * 16) = REG[i]; \
          WAVE_SYNC();                                                                                              \
          bf16x8 pf;                                                                                                \
          { const unsigned w0 = pk2hw(st[2 * (C)][0], st[2 * (C)][1]), w1 = pk2hw(st[2 * (C)][2], st[2 * (C)][3]),  \
                           w2 = pk2hw(st[2 * (C) + 1][0], st[2 * (C) + 1][1]), w3 = pk2hw(st[2 * (C) + 1][2], st[2 * (C) + 1][3]); \
            pf[0] = (short)(w0 & 0xffff); pf[1] = (short)(w0 >> 16); pf[2] = (short)(w1 & 0xffff); pf[3] = (short)(w1 >> 16); \
            pf[4] = (short)(w2 & 0xffff); pf[5] = (short)(w2 >> 16); pf[6] = (short)(w3 & 0xffff); pf[7] = (short)(w3 >> 16); } \
          _Pragma("unroll") for (int dt = 0; dt < 8; ++dt) {                                                        \
              const s16x4 lo = lds_tr16(vb0 + dt * 32), hh = lds_tr16(vb0 + dt * 32 + 16 * VB_PITCH);              \
              const bf16x8 vf = (bf16x8){lo[0], lo[1], lo[2], lo[3], hh[0], hh[1], hh[2], hh[3]};                   \
              ot[dt] = __builtin_amdgcn_mfma_f32_16x16x32_bf16(vf, pf, ot[dt], 0, 0, 0); } }
#define DSA_EXPSUM()                                                                                                \
        { mx = fmaxf(mx, __shfl_xor(mx, 16)); mx = fmaxf(mx, __shfl_xor(mx, 32));                                   \
          float sum = 0.f;                                                                                          \
          _Pragma("unroll") for (int kt = 0; kt < 16; ++kt)                                                         \
          _Pragma("unroll") for (int r = 0; r < 4; ++r) { const float e = __builtin_amdgcn_exp2f(st[kt][r] - mx); st[kt][r] = e; sum += e; } \
          sum += __shfl_xor(sum, 16); sum += __shfl_xor(sum, 32);                                                   \
          inv = 1.f / sum; }
        if (count == 256) {
            u32x4v ring[2][2][8];
            DSA_GATHER(ring[0][0], KB, 0) DSA_GATHER(ring[0][1], KB, 1)
#pragma unroll
            for (int s = 0; s < 4; ++s) {
                if (s < 3) { DSA_GATHER(ring[(s + 1) & 1][0], KB, 2 * s + 2) DSA_GATHER(ring[(s + 1) & 1][1], KB, 2 * s + 3) }
                DSA_KCHUNK(ring[s & 1][0], 2 * s) DSA_KCHUNK(ring[s & 1][1], 2 * s + 1)
            }
            DSA_GATHER(ring[0][0], VB, 0) DSA_GATHER(ring[0][1], VB, 1)
            float mx = -INFINITY;
#pragma unroll
            for (int kt = 0; kt < 16; ++kt)
#pragma unroll
                for (int r = 0; r < 4; ++r) { const float v = st[kt][r] * lsc; st[kt][r] = v; mx = fmaxf(mx, v); }
            DSA_EXPSUM()
#pragma unroll
            for (int s = 0; s < 4; ++s) {
                if (s < 3) { DSA_GATHER(ring[(s + 1) & 1][0], VB, 2 * s + 2) DSA_GATHER(ring[(s + 1) & 1][1], VB, 2 * s + 3) }
                DSA_VCHUNK(ring[s & 1][0], 2 * s) DSA_VCHUNK(ring[s & 1][1], 2 * s + 1)
            }
        } else {
#pragma unroll 1
            for (int c = 0; 32 * c < count; ++c) {
                u32x4v kreg[8];
                DSA_GATHER(kreg, KB, c)
                WAVE_SYNC();
#pragma unroll
                for (int i = 0; i < 8; ++i) *(LAS3 u32x4v*)(vbuf + (8 * g4 + i) * KB_PITCH + l15 * 16) = kreg[i];
                WAVE_SYNC();
                f32x4v s0 = (f32x4v){0.f, 0.f, 0.f, 0.f}, s1 = (f32x4v){0.f, 0.f, 0.f, 0.f};
#pragma unroll
                for (int ks = 0; ks < 4; ++ks) {
                    const bf16x8 kf0 = *(const LAS3 bf16x8*)(vbuf + l15 * KB_PITCH + (32 * ks + 8 * g4) * 2);
                    const bf16x8 kf1 = *(const LAS3 bf16x8*)(vbuf + (16 + l15) * KB_PITCH + (32 * ks + 8 * g4) * 2);
                    s0 = __builtin_amdgcn_mfma_f32_16x16x32_bf16(kf0, qf[ks], s0, 0, 0, 0);
                    s1 = __builtin_amdgcn_mfma_f32_16x16x32_bf16(kf1, qf[ks], s1, 0, 0, 0);
                }
#pragma unroll
                for (int cs = 0; cs < 8; ++cs) if (c == cs) { st[2 * cs] = s0; st[2 * cs + 1] = s1; }
            }
            float mx = -INFINITY;
#pragma unroll
            for (int kt = 0; kt < 16; ++kt)
#pragma unroll
                for (int r = 0; r < 4; ++r) { const int j = 16 * kt + 4 * g4 + r; const float v = (j < count) ? st[kt][r] * lsc : -INFINITY; st[kt][r] = v; mx = fmaxf(mx, v); }
            DSA_EXPSUM()
#pragma unroll
            for (int c = 0; c < 8; ++c) {
                if (32 * c < count) {
                    u32x4v vreg[8];
                    DSA_GATHER(vreg, VB, c)
                    DSA_VCHUNK(vreg, c)
                }
            }
        }
#undef DSA_GATHER
#undef DSA_KCHUNK
#undef DSA_VCHUNK
#undef DSA_EXPSUM

        if (l15 < 8) {
            u16* orow = MIX + m * DM + l15 * 128 + 4 * g4;
#pragma unroll
            for (int dt = 0; dt < 8; ++dt) {
                uint2 w; w.x = pk2hw(ot[dt][0] * inv, ot[dt][1] * inv); w.y = pk2hw(ot[dt][2] * inv, ot[dt][3] * inv);
                *(uint2*)(orow + 16 * dt) = w;
            }
        }
        }
    }
}
#undef GROUP_BARRIER

#define XB_TMO      128
#define XB_XCNT(j)  (256  + 64 * (j))
#define XB_XSUB(j)  (1280 + 64 * (j))
#define XB_XGEN(j)  (2304 + 64 * (j))
#define XB_TOP      3328
#define XB_TOPGEN   3392
#define XCD_BAR_WORDS 3456
#define XB_SPIN_CAP (1u << 18)

__device__ __forceinline__ unsigned xb_ld(unsigned* p)              { return __hip_atomic_load(p, __ATOMIC_RELAXED, __HIP_MEMORY_SCOPE_AGENT); }
__device__ __forceinline__ unsigned xb_add(unsigned* p, unsigned v) { return __hip_atomic_fetch_add(p, v, __ATOMIC_RELAXED, __HIP_MEMORY_SCOPE_AGENT); }
__device__ __forceinline__ unsigned xb_xcc_id() { return (unsigned)__builtin_amdgcn_s_getreg((3 << 11) | 20) & 0xFu; }
#define XB_SPIN(cond, bar) do { unsigned _sp = 0; while (cond) { __builtin_amdgcn_s_sleep(1); \
    if ((++_sp & 255u) == 0u) { if (xb_ld(&(bar)[XB_TMO])) break; if (_sp > XB_SPIN_CAP) { atomicAdd(&(bar)[XB_TMO], 1u); break; } } } } while (0)

struct XcdBarrier {
    unsigned* bar; unsigned x;
    volatile __attribute__((address_space(3))) unsigned* st;
};

__device__ __forceinline__ XcdBarrier xcd_barrier_post(unsigned* bar, volatile __attribute__((address_space(3))) unsigned* st) {
    XcdBarrier b; b.bar = bar; b.x = xb_xcc_id(); b.st = st;
    if (threadIdx.x == 0) (void)xb_add(&bar[XB_XCNT(b.x)], 1u);
    return b;
}
__device__ __forceinline__ void xcd_barrier_complete(unsigned* bar, unsigned x, unsigned& nloc, unsigned& nx) {
    const unsigned G = gridDim.x * gridDim.y * gridDim.z;
    unsigned sum, cnt, mine, sp = 0u;
    for (;;) {
        sum = 0u; cnt = 0u; mine = 0u;
#pragma unroll
        for (unsigned j = 0; j < 16; ++j) { const unsigned c = xb_ld(&bar[XB_XCNT(j)]); sum += c; cnt += (c > 0u) ? 1u : 0u; mine = (j == x) ? c : mine; }
        if (sum == G) break;
        __builtin_amdgcn_s_sleep(1);
        if ((++sp & 255u) == 0u) { if (xb_ld(&bar[XB_TMO])) break; if (sp > XB_SPIN_CAP) { atomicAdd(&bar[XB_TMO], 1u); break; } }
    }
    nloc = mine > 0u ? mine : 1u; nx = cnt > 0u ? cnt : 1u;
}

__device__ __forceinline__ void xcd_barrier(const XcdBarrier& b) {
    asm volatile("s_waitcnt vmcnt(0)" ::: "memory");
    __syncthreads();
    if (threadIdx.x == 0) {
        unsigned* bar = b.bar;
        __builtin_amdgcn_s_waitcnt(0);
        unsigned nloc = b.st[0], nx = b.st[1];
        if (nloc == 0u) { xcd_barrier_complete(bar, b.x, nloc, nx); b.st[0] = nloc; b.st[1] = nx; }
        const unsigned old = xb_add(&bar[XB_XSUB(b.x)], 1u);
        const unsigned gen = old / nloc;
        if (old + 1u == (gen + 1u) * nloc) {
            __builtin_amdgcn_fence(__ATOMIC_RELEASE, "agent");
            asm volatile("s_waitcnt vmcnt(0)" ::: "memory");
            const unsigned og = xb_add(&bar[XB_TOP], 1u);
            const unsigned tg = og / nx;
            if (og + 1u == (tg + 1u) * nx) xb_add(&bar[XB_TOPGEN], 1u);
            else XB_SPIN(xb_ld(&bar[XB_TOPGEN]) == tg, bar);
            __builtin_amdgcn_fence(__ATOMIC_ACQUIRE, "agent");
            xb_add(&bar[XB_XGEN(b.x)], 1u);
            asm volatile("s_waitcnt vmcnt(0)" ::: "memory");
        } else {
            XB_SPIN(xb_ld(&bar[XB_XGEN(b.x)]) == gen, bar);
            __builtin_amdgcn_fence(__ATOMIC_ACQUIRE, "agent");
            asm volatile("s_waitcnt vmcnt(0)" ::: "memory");
        }
    }
    __syncthreads();
}

__device__ __forceinline__ void xattn_precompute(const Params& p, int l, unsigned char* smem) {
    const u16* KV = (const u16*)(p.ws + WS_KV);
    const int half = (int)gridDim.x >> 1;
    if ((int)blockIdx.x < half) {
        pg8::Gemm g{KV, (const u16*)(p.ws + WS_WQ), 256, 1024, 256, 2048, 1024}; PreOrder<0> S{half, (int)blockIdx.x, l};
        EpiStore E{(u16*)(p.ws + WS_BT1), 1024, 0, nullptr};
        pg8::gemm_phase<EpiStore, PreOrder<0>, true, true>((PG8_LAS unsigned char*)smem, g, S, E); }
    else {
        pg8::Gemm g{(const u16*)(p.ws + WS_WO), KV, 1024, 256, 256, 1024, 2048}; PreOrder<1> S{(int)gridDim.x - half, (int)blockIdx.x - half, l};
        EpiStore E{(u16*)(p.ws + WS_BT2), 1024, 0, nullptr};
        pg8::gemm_phase<EpiStore, PreOrder<1>, true, true>((PG8_LAS unsigned char*)smem, g, S, E); }
}

typedef const __attribute__((address_space(4))) Params* KParams;
template <int PH> __device__ __forceinline__ void run_phase(unsigned char* smem) {
    constexpr int ph = PH;
#if defined(__HIP_DEVICE_COMPILE__)
    KParams kp = (KParams)__builtin_amdgcn_kernarg_segment_ptr(); asm volatile("" : "+s"(kp));
    Params p;
    p.x = kp->x; p.mem = kp->mem; p.pos = kp->pos; p.gains = kp->gains; p.wq = kp->wq; p.wkv = kp->wkv; p.wo = kp->wo; p.w1 = kp->w1; p.w2 = kp->w2;
    p.ev_w_in = kp->ev_w_in; p.sgu_g = kp->sgu_g; p.sgu_ws = kp->sgu_ws; p.sgu_bs = kp->sgu_bs; p.pool_w = kp->pool_w; p.pool_scale = kp->pool_scale;
    p.ev_w_out = kp->ev_w_out; p.od_w_in = kp->od_w_in; p.od_w_out = kp->od_w_out; p.out = kp->out; p.ws = kp->ws;
#else
    Params p{};
#endif
    u16* HN = (u16*)(p.ws + WS_HN); u16* Y = (u16*)(p.ws + WS_Y); u16* Z = (u16*)(p.ws + WS_Z); u16* MIX = (u16*)(p.ws + WS_MIX);
    u16* Qb = (u16*)(p.ws + WS_Q); u16* HID = (u16*)(p.ws + WS_HID); u16* MEMN = (u16*)(p.ws + WS_MEMN); u16* KV = (u16*)(p.ws + WS_KV); float* RS = (float*)(p.ws + WS_RS);
    if constexpr (ph == 0) {
        float2* rope = (float2*)(p.ws + WS_ROPE);
        const int gt = blockIdx.x * NT + tid_opaque(), gs = gridDim.x * NT;
        for (int i = gt; i < T * 64; i += gs) {
            const int m = i >> 6, j = i & 63;
            const float inv = expf(-0.14391156831212787f * (float)j);
            const float ang = (float)p.pos[m] * inv;
            rope[i] = make_float2(cosf(ang), sinf(ang));
        }
        for (int i = gt; i < 4 * 16384; i += gs) {
            const int t = (i >> 7) & 127, s = i & 127, gg = i >> 14;
            ((u16*)(p.ws + WS_WC))[i] = (s <= t) ? f2bf(p.sgu_ws[i]) : (u16)0;
            ((u16*)(p.ws + WS_PWT))[i] = f2bf(p.pool_w[(size_t)gg * 16384 + s * 128 + t]);
        }
        rmsnorm_rows(p.mem, p.gains + (0 * 7 + 6) * DM, MEMN, 2048);
        rmsnorm_rows(p.mem, p.gains + (1 * 7 + 6) * DM, MEMN + (size_t)2048 * DM, 2048);
        cast_rows(p.x, HN, RS);
#pragma unroll 1
        for (int l = 0; l < 2; ++l) {
            weight_prep(p.wkv + (size_t)l * DM * 2048, DM, 2048, 2048, (u16*)(p.ws + WS_WKV) + (size_t)l * 2048 * DM, smem);
            weight_cast(p.wq + (size_t)l * DM * DM, DM, DM, (u16*)(p.ws + WS_WQ) + (size_t)l * DM * DM, p.gains + (size_t)(l * 7 + 2) * DM);
            weight_prep(p.wo + (size_t)l * DM * DM, DM, DM, DM, (u16*)(p.ws + WS_WO) + (size_t)l * DM * DM, smem);
            weight_prep(p.w1 + (size_t)l * DM * DFF, DM, DFF, DFF, (u16*)(p.ws + WS_W1) + (size_t)l * DFF * DM, smem, p.gains + (size_t)(l * 7 + 4) * DM);
            weight_prep<false, true>(p.w2 + (size_t)l * DFF * DM, DFF, DM, DM, (u16*)(p.ws + WS_W2 + (size_t)l * DM * DFF), smem);
        }
        weight_prep(p.ev_w_in, DM, EVEN_IN, EVEN_IN, (u16*)(p.ws + WS_EVIN), smem, p.gains + 0);
        weight_prep(p.ev_w_out, DM, DM, DM, (u16*)(p.ws + WS_EVOUT), smem);
        weight_prep<true>(p.od_w_in, DM, ODD_IN, ZP1, (u16*)(p.ws + WS_ODIN), smem, p.gains + (size_t)7 * DM);
        weight_prep(p.od_w_out, DM, DM, DM, (u16*)(p.ws + WS_ODOUT), smem);
    } else if constexpr (ph == 1) {
        pg8::Gemm gm{MEMN, (const u16*)(p.ws + WS_WKV), 2048, 2048, DM, DM, DM}; KvOrder S{(int)gridDim.x, (int)blockIdx.x};
        EpiStore E{KV, 2048, 0, nullptr};
        pg8::gemm_phase<EpiStore, KvOrder, true, true>((PG8_LAS unsigned char*)smem, gm, S, E);
    } else if constexpr (ph == 2) {
        xattn_precompute(p, 0, smem);
    } else {
        constexpr int l = (ph - 3) / 12, s = (ph - 3) % 12;
        const float* g = p.gains + (size_t)l * 7 * DM;
        if constexpr (s == 0) {
            if constexpr (l == 0) { gemm8(HN, (const u16*)(p.ws + WS_EVIN), T, EVEN_IN, DM, Z, EVEN_IN, 0, RS, smem); xattn_precompute(p, 0, smem); }
            else { pg8::Gemm gm{HN, (const u16*)(p.ws + WS_ODIN), T, ZP1, DM, DM, DM}; pg8::StaticOrder S; S.init(T, ZP1, (int)gridDim.x, (int)blockIdx.x);
                   EpiRope E{Z, (u16*)(p.ws + WS_KB), (u16*)(p.ws + WS_VB), (u16*)(p.ws + WS_KI), RS, (const float2*)(p.ws + WS_ROPE)};
                   pg8::gemm_phase<EpiRope, pg8::StaticOrder, true, true>((PG8_LAS unsigned char*)smem, gm, S, E); }
        } else if constexpr (s == 1) {
            if constexpr (l == 0) { mixer_a_all(p, smem); mixer_b_all(p, smem); }
            else { }
        } else if constexpr (s == 2) { if constexpr (l == 1) dsa_phase(p, smem); }
        else if constexpr (s == 3) gemm8(MIX, (const u16*)(p.ws + (l == 0 ? WS_EVOUT : WS_ODOUT)), T, DM, DM, Y, DM, 0, nullptr, smem);
        else if constexpr (s == 4) { if constexpr (l == 1) xattn_precompute(p, 1, smem); postnorm_rows<false>(HN, Y, g + 1 * DM, RS, nullptr); }
        else if constexpr (s == 5) {
            pg8::Gemm g{HN, (const u16*)(p.ws + WS_BT1), T, DM, DM, DM, DM}; BatchBOrder S; S.init(T, DM, (int)gridDim.x, (int)blockIdx.x);
            EpiSoftmax E{MIX, DM, RS, (PG8_LAS float*)((PG8_LAS unsigned char*)smem + 131072)};
            pg8::gemm_phase<EpiSoftmax, BatchBOrder, true, true>((PG8_LAS unsigned char*)smem, g, S, E); }
        else if constexpr (s == 6) { }
        else if constexpr (s == 7) {
            pg8::Gemm g{MIX, (const u16*)(p.ws + WS_BT2), T, DM, DM, DM, DM}; BatchBOrder S; S.init(T, DM, (int)gridDim.x, (int)blockIdx.x);
            EpiStore E{Y, DM, 0, nullptr};
            pg8::gemm_phase<EpiStore, BatchBOrder, true, true>((PG8_LAS unsigned char*)smem, g, S, E); }
        else if constexpr (s == 8) postnorm_rows<false>(HN, Y, g + 3 * DM, RS, nullptr);
        else if constexpr (s == 9) {
            pg8::Gemm gm{HN, (const u16*)(p.ws + WS_W1) + (size_t)l * DFF * DM, T, DFF, DM, DM, DM}; pg8::StaticOrder S; S.init(T, DFF, (int)gridDim.x, (int)blockIdx.x);
            EpiStoreF8 E{(unsigned char*)HID, DFF, RS};
            pg8::gemm_phase<EpiStoreF8, pg8::StaticOrder, true, true>((PG8_LAS unsigned char*)smem, gm, S, E); }
        else if constexpr (s == 10) {
            pg8::Gemm gm{HID, (const u16*)(p.ws + WS_W2 + (size_t)l * DM * DFF), T, DM, DFF / 2, DFF / 2, DFF / 2}; pg8::StaticOrder S; S.init(T, DM, (int)gridDim.x, (int)blockIdx.x);
            EpiStore E{Y, DM, 0, nullptr, 1.f / 2048.f};
            pg8::gemm_phase<EpiStore, pg8::StaticOrder, true, true, true>((PG8_LAS unsigned char*)smem, gm, S, E); }
        else { if constexpr (l == 0) postnorm_rows<false>(HN, Y, g + 5 * DM, RS, nullptr); else postnorm_rows<true>(HN, Y, g + 5 * DM, nullptr, p.out); }
    }
}

template <int PH> __device__ __forceinline__ void run_all(unsigned char* smem, const XcdBarrier& bar) {
    if constexpr (PH < NPHASE) {
        if constexpr (PH == DUP_PH) { run_phase<PH>(smem); xcd_barrier(bar); }
        if constexpr (PH == 1) { for (int xb = 0; xb < EXTRA_BARRIERS; ++xb) xcd_barrier(bar); }
#ifdef ONLY_PH
        if constexpr (PH == ONLY_PH) {
#else
        if constexpr (PH != 2 && PH != 5 && PH != 9 && PH != 21 && PH != 16) {
#endif
            run_phase<PH>(smem);
            if constexpr (PH + 1 < NPHASE) xcd_barrier(bar);
        }
        run_all<PH + 1>(smem, bar);
    }
}
#endif
constexpr size_t WS_CTL = 0, CTL_ZERO_BYTES = 65536;
__global__ void __launch_bounds__(NT, 2) fwd_kernel(Params p) {
#if defined(__HIP_DEVICE_COMPILE__)
    extern __shared__ __attribute__((aligned(16))) unsigned char smem[];
    volatile __attribute__((address_space(3))) unsigned* st = (volatile __attribute__((address_space(3))) unsigned*)((__attribute__((address_space(3))) unsigned char*)smem + LDS_CTL_OFF);
    if (threadIdx.x < 16) st[threadIdx.x] = 0u;
    __syncthreads();
    const XcdBarrier bar = xcd_barrier_post((unsigned*)(p.ws + WS_CTL), st);
    if (p.ws == nullptr) cg::this_grid().sync();
    run_all<0>(smem, bar);
#endif
}

extern "C" void kernel_launch(void* const* d_in, const int* in_sizes, int n_in, void* d_out, int out_size, void* d_ws, size_t ws_size, hipStream_t stream) {
    static int inited = 0, cus = 256, per_cu = 1;
    if (!inited) {
        inited = 1;
        if (ws_size < WS_END) fprintf(stderr, "kernel_launch: workspace too small: %zu < %zu\n", ws_size, (size_t)WS_END);
        int dev = 0; (void)hipGetDevice(&dev); (void)hipDeviceGetAttribute(&cus, hipDeviceAttributeMultiprocessorCount, dev);
        (void)hipFuncSetAttribute((const void*)fwd_kernel, hipFuncAttributeMaxDynamicSharedMemorySize, LDS_BYTES);
        if (hipOccupancyMaxActiveBlocksPerMultiprocessor(&per_cu, (const void*)fwd_kernel, NT, LDS_BYTES) != hipSuccess || per_cu < 1) per_cu = 1;
        (void)hipGetLastError();
    }
    Params p{};
    p.x = (const float*)d_in[0]; p.mem = (const float*)d_in[1]; p.pos = (const int*)d_in[2]; p.gains = (const float*)d_in[3];
    p.wq = (const float*)d_in[4]; p.wkv = (const float*)d_in[5]; p.wo = (const float*)d_in[6]; p.w1 = (const float*)d_in[7]; p.w2 = (const float*)d_in[8];
    p.ev_w_in = (const float*)d_in[9]; p.sgu_g = (const float*)d_in[10]; p.sgu_ws = (const float*)d_in[11]; p.sgu_bs = (const float*)d_in[12];
    p.pool_w = (const float*)d_in[13]; p.pool_scale = (const float*)d_in[14]; p.ev_w_out = (const float*)d_in[15];
    p.od_w_in = (const float*)d_in[16]; p.od_w_out = (const float*)d_in[17];
    p.out = (float*)d_out; p.ws = (unsigned char*)d_ws;
    (void)hipMemsetAsync((char*)d_ws + WS_CTL, 0, CTL_ZERO_BYTES, stream);
    void* args[] = {&p};
    hipError_t e = hipLaunchCooperativeKernel((const void*)fwd_kernel, dim3(cus * per_cu), dim3(NT), args, LDS_BYTES, stream);
    if (e != hipSuccess) fprintf(stderr, "cooperative launch failed: %s\n", hipGetErrorString(e));
}
```

```cpp
#include <hip/hip_runtime.h>
#include <hip/hip_cooperative_groups.h>
#include <cstdio>
#include <cstdint>
namespace cg = cooperative_groups;


#ifndef DUP_PH
#define DUP_PH -1
#endif
#define DSA_DUP 0
#define EXTRA_BARRIERS 0
typedef unsigned short u16;
typedef short bf16x8 __attribute__((ext_vector_type(8)));
typedef float f32x4 __attribute__((ext_vector_type(4)));

constexpr int NT = 512;
constexpr int NB = 8, SEQ = 4096, T = NB * SEQ, DM = 1024, NMEM = 256, DFF = 4096;
constexpr int EVEN_IN = 1536, ODD_IN = 1864, ZP1 = 2048;
constexpr float EPS = 1e-6f;

constexpr size_t MiB = 1u << 20;
constexpr size_t WS_WKV = 2 * MiB, WS_WQ = 10 * MiB, WS_WO = 14 * MiB, WS_W1 = 18 * MiB, WS_W2 = 34 * MiB;
constexpr size_t WS_EVIN = 50 * MiB, WS_EVOUT = 53 * MiB, WS_ODIN = 55 * MiB, WS_ODOUT = 59 * MiB;
constexpr size_t WS_WC = 61 * MiB, WS_PWT = 61 * MiB + 131072;
constexpr size_t WS_RS = 62 * MiB;
constexpr size_t WS_ROPE = 66 * MiB;
constexpr size_t WS_MEMN = 82 * MiB;
constexpr size_t WS_KV   = 90 * MiB;
constexpr size_t WS_HN   = 122 * MiB;
constexpr size_t WS_Y    = 186 * MiB;
constexpr size_t WS_Z    = 250 * MiB;
constexpr size_t WS_MIX  = 378 * MiB;
constexpr size_t WS_Q    = 442 * MiB;
constexpr size_t WS_KB = 442 * MiB, WS_VB = 450 * MiB, WS_KI = 458 * MiB;
constexpr size_t WS_BT1 = 442 * MiB, WS_BT2 = 458 * MiB;
constexpr size_t WS_HID  = 250 * MiB;
constexpr size_t WS_END  = 506 * MiB;

constexpr int DSA_WAVE_LDS = 19 * 1024;
constexpr int NPHASE = 27;
constexpr int LDS_CTL_OFF = 8 * DSA_WAVE_LDS;
constexpr int LDS_BYTES = LDS_CTL_OFF + 64;

struct Params {
    const float* x; const float* mem; const int* pos; const float* gains;
    const float* wq; const float* wkv; const float* wo; const float* w1; const float* w2;
    const float* ev_w_in; const float* sgu_g; const float* sgu_ws; const float* sgu_bs;
    const float* pool_w; const float* pool_scale; const float* ev_w_out;
    const float* od_w_in; const float* od_w_out;
    float* out; unsigned char* ws;
};

#if defined(__HIP_DEVICE_COMPILE__)
__device__ __forceinline__ u16 f2bf(float f) { unsigned u = __float_as_uint(f); return (u16)((u + 0x7fffu + ((u >> 16) & 1u)) >> 16); }
__device__ __forceinline__ float bf2f(u16 h) { return __uint_as_float(((unsigned)h) << 16); }
__device__ __forceinline__ float bflo(unsigned w) { return __uint_as_float(w << 16); }
__device__ __forceinline__ float bfhi(unsigned w) { return __uint_as_float(w & 0xffff0000u); }
__device__ __forceinline__ unsigned pk2hw(float lo, float hi) { unsigned r; asm("v_cvt_pk_bf16_f32 %0, %1, %2" : "=v"(r) : "v"(lo), "v"(hi)); return r; }
__device__ __forceinline__ unsigned pk2(float lo, float hi) { return (unsigned)f2bf(lo) | ((unsigned)f2bf(hi) << 16); }
__device__ __forceinline__ float wsum(float v) {
#pragma unroll
    for (int o = 32; o > 0; o >>= 1) v += __shfl_xor(v, o);
    return v;
}
__device__ __forceinline__ float rsum16(float v) {
    v += __int_as_float(__builtin_amdgcn_update_dpp(0, __float_as_int(v), 0xB1, 0xf, 0xf, true));
    v += __int_as_float(__builtin_amdgcn_update_dpp(0, __float_as_int(v), 0x4E, 0xf, 0xf, true));
    v += __int_as_float(__builtin_amdgcn_update_dpp(0, __float_as_int(v), 0x141, 0xf, 0xf, true));
    v += __int_as_float(__builtin_amdgcn_update_dpp(0, __float_as_int(v), 0x140, 0xf, 0xf, true));
    return v;
}
__device__ __forceinline__ float wmax(float v) {
#pragma unroll
    for (int o = 32; o > 0; o >>= 1) v = fmaxf(v, __shfl_xor(v, o));
    return v;
}
__device__ __forceinline__ float gelu_tanh(float x) { return 0.5f * x * (1.f + tanhf(0.7978845608028654f * (x + 0.044715f * x * x * x))); }
__device__ __forceinline__ int tid_opaque() { int t = threadIdx.x; asm volatile("" : "+v"(t)); return t; }
#ifndef LAS3
#define LAS3 __attribute__((address_space(3)))
#endif
#define WAVE_SYNC() asm volatile("s_waitcnt lgkmcnt(0)" ::: "memory")

__device__ __forceinline__ void rmsnorm_rows(const float* in, const float* g, u16* out, int rows) {
    const int tid = tid_opaque(), lane = tid & 63, gw = (blockIdx.x * NT + tid) >> 6, ngw = (gridDim.x * NT) >> 6;
    for (int r = gw; r < rows; r += ngw) {
        const float4* xr = (const float4*)(in + (size_t)r * DM);
        float4 v[4]; float ss = 0.f;
#pragma unroll
        for (int j = 0; j < 4; ++j) { v[j] = xr[lane + 64 * j]; ss += v[j].x * v[j].x + v[j].y * v[j].y + v[j].z * v[j].z + v[j].w * v[j].w; }
        ss = wsum(ss);
        const float rstd = rsqrtf(ss * (1.f / DM) + EPS);
#pragma unroll
        for (int j = 0; j < 4; ++j) {
            const float4 gg = ((const float4*)g)[lane + 64 * j];
            uint2 o; o.x = pk2(v[j].x * rstd * gg.x, v[j].y * rstd * gg.y); o.y = pk2(v[j].z * rstd * gg.z, v[j].w * rstd * gg.w);
            ((uint2*)(out + (size_t)r * DM))[lane + 64 * j] = o;
        }
    }
}
__device__ __forceinline__ void cast_rows(const float* in, u16* hb, float* rs) {
    const int tid = tid_opaque(), lane = tid & 63, gw = (blockIdx.x * NT + tid) >> 6, ngw = (gridDim.x * NT) >> 6;
    for (int r = gw; r < T; r += ngw) {
        const float4* xr = (const float4*)(in + (size_t)r * DM);
        float4 v[4]; float ss = 0.f;
#pragma unroll
        for (int j = 0; j < 4; ++j) { v[j] = xr[lane + 64 * j]; ss += v[j].x * v[j].x + v[j].y * v[j].y + v[j].z * v[j].z + v[j].w * v[j].w; }
        ss = wsum(ss);
#pragma unroll
        for (int j = 0; j < 4; ++j) { uint2 o; o.x = pk2(v[j].x, v[j].y); o.y = pk2(v[j].z, v[j].w); ((uint2*)(hb + (size_t)r * DM))[lane + 64 * j] = o; }
        if (lane == 0) rs[r] = rsqrtf(ss * (1.f / DM) + EPS);
    }
}
template <bool FINAL> __device__ __forceinline__ void postnorm_rows(u16* hb, const u16* y, const float* gpost, float* rs, float* fout) {
    const int tid = tid_opaque(), lane = tid & 63, gw = (blockIdx.x * NT + tid) >> 6, ngw = (gridDim.x * NT) >> 6;
    for (int r0 = gw; r0 < T; r0 += 2 * ngw) {
        const bool two = r0 + ngw < T; const int r1 = two ? r0 + ngw : r0;
        uint4 yw[2][2], hw[2][2];
#pragma unroll
        for (int q = 0; q < 2; ++q) { const size_t ro = (size_t)(q ? r1 : r0) * DM + lane * 8;
#pragma unroll
            for (int j = 0; j < 2; ++j) { yw[q][j] = *(const uint4*)(y + ro + j * 512); hw[q][j] = *(const uint4*)(hb + ro + j * 512); } }
        float4 g0[2], g1[2];
#pragma unroll
        for (int j = 0; j < 2; ++j) { g0[j] = *(const float4*)(gpost + j * 512 + lane * 8); g1[j] = *(const float4*)(gpost + j * 512 + lane * 8 + 4); }
#pragma unroll
        for (int q = 0; q < 2; ++q) {
            if (q == 1 && !two) break;
            const int r = q ? r1 : r0;
            float yv[16], hv[16]; float ss = 0.f;
#pragma unroll
            for (int j = 0; j < 2; ++j) {
                const uint4 w = yw[q][j], h4 = hw[q][j];
                yv[j * 8 + 0] = bflo(w.x); yv[j * 8 + 1] = bfhi(w.x); yv[j * 8 + 2] = bflo(w.y); yv[j * 8 + 3] = bfhi(w.y);
                yv[j * 8 + 4] = bflo(w.z); yv[j * 8 + 5] = bfhi(w.z); yv[j * 8 + 6] = bflo(w.w); yv[j * 8 + 7] = bfhi(w.w);
                hv[j * 8 + 0] = bflo(h4.x); hv[j * 8 + 1] = bfhi(h4.x); hv[j * 8 + 2] = bflo(h4.y); hv[j * 8 + 3] = bfhi(h4.y);
                hv[j * 8 + 4] = bflo(h4.z); hv[j * 8 + 5] = bfhi(h4.z); hv[j * 8 + 6] = bflo(h4.w); hv[j * 8 + 7] = bfhi(h4.w);
            }
#pragma unroll
            for (int i = 0; i < 16; ++i) ss += yv[i] * yv[i];
            ss = wsum(ss);
            const float rstd = rsqrtf(ss * (1.f / DM) + EPS);
            float s2 = 0.f;
#pragma unroll
            for (int j = 0; j < 2; ++j) {
                hv[j * 8 + 0] += yv[j * 8 + 0] * rstd * g0[j].x; hv[j * 8 + 1] += yv[j * 8 + 1] * rstd * g0[j].y; hv[j * 8 + 2] += yv[j * 8 + 2] * rstd * g0[j].z; hv[j * 8 + 3] += yv[j * 8 + 3] * rstd * g0[j].w;
                hv[j * 8 + 4] += yv[j * 8 + 4] * rstd * g1[j].x; hv[j * 8 + 5] += yv[j * 8 + 5] * rstd * g1[j].y; hv[j * 8 + 6] += yv[j * 8 + 6] * rstd * g1[j].z; hv[j * 8 + 7] += yv[j * 8 + 7] * rstd * g1[j].w;
                if constexpr (FINAL) {
                    float* o = fout + (size_t)r * DM + j * 512 + lane * 8;
                    *(float4*)o = make_float4(hv[j * 8 + 0], hv[j * 8 + 1], hv[j * 8 + 2], hv[j * 8 + 3]);
                    *(float4*)(o + 4) = make_float4(hv[j * 8 + 4], hv[j * 8 + 5], hv[j * 8 + 6], hv[j * 8 + 7]);
                } else {
                    uint4 o;
                    o.x = pk2(hv[j * 8 + 0], hv[j * 8 + 1]); o.y = pk2(hv[j * 8 + 2], hv[j * 8 + 3]); o.z = pk2(hv[j * 8 + 4], hv[j * 8 + 5]); o.w = pk2(hv[j * 8 + 6], hv[j * 8 + 7]);
                    *(uint4*)(hb + (size_t)r * DM + j * 512 + lane * 8) = o;
                }
            }
            if constexpr (!FINAL) {
#pragma unroll
                for (int i = 0; i < 16; ++i) s2 += hv[i] * hv[i];
                s2 = wsum(s2);
                if (lane == 0) rs[r] = rsqrtf(s2 * (1.f / DM) + EPS);
            }
        }
    }
}

namespace pg8 {
#define PG8_LAS __attribute__((address_space(3)))
typedef unsigned short bf16_t;
typedef short bf16x8 __attribute__((ext_vector_type(8)));
typedef float f32x4 __attribute__((ext_vector_type(4)));
typedef unsigned u32x4 __attribute__((ext_vector_type(4)));
typedef int i32x4 __attribute__((ext_vector_type(4)));
typedef int i32x8 __attribute__((ext_vector_type(8)));
constexpr int BM = 256, BK = 64, HALF = 128, HTB = HALF * BK * 2  , STAGE_BYTES = 8 * HTB, NXCD = 8, WGM = 8;

__host__ __device__ __forceinline__ int lds_byte(int r, int c) { const int st = (r >> 4) * 2 + (c >> 5), rr = r & 15, cc = c & 31, ob = rr * 64 + cc * 2; return st * 1024 + (ob ^ (((ob >> 9) & 1) << 5)); }
__host__ __device__ __forceinline__ void stage_rc(int b, int& R, int& C) { const int st = b / 1024, sb = b % 1024, swz = sb ^ (((sb >> 9) & 1) << 5); R = (st >> 1) * 16 + swz / 64; C = (st & 1) * 32 + (swz % 64) / 2; }
__host__ __device__ __forceinline__ int perm32(int rho) { const int n = rho >> 4, i = rho & 15; return 8 * (i >> 2) + 4 * n + (i & 3); }

struct Unit { int pm, pn; long aoff, boff, coff; };
struct Gemm { const bf16_t* A; const bf16_t* Bt; int M, N, K, lda, ldb; };

struct StaticOrder {
    int nM, nN, nwg, G, c;
    __host__ __device__ void init(int M, int N, int G_, int c_) { nM = M / BM; nN = N / BM; nwg = nM * nN; G = G_; c = c_; }
    __host__ __device__ bool next(int i, Unit& u) const {
        const long L = (long)i * G + c; if (L >= nwg) return false;
        int wgid = (int)L; { const int q = nwg / NXCD, r = nwg % NXCD, xcd = wgid % NXCD, off = wgid / NXCD; wgid = (xcd < r ? xcd * (q + 1) : r * (q + 1) + (xcd - r) * q) + off; }
        const int nig = WGM * nN, gid = wgid / nig, fm = gid * WGM, gsz = (nM - fm) < WGM ? (nM - fm) : WGM;
        u.pm = fm + ((wgid % nig) % gsz); u.pn = (wgid % nig) / gsz; u.aoff = 0; u.boff = 0; u.coff = 0; return true;
    }
    __device__ __forceinline__ void a_ready(const Unit&) const {}
    __device__ __forceinline__ void done(const Unit&) const {}
};
__device__ __forceinline__ unsigned cvt_pk_bf16(float lo, float hi) { unsigned r; asm volatile("v_cvt_pk_bf16_f32 %0, %1, %2" : "=v"(r) : "v"(lo), "v"(hi)); return r; }
template <class Epi, class Sched, bool ALIGN_EPI = false, bool SP2 = false, bool F8 = false>
__device__ __forceinline__ void gemm_phase(PG8_LAS unsigned char* lds, const Gemm g, const Sched& S, const Epi& E) {
    const int tid = tid_opaque(), wid = __builtin_amdgcn_readfirstlane(tid >> 6), lane = tid & 63, wr = wid >> 2, wc = wid & 3, fr = lane & 15, fq = lane >> 4;
    const int K = g.K, nt = K / BK;
    unsigned voffA[2], voffB[2];
#pragma unroll
    for (int i = 0; i < 2; ++i) { int R, C; stage_rc(tid * 16 + i * 8192, R, C); const int Rb = Epi::PERM ? ((R & ~31) + perm32(R & 31)) : R;
        voffA[i] = (unsigned)(R * g.lda + C) * 2u; voffB[i] = (unsigned)(Rb * g.ldb + C) * 2u; }
    const size_t kstep = (size_t)(BK * 2);
    const size_t hstepA = (size_t)HALF * g.lda * 2, hstepB = (size_t)HALF * g.ldb * 2;
    const size_t tstepA = 2 * hstepA, tstepB = 2 * hstepB;
    const unsigned ldsw = (unsigned)wid * 1024u;
    const int aoff = lds_byte(wr * 64 + fr, fq * 8), boff = lds_byte(wc * 32 + fr, fq * 8);
#define PG8_SA(b, h) (((b) * 2 + (h)) * HTB)
#define PG8_SB(b, h) ((4 + (b) * 2 + (h)) * HTB)
#define PG8_STAGE(bufoff, gbase, voff) do { _Pragma("unroll") for (int _i = 0; _i < 2; ++_i) \
        __builtin_amdgcn_global_load_lds((const unsigned*)((const char*)(gbase) + (voff)[_i]), (PG8_LAS unsigned*)(lds + (bufoff) + ldsw + _i * 8192), 16, 0, 0); } while (0)
#define PG8_LDA(dst, b, h) do { _Pragma("unroll") for (int m = 0; m < 4; ++m) _Pragma("unroll") for (int k = 0; k < 2; ++k) dst[m][k] = *(const PG8_LAS bf16x8*)(lds + PG8_SA(b, h) + aoff + m * 2048 + k * 1024); } while (0)
#define PG8_LDB(dst, b, h) do { _Pragma("unroll") for (int n = 0; n < 2; ++n) _Pragma("unroll") for (int k = 0; k < 2; ++k) dst[n][k] = *(const PG8_LAS bf16x8*)(lds + PG8_SB(b, h) + boff + n * 2048 + k * 1024); } while (0)
#define PG8_MMA(ai, bj, At, Bt) do { __builtin_amdgcn_s_setprio(1); _Pragma("unroll") for (int m = 0; m < 4; ++m) _Pragma("unroll") for (int n = 0; n < 2; ++n) { \
        if constexpr (F8) { const i32x8 b8_ = __builtin_shufflevector((i32x4)Bt[n][0], (i32x4)Bt[n][1], 0, 1, 2, 3, 4, 5, 6, 7), a8_ = __builtin_shufflevector((i32x4)At[m][0], (i32x4)At[m][1], 0, 1, 2, 3, 4, 5, 6, 7); \
                            asm volatile("v_mfma_f32_16x16x128_f8f6f4 %0, %1, %2, %0" : "+v"(acc[ai][bj][m][n]) : "v"(b8_), "v"(a8_)); } \
        else { _Pragma("unroll") for (int k = 0; k < 2; ++k) acc[ai][bj][m][n] = __builtin_amdgcn_mfma_f32_16x16x32_bf16(Bt[n][k], At[m][k], acc[ai][bj][m][n], 0, 0, 0); } } \
        __builtin_amdgcn_s_setprio(0); } while (0)
#define PG8_WAIT_V(n) asm volatile("s_waitcnt vmcnt(" #n ")" ::: "memory")
#define PG8_WAIT_L(n) asm volatile("s_waitcnt lgkmcnt(" #n ")" ::: "memory")
#define PG8_BAR __builtin_amdgcn_s_barrier()
#define PG8_SCHED __builtin_amdgcn_sched_barrier(0)
    Unit cur, nxt; int ui = 0;
    if (!S.next(0, cur)) return;
    f32x4 acc[2][2][4][2];
#pragma unroll
    for (int a = 0; a < 2; ++a)
#pragma unroll
        for (int b = 0; b < 2; ++b)
#pragma unroll
            for (int m = 0; m < 4; ++m)
#pragma unroll
                for (int n = 0; n < 2; ++n) acc[a][b][m][n] = (f32x4){0.f, 0.f, 0.f, 0.f};
    bf16x8 At[4][2], B0[2][2], B1[2][2];
    const char* cA = (const char*)g.A + (size_t)cur.pm * tstepA + cur.aoff * 2; const char* cB = (const char*)g.Bt + (size_t)cur.pn * tstepB + cur.boff * 2;
    S.a_ready(cur);
    if constexpr (SP2) {
        PG8_STAGE(PG8_SB(0, 0), cB, voffB); PG8_STAGE(PG8_SB(0, 1), cB + hstepB, voffB); PG8_STAGE(PG8_SA(0, 0), cA, voffA); PG8_STAGE(PG8_SA(0, 1), cA + hstepA, voffA);
        if (wr == 1) PG8_BAR;
        PG8_WAIT_V(2); PG8_BAR;
        PG8_STAGE(PG8_SB(1, 0), cB + kstep, voffB); PG8_STAGE(PG8_SA(1, 0), cA + kstep, voffA); PG8_STAGE(PG8_SB(1, 1), cB + hstepB + kstep, voffB);
        PG8_WAIT_V(6); PG8_BAR;
    } else {
        PG8_STAGE(PG8_SB(0, 0), cB, voffB); PG8_STAGE(PG8_SA(0, 0), cA, voffA); PG8_STAGE(PG8_SB(0, 1), cB + hstepB, voffB); PG8_STAGE(PG8_SA(0, 1), cA + hstepA, voffA);
        if (wr == 1) PG8_BAR;
        PG8_WAIT_V(4); PG8_BAR;
        PG8_STAGE(PG8_SB(1, 0), cB + kstep, voffB); PG8_STAGE(PG8_SA(1, 0), cA + kstep, voffA); PG8_STAGE(PG8_SB(1, 1), cB + hstepB + kstep, voffB);
        PG8_WAIT_V(6); PG8_BAR;
    }
    for (;;) {
        const bool has_next = S.next(ui + 1, nxt);
        const char* nA = has_next ? (const char*)g.A + (size_t)nxt.pm * tstepA + nxt.aoff * 2 : cA; const char* nB = has_next ? (const char*)g.Bt + (size_t)nxt.pn * tstepB + nxt.boff * 2 : cB;
        for (int t = 0; t < nt; t += 2) {
            const bool last = (t == nt - 2);
            const char* a1 = cA + (size_t)(t + 1) * kstep;
            const char* a2 = last ? nA : cA + (size_t)(t + 2) * kstep; const char* b2 = last ? nB : cB + (size_t)(t + 2) * kstep;
            const char* a3 = a2 + kstep; const char* b3 = b2 + kstep;
            if (last && has_next) S.a_ready(nxt);
            if constexpr (SP2) {
            PG8_LDB(B0, 0, 0); PG8_LDB(B1, 0, 1); PG8_SCHED; PG8_LDA(At, 0, 0); PG8_STAGE(PG8_SA(1, 1), a1 + hstepA, voffA);
            PG8_WAIT_V(8); PG8_WAIT_L(0); PG8_BAR; PG8_MMA(0, 0, At, B0); PG8_MMA(0, 1, At, B1); PG8_BAR; PG8_SCHED;
            PG8_LDA(At, 0, 1); PG8_STAGE(PG8_SB(0, 0), b2, voffB); PG8_STAGE(PG8_SB(0, 1), b2 + hstepB, voffB); PG8_STAGE(PG8_SA(0, 0), a2, voffA);
            PG8_WAIT_V(8); PG8_WAIT_L(0); PG8_BAR; PG8_MMA(1, 0, At, B0); PG8_MMA(1, 1, At, B1); PG8_BAR; PG8_SCHED;
            PG8_LDB(B0, 1, 0); PG8_LDB(B1, 1, 1); PG8_SCHED; PG8_LDA(At, 1, 0); PG8_STAGE(PG8_SA(0, 1), a2 + hstepA, voffA);
            PG8_WAIT_V(8); PG8_WAIT_L(0); PG8_BAR; PG8_MMA(0, 0, At, B0); PG8_MMA(0, 1, At, B1); PG8_BAR; PG8_SCHED;
            PG8_LDA(At, 1, 1); PG8_STAGE(PG8_SB(1, 0), b3, voffB); PG8_STAGE(PG8_SB(1, 1), b3 + hstepB, voffB); PG8_STAGE(PG8_SA(1, 0), a3, voffA);
            PG8_WAIT_V(8); PG8_WAIT_L(0); PG8_BAR; PG8_MMA(1, 0, At, B0); PG8_MMA(1, 1, At, B1); PG8_BAR; PG8_SCHED;
            } else {
            PG8_LDB(B0, 0, 0); PG8_SCHED; PG8_LDA(At, 0, 0); PG8_STAGE(PG8_SA(1, 1), a1 + hstepA, voffA);
            PG8_WAIT_L(8); PG8_BAR; PG8_WAIT_L(0); PG8_MMA(0, 0, At, B0); PG8_BAR; PG8_SCHED;
            PG8_LDB(B1, 0, 1); PG8_STAGE(PG8_SB(0, 0), b2, voffB);
            PG8_BAR; PG8_WAIT_L(0); PG8_MMA(0, 1, At, B1); PG8_BAR;
            PG8_LDA(At, 0, 1); PG8_STAGE(PG8_SA(0, 0), a2, voffA);
            PG8_BAR; PG8_WAIT_L(0); PG8_MMA(1, 0, At, B0); PG8_BAR; PG8_SCHED;
            PG8_STAGE(PG8_SB(0, 1), b2 + hstepB, voffB);
            PG8_WAIT_V(6); PG8_BAR; PG8_MMA(1, 1, At, B1); PG8_BAR;
            PG8_LDB(B0, 1, 0); PG8_SCHED; PG8_LDA(At, 1, 0); PG8_STAGE(PG8_SA(0, 1), a2 + hstepA, voffA);
            PG8_WAIT_L(8); PG8_BAR; PG8_WAIT_L(0); PG8_MMA(0, 0, At, B0); PG8_BAR; PG8_SCHED;
            PG8_LDB(B1, 1, 1); PG8_STAGE(PG8_SB(1, 0), b3, voffB);
            PG8_BAR; PG8_WAIT_L(0); PG8_MMA(0, 1, At, B1); PG8_BAR;
            PG8_LDA(At, 1, 1); PG8_STAGE(PG8_SA(1, 0), a3, voffA);
            PG8_BAR; PG8_WAIT_L(0); PG8_MMA(1, 0, At, B0); PG8_BAR; PG8_SCHED;
            PG8_STAGE(PG8_SB(1, 1), b3 + hstepB, voffB);
            PG8_WAIT_V(6); PG8_BAR; PG8_MMA(1, 1, At, B1); PG8_BAR;
            }
        }
        if constexpr (F8) asm volatile("s_nop 15\n\ts_nop 15\n\ts_nop 15\n\ts_nop 15" ::: "memory");
        if constexpr (ALIGN_EPI) { if (wr == 0) PG8_BAR; }
        if constexpr (!Epi::AFTER_DRAIN) { E(acc, cur, wr, wc, fr, fq); S.done(cur); }
        if (!has_next) break;
#pragma unroll
        for (int a = 0; a < 2; ++a)
#pragma unroll
            for (int b = 0; b < 2; ++b)
#pragma unroll
                for (int m = 0; m < 4; ++m)
#pragma unroll
                    for (int n = 0; n < 2; ++n) acc[a][b][m][n] = (f32x4){0.f, 0.f, 0.f, 0.f};
        cur = nxt; cA = nA; cB = nB; ++ui;
        if constexpr (ALIGN_EPI) { if (wr == 1) PG8_BAR; }
    }
    PG8_WAIT_V(0);
    if constexpr (!ALIGN_EPI) { if (wr == 0) PG8_BAR; }
    PG8_BAR;
    if constexpr (Epi::AFTER_DRAIN) { E.fused(acc, cur, wr, wc, fr, fq, lds, wid, lane); S.done(cur); }
#undef PG8_SA
#undef PG8_SB
#undef PG8_STAGE
#undef PG8_LDA
#undef PG8_LDB
#undef PG8_MMA
#undef PG8_WAIT_V
#undef PG8_WAIT_L
#undef PG8_BAR
#undef PG8_SCHED
}
}

struct EpiStore {
    static constexpr bool PERM = true, AFTER_DRAIN = false;
    u16* O; int ldc; int act; const float* rs;
    float osc = 1.f;
    __device__ __forceinline__ void operator()(const pg8::f32x4 (&acc)[2][2][4][2], const pg8::Unit& u, int wr, int wc, int fr, int fq) const {
        int fr_ = fr, fq_ = fq; asm volatile("" : "+v"(fr_), "+v"(fq_));
        const int row0 = u.pm * 256 + wr * 64 + fr_;
        u16* base = O + u.coff + (size_t)(u.pm * 256) * ldc + u.pn * 256;
        const int loff0 = (wr * 64 + fr_) * ldc + wc * 32 + 8 * fq_;
#pragma unroll
        for (int ai = 0; ai < 2; ++ai)
#pragma unroll
            for (int m = 0; m < 4; ++m) { u16* rowp = base + (loff0 + (ai * 128 + m * 16) * ldc);
                const float rsc = rs ? rs[row0 + ai * 128 + m * 16] : osc;
#pragma unroll
                for (int bj = 0; bj < 2; ++bj) { pg8::f32x4 v0 = acc[ai][bj][m][0] * rsc, v1 = acc[ai][bj][m][1] * rsc;
                    if (act == 1) {
#pragma unroll
                        for (int r = 0; r < 4; ++r) { const float a = fmaxf(v0[r], 0.f), b = fmaxf(v1[r], 0.f); v0[r] = a * a; v1[r] = b * b; }
                    }
                    pg8::u32x4 w; w.x = pg8::cvt_pk_bf16(v0[0], v0[1]); w.y = pg8::cvt_pk_bf16(v0[2], v0[3]); w.z = pg8::cvt_pk_bf16(v1[0], v1[1]); w.w = pg8::cvt_pk_bf16(v1[2], v1[3]);
                    *(pg8::u32x4*)(rowp + bj * 128) = w; } }
    }
};
struct EpiStoreF8 {
    static constexpr bool PERM = true, AFTER_DRAIN = false;
    unsigned char* O; int ldc; const float* rs;
    __device__ __forceinline__ void operator()(const pg8::f32x4 (&acc)[2][2][4][2], const pg8::Unit& u, int wr, int wc, int fr, int fq) const {
        int fr_ = fr, fq_ = fq; asm volatile("" : "+v"(fr_), "+v"(fq_));
        const int row0 = u.pm * 256 + wr * 64 + fr_;
        unsigned char* base = O + (size_t)(u.pm * 256) * ldc + u.pn * 256;
        const int loff0 = (wr * 64 + fr_) * ldc + wc * 32 + 8 * fq_;
#pragma unroll
        for (int ai = 0; ai < 2; ++ai)
#pragma unroll
            for (int m = 0; m < 4; ++m) { unsigned char* rowp = base + (loff0 + (ai * 128 + m * 16) * ldc);
                const float rsc = rs[row0 + ai * 128 + m * 16] * 2.8284271247461903f;
#pragma unroll
                for (int bj = 0; bj < 2; ++bj) { pg8::f32x4 v0 = acc[ai][bj][m][0] * rsc, v1 = acc[ai][bj][m][1] * rsc;
#pragma unroll
                    for (int r = 0; r < 4; ++r) { const float a = fmaxf(v0[r], 0.f), b = fmaxf(v1[r], 0.f); v0[r] = fminf(a * a, 448.f); v1[r] = fminf(b * b, 448.f); }
                    int lo8 = __builtin_amdgcn_cvt_pk_fp8_f32(v0[0], v0[1], 0, false); lo8 = __builtin_amdgcn_cvt_pk_fp8_f32(v0[2], v0[3], lo8, true);
                    int hi8 = __builtin_amdgcn_cvt_pk_fp8_f32(v1[0], v1[1], 0, false); hi8 = __builtin_amdgcn_cvt_pk_fp8_f32(v1[2], v1[3], hi8, true);
                    uint2 w; w.x = (unsigned)lo8; w.y = (unsigned)hi8;
                    *(uint2*)(rowp + bj * 128) = w; } }
    }
};
template <int TYPE> struct PreOrder {
    int G, c, l;
    __device__ __forceinline__ bool next(int i, pg8::Unit& u) const {
        const int id = i * G + c; if (id >= 128) return false;
        const int pt = id & 3, h = (id >> 2) & 3, b = id >> 4;
        if (TYPE == 0) { u.pm = 0; u.pn = pt; u.aoff = (long)l * 2048 * 2048 + (long)(b * 256) * 2048 + h * 256; u.boff = (long)l * DM * DM + h * 256;
                         u.coff = ((long)b * 1024 + h * 256) * 1024; }
        else { u.pm = pt; u.pn = 0; u.aoff = (long)l * DM * DM + h * 256; u.boff = (long)l * 2048 * 2048 + (long)(b * 256) * 2048 + 1024 + h * 256;
               u.coff = (long)b * 1024 * 1024 + h * 256; }
        return true;
    }
    __device__ __forceinline__ void a_ready(const pg8::Unit&) const {}
    __device__ __forceinline__ void done(const pg8::Unit&) const {}
};
struct KvOrder {
    int G, c;
    __device__ __forceinline__ bool next(int i, pg8::Unit& u) const {
        const int id = i * G + c; if (id >= 128) return false;
        const int l = id >> 6, r = id & 63;
        u.pm = r >> 3; u.pn = r & 7; u.aoff = (long)l * 2048 * DM; u.boff = (long)l * 2048 * DM; u.coff = (long)l * 2048 * 2048; return true;
    }
    __device__ __forceinline__ void a_ready(const pg8::Unit&) const {}
    __device__ __forceinline__ void done(const pg8::Unit&) const {}
};
struct BatchBOrder : pg8::StaticOrder {
    __device__ __forceinline__ bool next(int i, pg8::Unit& u) const { if (!pg8::StaticOrder::next(i, u)) return false; u.boff = (long)(u.pm >> 4) * (1024 * 1024); return true; }
};
struct EpiSoftmax {
    static constexpr bool PERM = true, AFTER_DRAIN = false;
    u16* O; int ldc; const float* rs; PG8_LAS float* xl;
    __device__ __forceinline__ void operator()(pg8::f32x4 (&acc)[2][2][4][2], const pg8::Unit& u, int wr, int wc, int fr, int fq) const {
        int fr_ = fr, fq_ = fq; asm volatile("" : "+v"(fr_), "+v"(fq_));
        const int row0 = u.pm * 256 + wr * 64 + fr_;
        u16* base = O + (size_t)(u.pm * 256) * ldc + u.pn * 256;
        const int loff0 = (wr * 64 + fr_) * ldc + wc * 32 + 8 * fq_;
        float mown[2][4];
#pragma unroll
        for (int ai = 0; ai < 2; ++ai)
#pragma unroll
            for (int m = 0; m < 4; ++m) {
                const float rsc = rs[row0 + ai * 128 + m * 16] * (0.0625f * 1.4426950408889634f);
                float mx = -INFINITY;
#pragma unroll
                for (int bj = 0; bj < 2; ++bj)
#pragma unroll
                    for (int n = 0; n < 2; ++n) { acc[ai][bj][m][n] = acc[ai][bj][m][n] * rsc;
#pragma unroll
                        for (int r = 0; r < 4; ++r) mx = fmaxf(mx, acc[ai][bj][m][n][r]); }
                mx = fmaxf(mx, __shfl_xor(mx, 16)); mx = fmaxf(mx, __shfl_xor(mx, 32));
                float l = 0.f;
#pragma unroll
                for (int bj = 0; bj < 2; ++bj)
#pragma unroll
                    for (int n = 0; n < 2; ++n)
#pragma unroll
                        for (int r = 0; r < 4; ++r) { const float e = __builtin_amdgcn_exp2f(acc[ai][bj][m][n][r] - mx); acc[ai][bj][m][n][r] = e; l += e; }
                l += __shfl_xor(l, 16); l += __shfl_xor(l, 32);
                mown[ai][m] = mx;
                if (fq_ == 0) { PG8_LAS float* x = xl + ((ai * 128 + wr * 64 + m * 16 + fr_) * 4 + wc) * 2; x[0] = mx; x[1] = l; }
            }
        asm volatile("s_waitcnt lgkmcnt(0)" ::: "memory"); __builtin_amdgcn_s_barrier(); asm volatile("" ::: "memory");
#pragma unroll
        for (int ai = 0; ai < 2; ++ai)
#pragma unroll
            for (int m = 0; m < 4; ++m) {
                const PG8_LAS pg8::f32x4* x = (const PG8_LAS pg8::f32x4*)(xl + (ai * 128 + wr * 64 + m * 16 + fr_) * 8);
                const pg8::f32x4 x0 = x[0], x1 = x[1];
                const float M = fmaxf(fmaxf(x0[0], x0[2]), fmaxf(x1[0], x1[2]));
                const float L = x0[1] * __builtin_amdgcn_exp2f(x0[0] - M) + x0[3] * __builtin_amdgcn_exp2f(x0[2] - M) + x1[1] * __builtin_amdgcn_exp2f(x1[0] - M) + x1[3] * __builtin_amdgcn_exp2f(x1[2] - M);
                const float f = __builtin_amdgcn_exp2f(mown[ai][m] - M) / L;
                u16* rowp = base + (loff0 + (ai * 128 + m * 16) * ldc);
#pragma unroll
                for (int bj = 0; bj < 2; ++bj) { const pg8::f32x4 v0 = acc[ai][bj][m][0] * f, v1 = acc[ai][bj][m][1] * f;
                    pg8::u32x4 w; w.x = pg8::cvt_pk_bf16(v0[0], v0[1]); w.y = pg8::cvt_pk_bf16(v0[2], v0[3]); w.z = pg8::cvt_pk_bf16(v1[0], v1[1]); w.w = pg8::cvt_pk_bf16(v1[2], v1[3]);
                    *(pg8::u32x4*)(rowp + bj * 128) = w; }
            }
    }
};
struct EpiRope {
    static constexpr bool PERM = true, AFTER_DRAIN = false;
    u16* Z; u16* KB; u16* VB; u16* KI; const float* rs; const float2* rope;
    __device__ __forceinline__ void operator()(const pg8::f32x4 (&acc)[2][2][4][2], const pg8::Unit& u, int wr, int wc, int fr, int fq) const {
        int fr_ = fr, fq_ = fq; asm volatile("" : "+v"(fr_), "+v"(fq_));
#pragma unroll
        for (int ai = 0; ai < 2; ++ai)
#pragma unroll
            for (int m = 0; m < 4; ++m) {
                const int row = u.pm * 256 + ai * 128 + wr * 64 + m * 16 + fr_;
                const float rsc = rs[row];
#pragma unroll
                for (int bj = 0; bj < 2; ++bj) {
                    const int col = u.pn * 256 + bj * 128 + wc * 32 + 8 * fq_;
                    const pg8::f32x4 a0 = acc[ai][bj][m][0] * rsc, a1 = acc[ai][bj][m][1] * rsc;
                    float v[8] = {a0[0], a0[1], a0[2], a0[3], a1[0], a1[1], a1[2], a1[3]};
                    const bool is_v = (u.pn == 4 && bj == 1), is_tail = (u.pn == 7) && (bj == 1 || wc >= 2);
                    if (!is_v && !is_tail) {
                        const bool small = u.pn >= 5;
                        const int lc = small ? (col & 63) : (col & 127), i0 = lc >> 1;
                        const float2* tp = rope + (size_t)row * 64 + (small ? 2 * i0 : i0);
#pragma unroll
                        for (int e = 0; e < 4; ++e) {
                            const float2 cs = tp[small ? 2 * e : e];
                            const float x1 = v[2 * e], x2 = v[2 * e + 1];
                            v[2 * e] = x1 * cs.x - x2 * cs.y; v[2 * e + 1] = x2 * cs.x + x1 * cs.y;
                        }
                    }
                    pg8::u32x4 w; w.x = pg8::cvt_pk_bf16(v[0], v[1]); w.y = pg8::cvt_pk_bf16(v[2], v[3]); w.z = pg8::cvt_pk_bf16(v[4], v[5]); w.w = pg8::cvt_pk_bf16(v[6], v[7]);
                    if (u.pn < 4 || u.pn == 5 || u.pn == 6) *(pg8::u32x4*)(Z + (size_t)row * ZP1 + col) = w;
                    else if (u.pn == 4) { if (bj == 0) *(pg8::u32x4*)(KB + (size_t)row * 128 + (col - 1024)) = w; else *(pg8::u32x4*)(VB + (size_t)row * 128 + (col - 1152)) = w; }
                    else {
                        if (bj == 0 && wc < 2) { const int d = col - 1792, s = row & 4095, bb = row >> 12;
                            *(pg8::u32x4*)(KI + ((size_t)bb * 128 + (s >> 5)) * 2048 + ((d >> 4) * 2 + ((d >> 3) & 1)) * 256 + (s & 31) * 8) = w; }
                        else if (bj == 0 && wc == 2 && fq_ == 0) {
                            pg8::u32x4 ww; ww.x = pg8::cvt_pk_bf16(v[0] * 0.35355339059327373f, v[1] * 0.35355339059327373f); ww.y = pg8::cvt_pk_bf16(v[2] * 0.35355339059327373f, v[3] * 0.35355339059327373f);
                            ww.z = pg8::cvt_pk_bf16(v[4] * 0.35355339059327373f, v[5] * 0.35355339059327373f); ww.w = pg8::cvt_pk_bf16(v[6] * 0.35355339059327373f, v[7] * 0.35355339059327373f);
                            *(pg8::u32x4*)(Z + (size_t)row * ZP1 + 1856) = ww; }
                    }
                }
            }
    }
};
__device__ __forceinline__ void gemm8(const u16* A, const u16* Bt, int M, int N, int K, u16* C, int ldc, int act, const float* rs, unsigned char* smem) {
    pg8::Gemm g{A, Bt, M, N, K, K, K}; pg8::StaticOrder S; S.init(M, N, (int)gridDim.x, (int)blockIdx.x);
    EpiStore E{C, ldc, act, rs};
    pg8::gemm_phase<EpiStore, pg8::StaticOrder, true, true>((PG8_LAS unsigned char*)smem, g, S, E);
}

__device__ __forceinline__ int rope_col_perm(int n) {
    if (n < 1152) { const int d = n & 127; return (n & ~127) + 2 * (d & 63) + (d >> 6); }
    if (n < 1280 || n >= 1856) return n;
    const int d = (n - 1280) & 63; return n - d + 2 * (d & 31) + (d >> 5);
}
template <bool ROPE_PERM = false, bool F8 = false>
__device__ __forceinline__ void transpose_item(const float* W, int K, int N, u16* WT, LAS3 unsigned char* scr, int item, int lane, int nblk, const float* gain) {
    const int kb = item / nblk, nb = item % nblk, k0 = 64 * kb, n0 = 64 * nb;
    { const int kr = lane >> 4; int n = n0 + (lane & 15) * 4; if (n + 3 >= N) n = 0;
      const float* src = W + (size_t)(k0 + kr) * N + n;
#pragma unroll 1
      for (int i = 0; i < 16; ++i) { __builtin_amdgcn_global_load_lds((const unsigned*)src, (LAS3 unsigned*)(scr + i * 1040), 16, 0, 0); src += (size_t)4 * N; } }
    const int c = lane & 7;
    float gk[8];
#pragma unroll
    for (int e = 0; e < 8; ++e) gk[e] = F8 ? 256.f : (gain ? gain[k0 + 8 * c + e] : 1.f);
    asm volatile("s_waitcnt vmcnt(0)" ::: "memory");
#pragma unroll
    for (int j = 0; j < 8; ++j) { const int nn = (lane >> 3) + 8 * j;
        const LAS3 float* s = (const LAS3 float*)(scr + (2 * c) * 1040 + nn * 4);
        float v[8];
#pragma unroll
        for (int e = 0; e < 8; ++e) v[e] = *(const LAS3 float*)((const LAS3 unsigned char*)s + (e >> 2) * 1040 + (e & 3) * 256) * gk[e];
        if constexpr (F8) {
            int lo8 = __builtin_amdgcn_cvt_pk_fp8_f32(v[0], v[1], 0, false); lo8 = __builtin_amdgcn_cvt_pk_fp8_f32(v[2], v[3], lo8, true);
            int hi8 = __builtin_amdgcn_cvt_pk_fp8_f32(v[4], v[5], 0, false); hi8 = __builtin_amdgcn_cvt_pk_fp8_f32(v[6], v[7], hi8, true);
            uint2 o8; o8.x = (unsigned)lo8; o8.y = (unsigned)hi8;
            *(uint2*)((unsigned char*)WT + (size_t)(n0 + nn) * K + k0 + 8 * c) = o8;
        } else {
        uint4 o; o.x = pk2(v[0], v[1]); o.y = pk2(v[2], v[3]); o.z = pk2(v[4], v[5]); o.w = pk2(v[6], v[7]);
        if (n0 + nn >= N) o = make_uint4(0u, 0u, 0u, 0u);
        *(uint4*)(WT + (size_t)(ROPE_PERM ? rope_col_perm(n0 + nn) : (n0 + nn)) * K + k0 + 8 * c) = o; } }
    WAVE_SYNC();
}
__device__ __forceinline__ void weight_cast(const float* W, int K, int N, u16* out, const float* gain) {
    const int tid = tid_opaque(); const size_t gt = (size_t)blockIdx.x * NT + tid, gs = (size_t)gridDim.x * NT, tot = (size_t)K * N / 4;
    for (size_t i = gt; i < tot; i += gs) {
        const float4 v = ((const float4*)W)[i]; const float gk = gain[(i * 4) / N];
        uint2 o; o.x = pk2(v.x * gk, v.y * gk); o.y = pk2(v.z * gk, v.w * gk);
        ((uint2*)out)[i] = o;
    }
}
template <bool ROPE_PERM = false, bool F8 = false>
__device__ __forceinline__ void weight_prep(const float* W, int K, int N, int Npad, u16* WT, unsigned char* smem, const float* gain = nullptr) {
    const int tid = tid_opaque(), lane = tid & 63, wid = tid >> 6, gw = (blockIdx.x * NT + tid) >> 6, ngw = (gridDim.x * NT) >> 6;
    LAS3 unsigned char* scr = (LAS3 unsigned char*)smem + wid * 16640;
    const int nblk = Npad / 64, items = (K / 64) * nblk;
    for (int it = gw; it < items; it += ngw) transpose_item<ROPE_PERM, F8>(W, K, N, WT, scr, it, lane, nblk, gain);
}

typedef float f32x16 __attribute__((ext_vector_type(16)));
typedef short s16x4 __attribute__((ext_vector_type(4)));
typedef unsigned u32x4v __attribute__((ext_vector_type(4)));
constexpr int XK_PITCH = 528, XV_PITCH = 576;
__device__ __forceinline__ s16x4 lds_tr16(unsigned addr) {
    return __builtin_bit_cast(s16x4, __builtin_amdgcn_ds_read_tr16_b64_v4i16((LAS3 s16x4*)(uintptr_t)addr));
}

__device__ __forceinline__ float gelu_fast(float x) {
    const float u = 0.7978845608028654f * (x + 0.044715f * x * x * x);
    return x * __builtin_amdgcn_rcpf(1.f + __builtin_amdgcn_exp2f(-2.8853900817779268f * u));
}
constexpr int MV_PITCH = 320, MP_PITCH = 272;
__device__ __forceinline__ void mixer_a_all(const Params& p, unsigned char* smem) {
    const int tid = tid_opaque(), lane = tid & 63, wid = __builtin_amdgcn_readfirstlane(tid >> 6), r32 = lane & 31, hi = lane >> 5, l15 = lane & 15, g4 = lane >> 4;
    LAS3 unsigned char* lds = (LAS3 unsigned char*)smem;
    const unsigned lds0 = (unsigned)(uintptr_t)lds;
    const u16* Z = (const u16*)(p.ws + WS_Z); u16* MIX = (u16*)(p.ws + WS_MIX);
    const int ct = wid & 3, tb0 = wid >> 2;
    int unit = blockIdx.x;
    if (unit >= 1024) return;
    u32x4v vraw[4];
#pragma unroll
    for (int i = 0; i < 4; ++i) vraw[i] = *(const u32x4v*)(Z + ((size_t)(unit >> 2) * 128 + wid * 16 + 4 * i + g4) * EVEN_IN + 512 + (unit & 3) * 128 + l15 * 8);
    int gcur = -1;
    bf16x8 wfr[2][8]; float4 ga, gb; float biasj[2];
#pragma unroll 1
    for (; unit < 1024; unit += gridDim.x) {
    const int g = unit & 3, bn = unit >> 2;
    const size_t row0 = (size_t)bn * 128;
    if (g != gcur) {
        gcur = g;
        const u16* Wc = (const u16*)(p.ws + WS_WC) + (size_t)g * 16384;
#pragma unroll
        for (int j = 0; j < 2; ++j)
#pragma unroll
            for (int ks = 0; ks < 8; ++ks) wfr[j][ks] = *(const bf16x8*)(Wc + (32 * (tb0 + 2 * j) + r32) * 128 + 16 * ks + 8 * hi);
        ga = *(const float4*)(p.sgu_g + g * 128 + l15 * 8); gb = *(const float4*)(p.sgu_g + g * 128 + l15 * 8 + 4);
#pragma unroll
        for (int j = 0; j < 2; ++j) biasj[j] = p.sgu_bs[g * 128 + 32 * (tb0 + 2 * j) + r32];
    }
    uint2 uraw[2][4];
#pragma unroll
    for (int j = 0; j < 2; ++j) {
        const int t = 32 * (tb0 + 2 * j) + r32;
#pragma unroll
        for (int rq = 0; rq < 4; ++rq) uraw[j][rq] = *(const uint2*)(Z + (row0 + t) * EVEN_IN + g * 128 + 32 * ct + 4 * hi + 8 * rq);
    }
    __syncthreads();
    {
#pragma unroll
        for (int i = 0; i < 4; ++i) {
            const int s = wid * 16 + 4 * i + g4;
            const u32x4v w = vraw[i];
            const float a0 = gelu_fast(bflo(w.x)), a1 = gelu_fast(bfhi(w.x)), a2 = gelu_fast(bflo(w.y)), a3 = gelu_fast(bfhi(w.y)),
                        a4 = gelu_fast(bflo(w.z)), a5 = gelu_fast(bfhi(w.z)), a6 = gelu_fast(bflo(w.w)), a7 = gelu_fast(bfhi(w.w));
            const float rstd = rsqrtf(rsum16(a0 * a0 + a1 * a1 + a2 * a2 + a3 * a3 + a4 * a4 + a5 * a5 + a6 * a6 + a7 * a7) * (1.f / 128.f) + EPS);
            u32x4v o;
            o.x = pk2hw(a0 * rstd * ga.x, a1 * rstd * ga.y); o.y = pk2hw(a2 * rstd * ga.z, a3 * rstd * ga.w);
            o.z = pk2hw(a4 * rstd * gb.x, a5 * rstd * gb.y); o.w = pk2hw(a6 * rstd * gb.z, a7 * rstd * gb.w);
            *(LAS3 u32x4v*)(lds + s * MV_PITCH + l15 * 16) = o;
        }
    }
    { const int un = unit + (int)gridDim.x;
      if (un < 1024) {
#pragma unroll
          for (int i = 0; i < 4; ++i) vraw[i] = *(const u32x4v*)(Z + ((size_t)(un >> 2) * 128 + wid * 16 + 4 * i + g4) * EVEN_IN + 512 + (un & 3) * 128 + l15 * 8);
      } }
    __syncthreads();
    f32x16 acc[2];
#pragma unroll
    for (int j = 0; j < 2; ++j)
#pragma unroll
        for (int r = 0; r < 16; ++r) acc[j][r] = 0.f;
    const unsigned va = lds0 + (8 * hi + (l15 >> 2)) * MV_PITCH + (32 * ct + 16 * (g4 & 1) + 4 * (l15 & 3)) * 2;
#pragma unroll
    for (int ks = 0; ks < 8; ++ks) {
        const s16x4 lo = lds_tr16(va + 16 * ks * MV_PITCH), hh = lds_tr16(va + (16 * ks + 4) * MV_PITCH);
        const bf16x8 vf = (bf16x8){lo[0], lo[1], lo[2], lo[3], hh[0], hh[1], hh[2], hh[3]};
#pragma unroll
        for (int j = 0; j < 2; ++j) acc[j] = __builtin_amdgcn_mfma_f32_32x32x16_bf16(vf, wfr[j][ks], acc[j], 0, 0, 0);
    }
#pragma unroll
    for (int j = 0; j < 2; ++j) {
        const int t = 32 * (tb0 + 2 * j) + r32;
        const float bias = biasj[j];
        u16* o = MIX + (row0 + t) * DM + g * 128 + 32 * ct + 4 * hi;
#pragma unroll
        for (int rq = 0; rq < 4; ++rq) {
            const uint2 uw = uraw[j][rq];
            uint2 ow;
            ow.x = pk2(gelu_fast(bflo(uw.x)) * (acc[j][4 * rq + 0] + bias), gelu_fast(bfhi(uw.x)) * (acc[j][4 * rq + 1] + bias));
            ow.y = pk2(gelu_fast(bflo(uw.y)) * (acc[j][4 * rq + 2] + bias), gelu_fast(bfhi(uw.y)) * (acc[j][4 * rq + 3] + bias));
            *(uint2*)(o + 8 * rq) = ow;
        }
    }
    }
}
__device__ __forceinline__ void mixer_b_all(const Params& p, unsigned char* smem) {
    const int tid = tid_opaque(), lane = tid & 63, wid = __builtin_amdgcn_readfirstlane(tid >> 6), r32 = lane & 31, hi = lane >> 5;
    LAS3 unsigned char* lds = (LAS3 unsigned char*)smem;
    LAS3 unsigned char* Ps = lds + 144 * 256;
    const u16* Z = (const u16*)(p.ws + WS_Z); u16* MIX = (u16*)(p.ws + WS_MIX);
    const int dt = wid & 3, tb0 = wid >> 2;
    int unit = (int)blockIdx.x;
    while (unit < 1024) unit += (int)gridDim.x;
    unit -= 1024;
    if (unit >= 1024) return;
    u32x4v hraw[5];
#define MIXB_LOAD_HALO(UN) { const int g_ = (UN) & 3, bn_ = (UN) >> 2, n_ = bn_ & 31; \
        _Pragma("unroll") for (int i = 0; i < 5; ++i) { \
            const int idx = tid + NT * i, r = idx >> 4, c16 = idx & 15; const int tt = n_ * 128 - 16 + r; \
            hraw[i] = (u32x4v){0u, 0u, 0u, 0u}; \
            if (idx < 144 * 16 && tt >= 0) hraw[i] = *(const u32x4v*)(Z + ((size_t)bn_ * 128 - 16 + r) * EVEN_IN + 1024 + g_ * 128 + c16 * 8); } }
    MIXB_LOAD_HALO(unit)
    int gcur = -1;
    bf16x8 pfr[8]; float4 psc[4];
#pragma unroll 1
    for (; unit < 1024; unit += gridDim.x) {
    const int g = unit & 3, bn = unit >> 2, n = bn & 31;
    const size_t row0 = (size_t)bn * 128;
    const int w = 2 << g;
    if (g != gcur) {
        gcur = g;
        const u16* pwT = (const u16*)(p.ws + WS_PWT) + (size_t)g * 16384;
#pragma unroll
        for (int ks = 0; ks < 8; ++ks) pfr[ks] = *(const bf16x8*)(pwT + (32 * dt + r32) * 128 + 16 * ks + 8 * hi);
#pragma unroll
        for (int rq = 0; rq < 4; ++rq) psc[rq] = *(const float4*)(p.pool_scale + g * 128 + 32 * dt + 4 * hi + 8 * rq);
    }
    __syncthreads();
#pragma unroll
    for (int i = 0; i < 5; ++i) {
        const int idx = tid + NT * i, r = idx >> 4, c16 = idx & 15;
        if (idx < 144 * 16) *(LAS3 u32x4v*)(lds + r * 256 + c16 * 16) = hraw[i];
    }
    { const int un = unit + (int)gridDim.x; if (un < 1024) MIXB_LOAD_HALO(un) }
    __syncthreads();
#pragma unroll
    for (int i = 0; i < 4; ++i) {
        const int idx = tid + NT * i, t = idx >> 4, c16 = idx & 15; const int tt = n * 128 + t;
        const int cnt = (tt + 1 < w) ? (tt + 1) : w;
        float s[8];
#pragma unroll
        for (int e = 0; e < 8; ++e) s[e] = 0.f;
        u32x4v x0 = (u32x4v){0u, 0u, 0u, 0u};
        for (int k = 0; k < w; ++k) {
            const u32x4v v = *(const LAS3 u32x4v*)(lds + (16 + t - k) * 256 + c16 * 16);
            if (k == 0) x0 = v;
            s[0] += bflo(v.x); s[1] += bfhi(v.x); s[2] += bflo(v.y); s[3] += bfhi(v.y); s[4] += bflo(v.z); s[5] += bfhi(v.z); s[6] += bflo(v.w); s[7] += bfhi(v.w);
        }
        const float ic = 1.f / (float)cnt;
        u32x4v o;
        o.x = pk2(s[0] * ic - bflo(x0.x), s[1] * ic - bfhi(x0.x)); o.y = pk2(s[2] * ic - bflo(x0.y), s[3] * ic - bfhi(x0.y));
        o.z = pk2(s[4] * ic - bflo(x0.z), s[5] * ic - bfhi(x0.z)); o.w = pk2(s[6] * ic - bflo(x0.w), s[7] * ic - bfhi(x0.w));
        *(LAS3 u32x4v*)(Ps + t * MP_PITCH + c16 * 16) = o;
    }
    __syncthreads();
    f32x16 acc[2];
#pragma unroll
    for (int j = 0; j < 2; ++j)
#pragma unroll
        for (int r = 0; r < 16; ++r) acc[j][r] = 0.f;
#pragma unroll
    for (int ks = 0; ks < 8; ++ks)
#pragma unroll
        for (int j = 0; j < 2; ++j) {
            const bf16x8 bfrag = *(const LAS3 bf16x8*)(Ps + (32 * (tb0 + 2 * j) + r32) * MP_PITCH + (16 * ks + 8 * hi) * 2);
            acc[j] = __builtin_amdgcn_mfma_f32_32x32x16_bf16(pfr[ks], bfrag, acc[j], 0, 0, 0);
        }
#pragma unroll
    for (int j = 0; j < 2; ++j) {
        const int t = 32 * (tb0 + 2 * j) + r32;
        u16* o = MIX + (row0 + t) * DM + 512 + g * 128 + 32 * dt + 4 * hi;
#pragma unroll
        for (int rq = 0; rq < 4; ++rq) {
            const float4 s4 = psc[rq];
            uint2 ow; ow.x = pk2(acc[j][4 * rq + 0] * s4.x, acc[j][4 * rq + 1] * s4.y); ow.y = pk2(acc[j][4 * rq + 2] * s4.z, acc[j][4 * rq + 3] * s4.w);
            *(uint2*)(o + 8 * rq) = ow;
        }
    }
    }
#undef MIXB_LOAD_HALO
}

__device__ __forceinline__ void xattn_phase(const Params& p, int layer, unsigned char* smem) {
    LAS3 unsigned char* lds = (LAS3 unsigned char*)smem;
    const unsigned lds0 = (unsigned)(uintptr_t)lds;
    const u16* Q = (const u16*)(p.ws + WS_Q); const u16* KV = (const u16*)(p.ws + WS_KV) + (size_t)layer * 2048 * 2048;
    u16* MIX = (u16*)(p.ws + WS_MIX);
    for (int unit = blockIdx.x; unit < 512; unit += gridDim.x) {
        int tid = threadIdx.x; asm volatile("" : "+v"(tid));
        const int lane = tid & 63, wid = tid >> 6, r32 = lane & 31, hi = lane >> 5;
        const int qb = unit & 15, h = (unit >> 4) & 3, b = unit >> 6;
        const int m0 = b * SEQ + qb * 256 + wid * 32;
        bf16x8 qf[8];
        const u16* qrow = Q + (size_t)(m0 + r32) * DM + h * 256 + hi * 8;
#pragma unroll
        for (int ks = 0; ks < 8; ++ks) qf[ks] = *(const bf16x8*)(qrow + ks * 16);
        __syncthreads();
#pragma unroll 4
        for (int i = 0; i < 16; ++i) { const int idx = tid + 512 * i, key = idx >> 5, c = idx & 31;
            const u32x4v v = *(const u32x4v*)(KV + (size_t)(b * 256 + key) * 2048 + h * 256 + c * 8);
            *(LAS3 u32x4v*)(lds + key * XK_PITCH + c * 16) = v; }
        __syncthreads();
        f32x16 st[8];
#pragma unroll
        for (int kt = 0; kt < 8; ++kt)
#pragma unroll
            for (int r = 0; r < 16; ++r) st[kt][r] = 0.f;
#pragma unroll
        for (int dh = 0; dh < 2; ++dh) {
            if (dh == 1) {
                asm volatile("" ::: "memory");
#pragma unroll
                for (int ks = 0; ks < 8; ++ks) qf[ks] = *(const bf16x8*)(qrow + 128 + ks * 16);
            }
#pragma unroll
            for (int ks = 0; ks < 8; ++ks)
#pragma unroll
                for (int kt = 0; kt < 8; ++kt) {
                    const bf16x8 kf = *(const LAS3 bf16x8*)(lds + (32 * kt + r32) * XK_PITCH + (2 * (dh * 8 + ks) + hi) * 16);
                    st[kt] = __builtin_amdgcn_mfma_f32_32x32x16_bf16(kf, qf[ks], st[kt], 0, 0, 0);
                }
            asm volatile("" ::: "memory");
        }
        float mx = -INFINITY;
#pragma unroll
        for (int kt = 0; kt < 8; ++kt)
#pragma unroll
            for (int r = 0; r < 16; ++r) mx = fmaxf(mx, st[kt][r]);
        mx = fmaxf(mx, __shfl_xor(mx, 32));
        const float cs = 0.0625f * 1.4426950408889634f;
        float sum = 0.f; unsigned pk[8][8];
#pragma unroll
        for (int kt = 0; kt < 8; ++kt)
#pragma unroll
            for (int r = 0; r < 8; ++r) {
                const float p0 = exp2f((st[kt][2 * r] - mx) * cs), p1 = exp2f((st[kt][2 * r + 1] - mx) * cs);
                sum += p0 + p1; pk[kt][r] = pk2(p0, p1);
            }
        sum += __shfl_xor(sum, 32);
        const float inv = 1.f / sum;
        __syncthreads();
#pragma unroll 4
        for (int i = 0; i < 16; ++i) { const int idx = tid + 512 * i, key = idx >> 5, c = idx & 31;
            const u32x4v v = *(const u32x4v*)(KV + (size_t)(b * 256 + key) * 2048 + 1024 + h * 256 + c * 8);
            *(LAS3 u32x4v*)(lds + key * XV_PITCH + c * 16) = v; }
        __syncthreads();
        const unsigned vbase = lds0 + (4 * hi + ((lane & 15) >> 2)) * XV_PITCH + (2 * ((lane >> 4) & 1) + ((lane & 3) >> 1)) * 16 + 8 * (lane & 1);
#pragma unroll
        for (int half = 0; half < 2; ++half) {
            f32x16 o[4];
#pragma unroll
            for (int dt = 0; dt < 4; ++dt)
#pragma unroll
                for (int r = 0; r < 16; ++r) o[dt][r] = 0.f;
#pragma unroll
            for (int kt = 0; kt < 8; ++kt)
#pragma unroll
                for (int s = 0; s < 2; ++s) {
                    bf16x8 pf;
                    { const unsigned w0 = pk[kt][4 * s + 0], w1 = pk[kt][4 * s + 1], w2 = pk[kt][4 * s + 2], w3 = pk[kt][4 * s + 3];
                      pf[0] = (short)(w0 & 0xffff); pf[1] = (short)(w0 >> 16); pf[2] = (short)(w1 & 0xffff); pf[3] = (short)(w1 >> 16);
                      pf[4] = (short)(w2 & 0xffff); pf[5] = (short)(w2 >> 16); pf[6] = (short)(w3 & 0xffff); pf[7] = (short)(w3 >> 16); }
#pragma unroll
                    for (int dt = 0; dt < 4; ++dt) {
                        const unsigned a1 = vbase + (32 * kt + 16 * s) * XV_PITCH + (half * 4 + dt) * 64;
                        const s16x4 lo = lds_tr16(a1), hh = lds_tr16(a1 + 8 * XV_PITCH);
                        const bf16x8 vf = (bf16x8){lo[0], lo[1], lo[2], lo[3], hh[0], hh[1], hh[2], hh[3]};
                        o[dt] = __builtin_amdgcn_mfma_f32_32x32x16_bf16(vf, pf, o[dt], 0, 0, 0);
                    }
                }
            u16* orow = MIX + (size_t)(m0 + r32) * DM + h * 256 + 4 * hi;
#pragma unroll
            for (int dt = 0; dt < 4; ++dt)
#pragma unroll
                for (int rq = 0; rq < 4; ++rq) {
                    uint2 w; w.x = pk2(o[dt][4 * rq + 0] * inv, o[dt][4 * rq + 1] * inv); w.y = pk2(o[dt][4 * rq + 2] * inv, o[dt][4 * rq + 3] * inv);
                    *(uint2*)(orow + 32 * (half * 4 + dt) + 8 * rq) = w;
                }
        }
    }
}

__device__ __forceinline__ void rope_phase(const Params& p) {
    const int tid = tid_opaque(), lane = tid & 63, gw = (blockIdx.x * NT + tid) >> 6, ngw = (gridDim.x * NT) >> 6;
    u16* Z = (u16*)(p.ws + WS_Z); const float2* rope = (const float2*)(p.ws + WS_ROPE);
    u16* KB = (u16*)(p.ws + WS_KB); u16* VB = (u16*)(p.ws + WS_VB); u16* KI = (u16*)(p.ws + WS_KI);
    for (int m = gw; m < T; m += ngw) {
        u16* zr = Z + (size_t)m * ZP1;
        const float2 cs = rope[(size_t)m * 64 + lane];
#pragma unroll
        for (int hd = 0; hd < 8; ++hd) {
            const float x1 = bf2f(zr[hd * 128 + lane]), x2 = bf2f(zr[hd * 128 + 64 + lane]);
            zr[hd * 128 + lane] = f2bf(x1 * cs.x - x2 * cs.y); zr[hd * 128 + 64 + lane] = f2bf(x2 * cs.x + x1 * cs.y);
        }
        { const float x1 = bf2f(zr[1024 + lane]), x2 = bf2f(zr[1088 + lane]);
          KB[(size_t)m * 128 + lane] = f2bf(x1 * cs.x - x2 * cs.y); KB[(size_t)m * 128 + 64 + lane] = f2bf(x2 * cs.x + x1 * cs.y); }
        *(unsigned*)(VB + (size_t)m * 128 + 2 * lane) = *(const unsigned*)(zr + 1152 + 2 * lane);
#pragma unroll
        for (int i = 0; i < 4; ++i) {
            const int pp = lane + 64 * i, hd = pp >> 5, jj = pp & 31;
            const float2 c2 = rope[(size_t)m * 64 + 2 * jj];
            const float x1 = bf2f(zr[1280 + hd * 64 + jj]), x2 = bf2f(zr[1280 + hd * 64 + 32 + jj]);
            zr[1280 + hd * 64 + jj] = f2bf(x1 * c2.x - x2 * c2.y); zr[1280 + hd * 64 + 32 + jj] = f2bf(x2 * c2.x + x1 * c2.y);
        }
        if (lane < 32) {
            const float2 c2 = rope[(size_t)m * 64 + 2 * lane];
            const float x1 = bf2f(zr[1792 + lane]), x2 = bf2f(zr[1824 + lane]);
            const int s = m & 4095, bb = m >> 12;
            u16* kt = KI + ((size_t)bb * 128 + (s >> 5)) * 2048 + (s & 31) * 8;
            const int d1 = lane, d2 = lane + 32;
            kt[((d1 >> 4) * 2 + ((d1 >> 3) & 1)) * 256 + (d1 & 7)] = f2bf(x1 * c2.x - x2 * c2.y);
            kt[((d2 >> 4) * 2 + ((d2 >> 3) & 1)) * 256 + (d2 & 7)] = f2bf(x2 * c2.x + x1 * c2.y);
        }
        if (lane < 8) zr[1856 + lane] = f2bf(bf2f(zr[1856 + lane]) * 0.35355339059327373f);
    }
}

typedef float f32x4v __attribute__((ext_vector_type(4)));
constexpr int VB_PITCH = 288, KB_PITCH = 272, CAND_CAP = 256, NBIN = 512;
__device__ __forceinline__ int score_bin(float sc) { const int b = (int)floorf(sc * 64.f) + 256; return b < 0 ? 0 : (b > 511 ? 511 : b); }
__device__ __forceinline__ unsigned score_key(unsigned f) { f = __float_as_uint(__uint_as_float(f) + 0.0f); return (f & 0x80000000u) ? ~f : (f | 0x80000000u); }
__device__ __forceinline__ float minscore_for_bin(int B) { return (B <= 0) ? -INFINITY : (float)(B - 256) * 0.015625f; }
__device__ __forceinline__ unsigned minkey_for_bin(int B) {
    if (B <= 0) return 0u;
    const unsigned f = __float_as_uint((float)(B - 256) * 0.015625f);
    return (f & 0x80000000u) ? ~f : (f | 0x80000000u);
}
#define ZERO_HIST(h, ln) do { _Pragma("unroll") for (int z_ = 0; z_ < 8; ++z_) (h)[(ln) * 8 + z_] = 0u; } while (0)
__device__ __forceinline__ int wave_iscan(int v) {
    v += __builtin_amdgcn_update_dpp(0, v, 0x111, 0xf, 0xf, false);
    v += __builtin_amdgcn_update_dpp(0, v, 0x112, 0xf, 0xf, false);
    v += __builtin_amdgcn_update_dpp(0, v, 0x114, 0xf, 0xf, false);
    v += __builtin_amdgcn_update_dpp(0, v, 0x118, 0xf, 0xf, false);
    v += __builtin_amdgcn_update_dpp(0, v, 0x142, 0xa, 0xf, false);
    v += __builtin_amdgcn_update_dpp(0, v, 0x143, 0xc, 0xf, false);
    return v;
}
__device__ __forceinline__ float relu_i(float x) { const int b = __float_as_int(x); return __int_as_float(b > 0 ? b : 0); }
__device__ __forceinline__ void dsa_phase(const Params& p, unsigned char* smem) {
    LAS3 unsigned char* lds = (LAS3 unsigned char*)smem;
    const u16* Z = (const u16*)(p.ws + WS_Z); u16* MIX = (u16*)(p.ws + WS_MIX);
    const u16* KB = (const u16*)(p.ws + WS_KB); const u16* VB = (const u16*)(p.ws + WS_VB); const u16* KI = (const u16*)(p.ws + WS_KI);
    { const int t0_ = tid_opaque(); LAS3 unsigned* h0 = (LAS3 unsigned*)(lds + 131072 + (t0_ >> 6) * 3072 + 512);
      ZERO_HIST(h0, t0_ & 63); }
    for (int U = blockIdx.x; U < 4096; U += gridDim.x) {
        const int tid = tid_opaque(), lane = tid & 63, wid = __builtin_amdgcn_readfirstlane(tid >> 6);
        const int r32 = lane & 31, hi = lane >> 5, l15 = lane & 15, g4 = lane >> 4;
        LAS3 unsigned* sck_all = (LAS3 unsigned*)lds;
        LAS3 unsigned* sck = sck_all + wid * 4096;
        LAS3 unsigned char* aux = lds + 131072 + wid * 3072;
        LAS3 u16* idx = (LAS3 u16*)aux; LAS3 unsigned* hist = (LAS3 unsigned*)(aux + 512); LAS3 u16* cand = (LAS3 u16*)(aux + 2560);
        LAS3 unsigned char* vbuf = (LAS3 unsigned char*)sck;
        const unsigned vb0 = (unsigned)(uintptr_t)vbuf + (4 * g4 + (l15 >> 2)) * VB_PITCH + 8 * (l15 & 3);
        const unsigned long long lt_mask = (lane == 0) ? 0ull : (~0ull >> (64 - lane));
        const int uj = U >> 8, uc = U & 255, b = uc & 7, uy = uc >> 3;
        const int t0 = 8 * (32 * uj + ((uj & 1) ? 31 - uy : uy));
        const size_t brow = (size_t)b * SEQ;
        bf16x8 qif[2][4]; uint2 wqw[2][4];
        {   const int tq0 = (t0 >= 256) ? t0 : 256;
#pragma unroll
            for (int rt = 0; rt < 2; ++rt) {
                const u16* zr = Z + (brow + tq0 + 4 * rt + (r32 >> 3)) * ZP1 + 1280 + (r32 & 7) * 64 + 8 * hi;
#pragma unroll
                for (int ks = 0; ks < 4; ++ks) qif[rt][ks] = *(const bf16x8*)(zr + 16 * ks);
#pragma unroll
                for (int qq = 0; qq < 4; ++qq) wqw[rt][qq] = *(const uint2*)(Z + (brow + tq0 + 4 * rt + qq) * ZP1 + 1856 + 4 * hi);
            }
        }
        __syncthreads();
        for (int rep_s = 0; rep_s < (DSA_DUP == 1 ? 2 : 1); ++rep_s)
        if (t0 >= 256) {
            if (rep_s == 1) { __syncthreads(); ZERO_HIST(hist, lane); __syncthreads(); }
            float wq[2][16];
#pragma unroll
            for (int rt = 0; rt < 2; ++rt)
#pragma unroll
                for (int qq = 0; qq < 4; ++qq) {
                    const uint2 w = wqw[rt][qq];
                    wq[rt][4 * qq + 0] = 0.125f * bflo(w.x); wq[rt][4 * qq + 1] = 0.125f * bfhi(w.x);
                    wq[rt][4 * qq + 2] = 0.125f * bflo(w.y); wq[rt][4 * qq + 3] = 0.125f * bfhi(w.y);
                }
            const int ntile = (t0 + 8 + 31) >> 5;
            bf16x8 kif[4], kn1[4];
            {
                const u16* kr = KI + ((size_t)b * 128 + wid) * 2048 + hi * 256 + r32 * 8;
#pragma unroll
                for (int ks = 0; ks < 4; ++ks) kif[ks] = *(const bf16x8*)(kr + 512 * ks);
                const int kt1 = (wid + 8 < ntile) ? wid + 8 : wid;
                const u16* kr1 = KI + ((size_t)b * 128 + kt1) * 2048 + hi * 256 + r32 * 8;
#pragma unroll
                for (int ks = 0; ks < 4; ++ks) kn1[ks] = *(const bf16x8*)(kr1 + 512 * ks);
            }
#define SCORE_STEP(CUR, DST) { \
                { const int ktn = (kt + 16 < ntile) ? kt + 16 : kt; \
                  const u16* kr = KI + ((size_t)b * 128 + ktn) * 2048 + hi * 256 + r32 * 8; \
                  _Pragma("unroll") for (int ks = 0; ks < 4; ++ks) DST[ks] = *(const bf16x8*)(kr + 512 * ks); } \
                f32x16 c0, c1; \
                _Pragma("unroll") \
                for (int r = 0; r < 16; ++r) { c0[r] = 0.f; c1[r] = 0.f; } \
                _Pragma("unroll") \
                for (int ks = 0; ks < 4; ++ks) { \
                    c0 = __builtin_amdgcn_mfma_f32_32x32x16_bf16(qif[0][ks], CUR[ks], c0, 0, 0, 0); \
                    c1 = __builtin_amdgcn_mfma_f32_32x32x16_bf16(qif[1][ks], CUR[ks], c1, 0, 0, 0); \
                } \
                _Pragma("unroll") \
                for (int qq = 0; qq < 4; ++qq) { \
                    float pa = 0.f, pb = 0.f; \
                _Pragma("unroll") \
                    for (int e = 0; e < 4; ++e) { pa = fmaf(relu_i(c0[4 * qq + e]), wq[0][4 * qq + e], pa); pb = fmaf(relu_i(c1[4 * qq + e]), wq[1][4 * qq + e], pb); } \
                    const auto rr = __builtin_amdgcn_permlane32_swap(__float_as_uint(pa), __float_as_uint(pb), false, false); \
                    const float sc = __uint_as_float(rr[0]) + __uint_as_float(rr[1]);     \
                    sck_all[(4 * hi + qq) * 4096 + 32 * kt + r32] = __float_as_uint(sc);     \
 \
 \
                    { const bool vis = (32 * kt + 31 <= t0) || (32 * kt + r32 <= t0 + 4 * hi + qq); \
                      LAS3 unsigned* hq = (LAS3 unsigned*)(lds + 131072 + (4 * hi + qq) * 3072 + 512) + score_bin(sc); \
                      __hip_atomic_fetch_add(vis ? hq : (LAS3 unsigned*)(lds + LDS_CTL_OFF + 56), 1u, __ATOMIC_RELAXED, __HIP_MEMORY_SCOPE_WORKGROUP); } \
                } \
                kt += 8; if (kt >= ntile) break; }
            bf16x8 kn2[4];
            for (int kt = wid;;) { SCORE_STEP(kif, kn2) SCORE_STEP(kn1, kif) SCORE_STEP(kn2, kn1) }
#undef SCORE_STEP
        }
        __syncthreads();
        const int t = t0 + wid, n = t + 1;
        const size_t m = brow + t;
        bf16x8 qf[4];
#pragma unroll
        for (int ks = 0; ks < 4; ++ks) {
            qf[ks] = (bf16x8){0, 0, 0, 0, 0, 0, 0, 0};
            if (l15 < 8) qf[ks] = *(const bf16x8*)(Z + m * ZP1 + l15 * 128 + 32 * ks + 8 * g4);
        }
        int count;
        for (int rep_t = 0; rep_t < (DSA_DUP == 2 ? 2 : 1); ++rep_t)
        if (n <= 256) {
            count = n;
            for (int j = lane; j < 256; j += 64) idx[j] = (u16)(j < n ? j : 0);
        } else {
            count = 256;
            int bdig, bwant, bcnt;
            {
                int cb_[8]; int tot = 0;
                { const u32x4v h0v = *(const LAS3 u32x4v*)(hist + lane * 8), h1v = *(const LAS3 u32x4v*)(hist + lane * 8 + 4);
                  cb_[0] = (int)h0v.x; cb_[1] = (int)h0v.y; cb_[2] = (int)h0v.z; cb_[3] = (int)h0v.w; cb_[4] = (int)h1v.x; cb_[5] = (int)h1v.y; cb_[6] = (int)h1v.z; cb_[7] = (int)h1v.w; }
#pragma unroll
                for (int z = 0; z < 8; ++z) tot += cb_[z];
                const int P_ = wave_iscan(tot);
                const int S = __builtin_amdgcn_readlane(P_, 63) - P_ + tot;
                const int above = S - tot;
                const bool ok = (above < 256) && (256 <= S);
                int dig = 0, nw = 0, hb = 0;
                if (ok) {
                    int cum = above; bool found = false;
#pragma unroll
                    for (int z = 7; z >= 0; --z) { if (!found) { if (cum + cb_[z] >= 256) { dig = lane * 8 + z; nw = 256 - cum; hb = cb_[z]; found = true; } else cum += cb_[z]; } }
                }
                const unsigned long long bal = __ballot(ok);
                const int src = (int)__ffsll((long long)bal) - 1;
                bdig = __shfl(dig, src); bwant = __shfl(nw, src); bcnt = __shfl(hb, src);
            }
            if (bcnt == bwant || bcnt <= CAND_CAP) {
                const int tb = (bcnt == bwant) ? bdig : bdig + 1;
                const float klo = minscore_for_bin(tb), khi = minscore_for_bin(bdig);
                const bool any_take = tb < NBIN, want_cand = tb != bdig;
                LAS3 unsigned long long* tmask = (LAS3 unsigned long long*)hist; LAS3 unsigned long long* cmask = tmask + 64;
                const int ntrip = (n + 255) >> 8;
                const float klo_ = any_take ? klo : INFINITY, khi_ = want_cand ? khi : klo_;
                const int nfull = n >> 8;
                for (int it = 0; it < nfull; ++it) {
                    const u32x4v k4 = *(const LAS3 u32x4v*)(sck + 256 * it + 4 * lane);
                    unsigned long long bt[4], bc[4];
#pragma unroll
                    for (int e = 0; e < 4; ++e) { bt[e] = __builtin_amdgcn_ballot_w64(__uint_as_float(k4[e]) >= klo_); bc[e] = __builtin_amdgcn_ballot_w64(__uint_as_float(k4[e]) >= khi_) & ~bt[e]; }
                    if (lane == 0) {
#pragma unroll
                        for (int e = 0; e < 4; ++e) { tmask[4 * it + e] = bt[e]; cmask[4 * it + e] = bc[e]; }
                    }
                }
                if (nfull < ntrip) {
                    const int it = nfull;
                    const u32x4v k4 = *(const LAS3 u32x4v*)(sck + 256 * it + 4 * lane);
                    unsigned long long bt[4], bc[4];
#pragma unroll
                    for (int e = 0; e < 4; ++e) { const bool in = 256 * it + 4 * lane + e < n;
                        bt[e] = __builtin_amdgcn_ballot_w64(in && __uint_as_float(k4[e]) >= klo_); bc[e] = __builtin_amdgcn_ballot_w64(in && __uint_as_float(k4[e]) >= khi_) & ~bt[e]; }
                    if (lane == 0) {
#pragma unroll
                        for (int e = 0; e < 4; ++e) { tmask[4 * it + e] = bt[e]; cmask[4 * it + e] = bc[e]; }
                    }
                }
                WAVE_SYNC();
                int base;
                {
                    const bool hasw = lane < 4 * ntrip;
                    unsigned long long tw = hasw ? tmask[lane] : 0ull, cw = hasw ? cmask[lane] : 0ull;
                    const int key0 = 256 * (lane >> 2) + (lane & 3);
                    int ct = __popcll(tw), cc = __popcll(cw);
                    const int st_ = wave_iscan(ct), sc_ = wave_iscan(cc);
                    base = __builtin_amdgcn_readlane(st_, 63);
                    int pt = st_ - ct, pc = sc_ - cc;
                    while (tw) { const int bb = __builtin_ctzll(tw); tw &= tw - 1; if (pt < 256) idx[pt] = (u16)(key0 + 4 * bb); ++pt; }
                    while (cw) { const int bb = __builtin_ctzll(cw); cw &= cw - 1; if (pc < CAND_CAP) cand[pc] = (u16)(key0 + 4 * bb); ++pc; }
                }
                if (tb != bdig) {
                    WAVE_SYNC();
                    if (bcnt <= 64) {
                        const bool in = lane < bcnt;
                        const int si = in ? (int)cand[lane] : 0; const float kk = in ? __uint_as_float(sck[si]) : 0.f;
                        int rank = 0;
                        for (int j = 0; j < bcnt; ++j) {
                            const float kj = __int_as_float(__builtin_amdgcn_readlane(__float_as_int(kk), j)); const int sj = __builtin_amdgcn_readlane(si, j);
                            rank += (kj > kk || (kj == kk && sj < si)) ? 1 : 0;
                        }
                        const bool take = in && (rank < bwant);
                        const unsigned long long bt = __ballot(take);
                        const int pos = base + __popcll(bt & lt_mask);
                        if (take && pos < 256) idx[pos] = (u16)si;
                        base += __popcll(bt);
                    } else
                    for (int i0 = 0; i0 < bcnt; i0 += 64) {
                        const int i = i0 + lane; const bool in = i < bcnt;
                        const int si = in ? (int)cand[i] : 0; const float kk = __uint_as_float(sck[si]);
                        int rank = 0;
                        for (int j = 0; j < bcnt; ++j) { const int sj = (int)cand[j]; const float kj = __uint_as_float(sck[sj]); rank += (kj > kk || (kj == kk && sj < si)) ? 1 : 0; }
                        const bool take = in && (rank < bwant);
                        const unsigned long long bt = __ballot(take);
                        const int pos = base + __popcll(bt & lt_mask);
                        if (take && pos < 256) idx[pos] = (u16)si;
                        base += __popcll(bt);
                    }
                }
            } else {
            unsigned prefix = 0u, mask = 0u; int want = 256;
            for (int pass = 0; pass < 4; ++pass) {
                const int shift = 24 - 8 * pass;
                hist[lane * 4 + 0] = 0u; hist[lane * 4 + 1] = 0u; hist[lane * 4 + 2] = 0u; hist[lane * 4 + 3] = 0u;
                WAVE_SYNC();
                for (int s = lane; s < n; s += 64) { const unsigned k = score_key(sck[s]); if ((k & mask) == prefix) __hip_atomic_fetch_add(&hist[(k >> shift) & 255u], 1u, __ATOMIC_RELAXED, __HIP_MEMORY_SCOPE_WORKGROUP); }
                WAVE_SYNC();
                const int c0 = (int)hist[lane * 4 + 0], c1 = (int)hist[lane * 4 + 1], c2 = (int)hist[lane * 4 + 2], c3 = (int)hist[lane * 4 + 3];
                const int tot = c0 + c1 + c2 + c3;
                int S = tot;
#pragma unroll
                for (int o = 1; o < 64; o <<= 1) { const int v = __shfl_down(S, o); if (lane + o < 64) S += v; }
                const int above = S - tot;
                const bool ok = (above < want) && (want <= S);
                int dig = 0, nw = 0;
                if (ok) {
                    int cum = above;
                    if (cum + c3 >= want) { dig = lane * 4 + 3; nw = want - cum; }
                    else { cum += c3;
                        if (cum + c2 >= want) { dig = lane * 4 + 2; nw = want - cum; }
                        else { cum += c2;
                            if (cum + c1 >= want) { dig = lane * 4 + 1; nw = want - cum; }
                            else { cum += c1; dig = lane * 4; nw = want - cum; } } }
                }
                const unsigned long long bal = __ballot(ok);
                const int src = (int)__ffsll((long long)bal) - 1;
                dig = __shfl(dig, src); nw = __shfl(nw, src);
                prefix |= ((unsigned)dig) << shift; mask |= 255u << shift; want = nw;
                WAVE_SYNC();
            }
            int base = 0, eqt = 0;
            for (int s0 = 0; s0 < n; s0 += 64) {
                const int s = s0 + lane; const bool in = s < n;
                const unsigned k = in ? score_key(sck[s]) : 0u;
                const bool gt = in && (k > prefix), eq = in && (k == prefix);
                const unsigned long long beq = __ballot(eq);
                const int rank = eqt + __popcll(beq & lt_mask);
                const bool take = gt || (eq && rank < want);
                const unsigned long long bt = __ballot(take);
                const int pos = base + __popcll(bt & lt_mask);
                if (take && pos < 256) idx[pos] = (u16)s;
                base += __popcll(bt); eqt += __popcll(beq);
            }
            }
            WAVE_SYNC();
            if (rep_t == (DSA_DUP == 2 ? 1 : 0)) { ZERO_HIST(hist, lane); }
        }
        WAVE_SYNC();
        for (int rep_a = 0; rep_a < (DSA_DUP == 3 ? 2 : 1); ++rep_a) {
        f32x4v st[16];
#pragma unroll
        for (int kt = 0; kt < 16; ++kt) st[kt] = (f32x4v){0.f, 0.f, 0.f, 0.f};
        f32x4v ot[8];
#pragma unroll
        for (int dt = 0; dt < 8; ++dt) ot[dt] = (f32x4v){0.f, 0.f, 0.f, 0.f};
        const float lsc = 0.08838834764831845f * 1.4426950408889634f;
        float inv;
#define DSA_GATHER(REG, SRC, C)                                                                                     \
        { const u32x4v iv = *(const LAS3 u32x4v*)(idx + 32 * (C) + 8 * g4);                                         \
          _Pragma("unroll") for (int i = 0; i < 8; ++i) {                                                           \
              const int ki = (int)((iv[i >> 1] >> (16 * (i & 1))) & 0xffffu);                                       \
              REG[i] = *(const u32x4v*)(SRC + (brow + ki) * 128 + l15 * 8); } }
#define DSA_KCHUNK(REG, C)                                                                                          \
        { WAVE_SYNC();                                                                                              \
          _Pragma("unroll") for (int i = 0; i < 8; ++i) *(LAS3 u32x4v*)(vbuf + (8 * g4 + i) * KB_PITCH + l15 * 16) = REG[i]; \
          WAVE_SYNC();                                                                                              \
          _Pragma("unroll") for (int a = 0; a < 2; ++a)                                                             \
          _Pragma("unroll") for (int ks = 0; ks < 4; ++ks) {                                                        \
              const bf16x8 kf = *(const LAS3 bf16x8*)(vbuf + (16 * a + l15) * KB_PITCH + (32 * ks + 8 * g4) * 2);   \
              st[2 * (C) + a] = __builtin_amdgcn_mfma_f32_16x16x32_bf16(kf, qf[ks], st[2 * (C) + a], 0, 0, 0); } }
#define DSA_VCHUNK(REG, C)                                                                                          \
        { WAVE_SYNC();                                                                                              \
          _Pragma("unroll") for (int i = 0; i < 8; ++i) *(LAS3 u32x4v*)(vbuf + (8 * g4 + i) * VB_PITCH + l15 * 16) = REG[i]; \
          WAVE_SYNC();                                                                                              \
          bf16x8 pf;                                                                                                \
          { const unsigned w0 = pk2hw(st[2 * (C)][0], st[2 * (C)][1]), w1 = pk2hw(st[2 * (C)][2], st[2 * (C)][3]),  \
                           w2 = pk2hw(st[2 * (C) + 1][0], st[2 * (C) + 1][1]), w3 = pk2hw(st[2 * (C) + 1][2], st[2 * (C) + 1][3]); \
            pf[0] = (short)(w0 & 0xffff); pf[1] = (short)(w0 >> 16); pf[2] = (short)(w1 & 0xffff); pf[3] = (short)(w1 >> 16); \
            pf[4] = (short)(w2 & 0xffff); pf[5] = (short)(w2 >> 16); pf[6] = (short)(w3 & 0xffff); pf[7] = (short)(w3 >> 16); } \
          _Pragma("unroll") for (int dt = 0; dt < 8; ++dt) {                                                        \
              const s16x4 lo = lds_tr16(vb0 + dt * 32), hh = lds_tr16(vb0 + dt * 32 + 16 * VB_PITCH);              \
              const bf16x8 vf = (bf16x8){lo[0], lo[1], lo[2], lo[3], hh[0], hh[1], hh[2], hh[3]};                   \
              ot[dt] = __builtin_amdgcn_mfma_f32_16x16x32_bf16(vf, pf, ot[dt], 0, 0, 0); } }
#define DSA_EXPSUM()                                                                                                \
        { mx = fmaxf(mx, __shfl_xor(mx, 16)); mx = fmaxf(mx, __shfl_xor(mx, 32));                                   \
          float sum = 0.f;                                                                                          \
          _Pragma("unroll") for (int kt = 0; kt < 16; ++kt)                                                         \
          _Pragma("unroll") for (int r = 0; r < 4; ++r) { const float e = __builtin_amdgcn_exp2f(st[kt][r] - mx); st[kt][r] = e; sum += e; } \
          sum += __shfl_xor(sum, 16); sum += __shfl_xor(sum, 32);                                                   \
          inv = 1.f / sum; }
        if (count == 256) {
            u32x4v ring[2][2][8];
            DSA_GATHER(ring[0][0], KB, 0) DSA_GATHER(ring[0][1], KB, 1)
#pragma unroll
            for (int s = 0; s < 4; ++s) {
                if (s < 3) { DSA_GATHER(ring[(s + 1) & 1][0], KB, 2 * s + 2) DSA_GATHER(ring[(s + 1) & 1][1], KB, 2 * s + 3) }
                DSA_KCHUNK(ring[s & 1][0], 2 * s) DSA_KCHUNK(ring[s & 1][1], 2 * s + 1)
            }
            DSA_GATHER(ring[0][0], VB, 0) DSA_GATHER(ring[0][1], VB, 1)
            float mx = -INFINITY;
#pragma unroll
            for (int kt = 0; kt < 16; ++kt)
#pragma unroll
                for (int r = 0; r < 4; ++r) { const float v = st[kt][r] * lsc; st[kt][r] = v; mx = fmaxf(mx, v); }
            DSA_EXPSUM()
#pragma unroll
            for (int s = 0; s < 4; ++s) {
                if (s < 3) { DSA_GATHER(ring[(s + 1) & 1][0], VB, 2 * s + 2) DSA_GATHER(ring[(s + 1) & 1][1], VB, 2 * s + 3) }
                DSA_VCHUNK(ring[s & 1][0], 2 * s) DSA_VCHUNK(ring[s & 1][1], 2 * s + 1)
            }
        } else {
#pragma unroll 1
            for (int c = 0; 32 * c < count; ++c) {
                u32x4v kreg[8];
                DSA_GATHER(kreg, KB, c)
                WAVE_SYNC();
#pragma unroll
                for (int i = 0; i < 8; ++i) *(LAS3 u32x4v*)(vbuf + (8 * g4 + i) * KB_PITCH + l15 * 16) = kreg[i];
                WAVE_SYNC();
                f32x4v s0 = (f32x4v){0.f, 0.f, 0.f, 0.f}, s1 = (f32x4v){0.f, 0.f, 0.f, 0.f};
#pragma unroll
                for (int ks = 0; ks < 4; ++ks) {
                    const bf16x8 kf0 = *(const LAS3 bf16x8*)(vbuf + l15 * KB_PITCH + (32 * ks + 8 * g4) * 2);
                    const bf16x8 kf1 = *(const LAS3 bf16x8*)(vbuf + (16 + l15) * KB_PITCH + (32 * ks + 8 * g4) * 2);
                    s0 = __builtin_amdgcn_mfma_f32_16x16x32_bf16(kf0, qf[ks], s0, 0, 0, 0);
                    s1 = __builtin_amdgcn_mfma_f32_16x16x32_bf16(kf1, qf[ks], s1, 0, 0, 0);
                }
#pragma unroll
                for (int cs = 0; cs < 8; ++cs) if (c == cs) { st[2 * cs] = s0; st[2 * cs + 1] = s1; }
            }
            float mx = -INFINITY;
#pragma unroll
            for (int kt = 0; kt < 16; ++kt)
#pragma unroll
                for (int r = 0; r < 4; ++r) { const int j = 16 * kt + 4 * g4 + r; const float v = (j < count) ? st[kt][r] * lsc : -INFINITY; st[kt][r] = v; mx = fmaxf(mx, v); }
            DSA_EXPSUM()
#pragma unroll
            for (int c = 0; c < 8; ++c) {
                if (32 * c < count) {
                    u32x4v vreg[8];
                    DSA_GATHER(vreg, VB, c)
                    DSA_VCHUNK(vreg, c)
                }
            }
        }
#undef DSA_GATHER
#undef DSA_KCHUNK
#undef DSA_VCHUNK
#undef DSA_EXPSUM
        if (l15 < 8) {
            u16* orow = MIX + m * DM + l15 * 128 + 4 * g4;
#pragma unroll
            for (int dt = 0; dt < 8; ++dt) {
                uint2 w; w.x = pk2hw(ot[dt][0] * inv, ot[dt][1] * inv); w.y = pk2hw(ot[dt][2] * inv, ot[dt][3] * inv);
                *(uint2*)(orow + 16 * dt) = w;
            }
        }
        }
    }
}

#define XB_TMO      128
#define XB_XCNT(j)  (256  + 64 * (j))
#define XB_XSUB(j)  (1280 + 64 * (j))
#define XB_XGEN(j)  (2304 + 64 * (j))
#define XB_TOP      3328
#define XB_TOPGEN   3392
#define XCD_BAR_WORDS 3456
#define XB_SPIN_CAP (1u << 18)

__device__ __forceinline__ unsigned xb_ld(unsigned* p)              { return __hip_atomic_load(p, __ATOMIC_RELAXED, __HIP_MEMORY_SCOPE_AGENT); }
__device__ __forceinline__ unsigned xb_add(unsigned* p, unsigned v) { return __hip_atomic_fetch_add(p, v, __ATOMIC_RELAXED, __HIP_MEMORY_SCOPE_AGENT); }
__device__ __forceinline__ unsigned xb_xcc_id() { return (unsigned)__builtin_amdgcn_s_getreg((3 << 11) | 20) & 0xFu; }
#define XB_SPIN(cond, bar) do { unsigned _sp = 0; while (cond) { __builtin_amdgcn_s_sleep(1); \
    if ((++_sp & 255u) == 0u) { if (xb_ld(&(bar)[XB_TMO])) break; if (_sp > XB_SPIN_CAP) { atomicAdd(&(bar)[XB_TMO], 1u); break; } } } } while (0)

struct XcdBarrier {
    unsigned* bar; unsigned x;
    volatile __attribute__((address_space(3))) unsigned* st;
};

__device__ __forceinline__ XcdBarrier xcd_barrier_post(unsigned* bar, volatile __attribute__((address_space(3))) unsigned* st) {
    XcdBarrier b; b.bar = bar; b.x = xb_xcc_id(); b.st = st;
    if (threadIdx.x == 0) (void)xb_add(&bar[XB_XCNT(b.x)], 1u);
    return b;
}
__device__ __forceinline__ void xcd_barrier_complete(unsigned* bar, unsigned x, unsigned& nloc, unsigned& nx) {
    const unsigned G = gridDim.x * gridDim.y * gridDim.z;
    unsigned sum, cnt, mine, sp = 0u;
    for (;;) {
        sum = 0u; cnt = 0u; mine = 0u;
#pragma unroll
        for (unsigned j = 0; j < 16; ++j) { const unsigned c = xb_ld(&bar[XB_XCNT(j)]); sum += c; cnt += (c > 0u) ? 1u : 0u; mine = (j == x) ? c : mine; }
        if (sum == G) break;
        __builtin_amdgcn_s_sleep(1);
        if ((++sp & 255u) == 0u) { if (xb_ld(&bar[XB_TMO])) break; if (sp > XB_SPIN_CAP) { atomicAdd(&bar[XB_TMO], 1u); break; } }
    }
    nloc = mine > 0u ? mine : 1u; nx = cnt > 0u ? cnt : 1u;
}

__device__ __forceinline__ void xcd_barrier(const XcdBarrier& b) {
    asm volatile("s_waitcnt vmcnt(0)" ::: "memory");
    __syncthreads();
    if (threadIdx.x == 0) {
        unsigned* bar = b.bar;
        __builtin_amdgcn_s_waitcnt(0);
        unsigned nloc = b.st[0], nx = b.st[1];
        if (nloc == 0u) { xcd_barrier_complete(bar, b.x, nloc, nx); b.st[0] = nloc; b.st[1] = nx; }
        const unsigned old = xb_add(&bar[XB_XSUB(b.x)], 1u);
        const unsigned gen = old / nloc;
        if (old + 1u == (gen + 1u) * nloc) {
            __builtin_amdgcn_fence(__ATOMIC_RELEASE, "agent");
            asm volatile("s_waitcnt vmcnt(0)" ::: "memory");
            const unsigned og = xb_add(&bar[XB_TOP], 1u);
            const unsigned tg = og / nx;
            if (og + 1u == (tg + 1u) * nx) xb_add(&bar[XB_TOPGEN], 1u);
            else XB_SPIN(xb_ld(&bar[XB_TOPGEN]) == tg, bar);
            __builtin_amdgcn_fence(__ATOMIC_ACQUIRE, "agent");
            xb_add(&bar[XB_XGEN(b.x)], 1u);
            asm volatile("s_waitcnt vmcnt(0)" ::: "memory");
        } else {
            XB_SPIN(xb_ld(&bar[XB_XGEN(b.x)]) == gen, bar);
            __builtin_amdgcn_fence(__ATOMIC_ACQUIRE, "agent");
            asm volatile("s_waitcnt vmcnt(0)" ::: "memory");
        }
    }
    __syncthreads();
}

__device__ __forceinline__ void xattn_precompute(const Params& p, int l, unsigned char* smem) {
    const u16* KV = (const u16*)(p.ws + WS_KV);
    const int half = (int)gridDim.x >> 1;
    if ((int)blockIdx.x < half) {
        pg8::Gemm g{KV, (const u16*)(p.ws + WS_WQ), 256, 1024, 256, 2048, 1024}; PreOrder<0> S{half, (int)blockIdx.x, l};
        EpiStore E{(u16*)(p.ws + WS_BT1), 1024, 0, nullptr};
        pg8::gemm_phase<EpiStore, PreOrder<0>, true, true>((PG8_LAS unsigned char*)smem, g, S, E); }
    else {
        pg8::Gemm g{(const u16*)(p.ws + WS_WO), KV, 1024, 256, 256, 1024, 2048}; PreOrder<1> S{(int)gridDim.x - half, (int)blockIdx.x - half, l};
        EpiStore E{(u16*)(p.ws + WS_BT2), 1024, 0, nullptr};
        pg8::gemm_phase<EpiStore, PreOrder<1>, true, true>((PG8_LAS unsigned char*)smem, g, S, E); }
}

typedef const __attribute__((address_space(4))) Params* KParams;
template <int PH> __device__ __forceinline__ void run_phase(unsigned char* smem) {
    constexpr int ph = PH;
#if defined(__HIP_DEVICE_COMPILE__)
    KParams kp = (KParams)__builtin_amdgcn_kernarg_segment_ptr(); asm volatile("" : "+s"(kp));
    Params p;
    p.x = kp->x; p.mem = kp->mem; p.pos = kp->pos; p.gains = kp->gains; p.wq = kp->wq; p.wkv = kp->wkv; p.wo = kp->wo; p.w1 = kp->w1; p.w2 = kp->w2;
    p.ev_w_in = kp->ev_w_in; p.sgu_g = kp->sgu_g; p.sgu_ws = kp->sgu_ws; p.sgu_bs = kp->sgu_bs; p.pool_w = kp->pool_w; p.pool_scale = kp->pool_scale;
    p.ev_w_out = kp->ev_w_out; p.od_w_in = kp->od_w_in; p.od_w_out = kp->od_w_out; p.out = kp->out; p.ws = kp->ws;
#else
    Params p{};
#endif
    u16* HN = (u16*)(p.ws + WS_HN); u16* Y = (u16*)(p.ws + WS_Y); u16* Z = (u16*)(p.ws + WS_Z); u16* MIX = (u16*)(p.ws + WS_MIX);
    u16* Qb = (u16*)(p.ws + WS_Q); u16* HID = (u16*)(p.ws + WS_HID); u16* MEMN = (u16*)(p.ws + WS_MEMN); u16* KV = (u16*)(p.ws + WS_KV); float* RS = (float*)(p.ws + WS_RS);
    if constexpr (ph == 0) {
        float2* rope = (float2*)(p.ws + WS_ROPE);
        const int gt = blockIdx.x * NT + tid_opaque(), gs = gridDim.x * NT;
        for (int i = gt; i < T * 64; i += gs) {
            const int m = i >> 6, j = i & 63;
            const float inv = expf(-0.14391156831212787f * (float)j);
            const float ang = (float)p.pos[m] * inv;
            rope[i] = make_float2(cosf(ang), sinf(ang));
        }
        for (int i = gt; i < 4 * 16384; i += gs) {
            const int t = (i >> 7) & 127, s = i & 127, gg = i >> 14;
            ((u16*)(p.ws + WS_WC))[i] = (s <= t) ? f2bf(p.sgu_ws[i]) : (u16)0;
            ((u16*)(p.ws + WS_PWT))[i] = f2bf(p.pool_w[(size_t)gg * 16384 + s * 128 + t]);
        }
        rmsnorm_rows(p.mem, p.gains + (0 * 7 + 6) * DM, MEMN, 2048);
        rmsnorm_rows(p.mem, p.gains + (1 * 7 + 6) * DM, MEMN + (size_t)2048 * DM, 2048);
        cast_rows(p.x, HN, RS);
#pragma unroll 1
        for (int l = 0; l < 2; ++l) {
            weight_prep(p.wkv + (size_t)l * DM * 2048, DM, 2048, 2048, (u16*)(p.ws + WS_WKV) + (size_t)l * 2048 * DM, smem);
            weight_cast(p.wq + (size_t)l * DM * DM, DM, DM, (u16*)(p.ws + WS_WQ) + (size_t)l * DM * DM, p.gains + (size_t)(l * 7 + 2) * DM);
            weight_prep(p.wo + (size_t)l * DM * DM, DM, DM, DM, (u16*)(p.ws + WS_WO) + (size_t)l * DM * DM, smem);
            weight_prep(p.w1 + (size_t)l * DM * DFF, DM, DFF, DFF, (u16*)(p.ws + WS_W1) + (size_t)l * DFF * DM, smem, p.gains + (size_t)(l * 7 + 4) * DM);
            weight_prep<false, true>(p.w2 + (size_t)l * DFF * DM, DFF, DM, DM, (u16*)(p.ws + WS_W2 + (size_t)l * DM * DFF), smem);
        }
        weight_prep(p.ev_w_in, DM, EVEN_IN, EVEN_IN, (u16*)(p.ws + WS_EVIN), smem, p.gains + 0);
        weight_prep(p.ev_w_out, DM, DM, DM, (u16*)(p.ws + WS_EVOUT), smem);
        weight_prep<true>(p.od_w_in, DM, ODD_IN, ZP1, (u16*)(p.ws + WS_ODIN), smem, p.gains + (size_t)7 * DM);
        weight_prep(p.od_w_out, DM, DM, DM, (u16*)(p.ws + WS_ODOUT), smem);
    } else if constexpr (ph == 1) {
        pg8::Gemm gm{MEMN, (const u16*)(p.ws + WS_WKV), 2048, 2048, DM, DM, DM}; KvOrder S{(int)gridDim.x, (int)blockIdx.x};
        EpiStore E{KV, 2048, 0, nullptr};
        pg8::gemm_phase<EpiStore, KvOrder, true, true>((PG8_LAS unsigned char*)smem, gm, S, E);
    } else if constexpr (ph == 2) {
        xattn_precompute(p, 0, smem);
    } else {
        constexpr int l = (ph - 3) / 12, s = (ph - 3) % 12;
        const float* g = p.gains + (size_t)l * 7 * DM;
        if constexpr (s == 0) {
            if constexpr (l == 0) { gemm8(HN, (const u16*)(p.ws + WS_EVIN), T, EVEN_IN, DM, Z, EVEN_IN, 0, RS, smem); xattn_precompute(p, 0, smem); }
            else { pg8::Gemm gm{HN, (const u16*)(p.ws + WS_ODIN), T, ZP1, DM, DM, DM}; pg8::StaticOrder S; S.init(T, ZP1, (int)gridDim.x, (int)blockIdx.x);
                   EpiRope E{Z, (u16*)(p.ws + WS_KB), (u16*)(p.ws + WS_VB), (u16*)(p.ws + WS_KI), RS, (const float2*)(p.ws + WS_ROPE)};
                   pg8::gemm_phase<EpiRope, pg8::StaticOrder, true, true>((PG8_LAS unsigned char*)smem, gm, S, E); }
        } else if constexpr (s == 1) {
            if constexpr (l == 0) { mixer_a_all(p, smem); mixer_b_all(p, smem); }
            else { }
        } else if constexpr (s == 2) { if constexpr (l == 1) dsa_phase(p, smem); }
        else if constexpr (s == 3) gemm8(MIX, (const u16*)(p.ws + (l == 0 ? WS_EVOUT : WS_ODOUT)), T, DM, DM, Y, DM, 0, nullptr, smem);
        else if constexpr (s == 4) { if constexpr (l == 1) xattn_precompute(p, 1, smem); postnorm_rows<false>(HN, Y, g + 1 * DM, RS, nullptr); }
        else if constexpr (s == 5) {
            pg8::Gemm g{HN, (const u16*)(p.ws + WS_BT1), T, DM, DM, DM, DM}; BatchBOrder S; S.init(T, DM, (int)gridDim.x, (int)blockIdx.x);
            EpiSoftmax E{MIX, DM, RS, (PG8_LAS float*)((PG8_LAS unsigned char*)smem + 131072)};
            pg8::gemm_phase<EpiSoftmax, BatchBOrder, true, true>((PG8_LAS unsigned char*)smem, g, S, E); }
        else if constexpr (s == 6) { }
        else if constexpr (s == 7) {
            pg8::Gemm g{MIX, (const u16*)(p.ws + WS_BT2), T, DM, DM, DM, DM}; BatchBOrder S; S.init(T, DM, (int)gridDim.x, (int)blockIdx.x);
            EpiStore E{Y, DM, 0, nullptr};
            pg8::gemm_phase<EpiStore, BatchBOrder, true, true>((PG8_LAS unsigned char*)smem, g, S, E); }
        else if constexpr (s == 8) postnorm_rows<false>(HN, Y, g + 3 * DM, RS, nullptr);
        else if constexpr (s == 9) {
            pg8::Gemm gm{HN, (const u16*)(p.ws + WS_W1) + (size_t)l * DFF * DM, T, DFF, DM, DM, DM}; pg8::StaticOrder S; S.init(T, DFF, (int)gridDim.x, (int)blockIdx.x);
            EpiStoreF8 E{(unsigned char*)HID, DFF, RS};
            pg8::gemm_phase<EpiStoreF8, pg8::StaticOrder, true, true>((PG8_LAS unsigned char*)smem, gm, S, E); }
        else if constexpr (s == 10) {
            pg8::Gemm gm{HID, (const u16*)(p.ws + WS_W2 + (size_t)l * DM * DFF), T, DM, DFF / 2, DFF / 2, DFF / 2}; pg8::StaticOrder S; S.init(T, DM, (int)gridDim.x, (int)blockIdx.x);
            EpiStore E{Y, DM, 0, nullptr, 1.f / 2048.f};
            pg8::gemm_phase<EpiStore, pg8::StaticOrder, true, true, true>((PG8_LAS unsigned char*)smem, gm, S, E); }
        else { if constexpr (l == 0) postnorm_rows<false>(HN, Y, g + 5 * DM, RS, nullptr); else postnorm_rows<true>(HN, Y, g + 5 * DM, nullptr, p.out); }
    }
}

template <int PH> __device__ __forceinline__ void run_all(unsigned char* smem, const XcdBarrier& bar) {
    if constexpr (PH < NPHASE) {
        if constexpr (PH == DUP_PH) { run_phase<PH>(smem); xcd_barrier(bar); }
        if constexpr (PH == 1) { for (int xb = 0; xb < EXTRA_BARRIERS; ++xb) xcd_barrier(bar); }
#ifdef ONLY_PH
        if constexpr (PH == ONLY_PH) {
#else
        if constexpr (PH != 2 && PH != 5 && PH != 9 && PH != 21 && PH != 16) {
#endif
            run_phase<PH>(smem);
            if constexpr (PH + 1 < NPHASE) xcd_barrier(bar);
        }
        run_all<PH + 1>(smem, bar);
    }
}
#endif
constexpr size_t WS_CTL = 0, CTL_ZERO_BYTES = 65536;
__global__ void __launch_bounds__(NT, 2) fwd_kernel(Params p) {
#if defined(__HIP_DEVICE_COMPILE__)
    extern __shared__ __attribute__((aligned(16))) unsigned char smem[];
    volatile __attribute__((address_space(3))) unsigned* st = (volatile __attribute__((address_space(3))) unsigned*)((__attribute__((address_space(3))) unsigned char*)smem + LDS_CTL_OFF);
    if (threadIdx.x < 16) st[threadIdx.x] = 0u;
    __syncthreads();
    const XcdBarrier bar = xcd_barrier_post((unsigned*)(p.ws + WS_CTL), st);
    if (p.ws == nullptr) cg::this_grid().sync();
    run_all<0>(smem, bar);
#endif
}

extern "C" void kernel_launch(void* const* d_in, const int* in_sizes, int n_in, void* d_out, int out_size, void* d_ws, size_t ws_size, hipStream_t stream) {
    static int inited = 0, cus = 256, per_cu = 1;
    if (!inited) {
        inited = 1;
        if (ws_size < WS_END) fprintf(stderr, "kernel_launch: workspace too small: %zu < %zu\n", ws_size, (size_t)WS_END);
        int dev = 0; (void)hipGetDevice(&dev); (void)hipDeviceGetAttribute(&cus, hipDeviceAttributeMultiprocessorCount, dev);
        (void)hipFuncSetAttribute((const void*)fwd_kernel, hipFuncAttributeMaxDynamicSharedMemorySize, LDS_BYTES);
        if (hipOccupancyMaxActiveBlocksPerMultiprocessor(&per_cu, (const void*)fwd_kernel, NT, LDS_BYTES) != hipSuccess || per_cu < 1) per_cu = 1;
        (void)hipGetLastError();
    }
    Params p{};
    p.x = (const float*)d_in[0]; p.mem = (const float*)d_in[1]; p.pos = (const int*)d_in[2]; p.gains = (const float*)d_in[3];
    p.wq = (const float*)d_in[4]; p.wkv = (const float*)d_in[5]; p.wo = (const float*)d_in[6]; p.w1 = (const float*)d_in[7]; p.w2 = (const float*)d_in[8];
    p.ev_w_in = (const float*)d_in[9]; p.sgu_g = (const float*)d_in[10]; p.sgu_ws = (const float*)d_in[11]; p.sgu_bs = (const float*)d_in[12];
    p.pool_w = (const float*)d_in[13]; p.pool_scale = (const float*)d_in[14]; p.ev_w_out = (const float*)d_in[15];
    p.od_w_in = (const float*)d_in[16]; p.od_w_out = (const float*)d_in[17];
    p.out = (float*)d_out; p.ws = (unsigned char*)d_ws;
    (void)hipMemsetAsync((char*)d_ws + WS_CTL, 0, CTL_ZERO_BYTES, stream);
    void* args[] = {&p};
    hipError_t e = hipLaunchCooperativeKernel((const void*)fwd_kernel, dim3(cus * per_cu), dim3(NT), args, LDS_BYTES, stream);
    if (e != hipSuccess) fprintf(stderr, "cooperative launch failed: %s\n", hipGetErrorString(e));
}
```

```cpp
#include <hip/hip_runtime.h>
#include <hip/hip_cooperative_groups.h>
#include <cstdio>
#include <cstdint>
namespace cg = cooperative_groups;


#ifndef DUP_PH
#define DUP_PH -1
#endif
#define DSA_DUP 0
#define EXTRA_BARRIERS 0
typedef unsigned short u16;
typedef short bf16x8 __attribute__((ext_vector_type(8)));
typedef float f32x4 __attribute__((ext_vector_type(4)));

constexpr int NT = 512;
constexpr int NB = 8, SEQ = 4096, T = NB * SEQ, DM = 1024, NMEM = 256, DFF = 4096;
constexpr int EVEN_IN = 1536, ODD_IN = 1864, ZP1 = 2048, ZP0 = 2048;
constexpr float EPS = 1e-6f;

constexpr size_t MiB = 1u << 20;
constexpr size_t WS_WKV = 2 * MiB, WS_WQ = 10 * MiB, WS_WO = 14 * MiB, WS_W1 = 18 * MiB, WS_W2 = 34 * MiB;
constexpr size_t WS_EVIN = 50 * MiB, WS_EVOUT = 53 * MiB, WS_ODIN = 55 * MiB, WS_ODOUT = 59 * MiB;
constexpr size_t WS_WC = 61 * MiB, WS_PWT = 61 * MiB + 131072;
constexpr size_t WS_RS = 62 * MiB;
constexpr size_t WS_ROPE = 66 * MiB;
constexpr size_t WS_MEMN = 82 * MiB;
constexpr size_t WS_KV   = 90 * MiB;
constexpr size_t WS_HN   = 122 * MiB;
constexpr size_t WS_Y    = 186 * MiB;
constexpr size_t WS_Z    = 250 * MiB;
constexpr size_t WS_MIX  = 378 * MiB;
constexpr size_t WS_Q    = 442 * MiB;
constexpr size_t WS_KB = 442 * MiB, WS_VB = 450 * MiB, WS_KI = 458 * MiB;
constexpr size_t WS_BT1 = 442 * MiB, WS_BT2 = 458 * MiB;
constexpr size_t WS_HID  = 250 * MiB;
constexpr size_t WS_END  = 506 * MiB;

constexpr int DSA_WAVE_LDS = 19 * 1024;
constexpr int NPHASE = 27;
constexpr int LDS_CTL_OFF = 8 * DSA_WAVE_LDS;
constexpr int LDS_BYTES = LDS_CTL_OFF + 64;

struct Params {
    const float* x; const float* mem; const int* pos; const float* gains;
    const float* wq; const float* wkv; const float* wo; const float* w1; const float* w2;
    const float* ev_w_in; const float* sgu_g; const float* sgu_ws; const float* sgu_bs;
    const float* pool_w; const float* pool_scale; const float* ev_w_out;
    const float* od_w_in; const float* od_w_out;
    float* out; unsigned char* ws;
};

#if defined(__HIP_DEVICE_COMPILE__)
__device__ __forceinline__ u16 f2bf(float f) { unsigned u = __float_as_uint(f); return (u16)((u + 0x7fffu + ((u >> 16) & 1u)) >> 16); }
__device__ __forceinline__ float bf2f(u16 h) { return __uint_as_float(((unsigned)h) << 16); }
__device__ __forceinline__ float bflo(unsigned w) { return __uint_as_float(w << 16); }
__device__ __forceinline__ float bfhi(unsigned w) { return __uint_as_float(w & 0xffff0000u); }
__device__ __forceinline__ unsigned pk2hw(float lo, float hi) { unsigned r; asm("v_cvt_pk_bf16_f32 %0, %1, %2" : "=v"(r) : "v"(lo), "v"(hi)); return r; }
__device__ __forceinline__ unsigned pk2(float lo, float hi) { return (unsigned)f2bf(lo) | ((unsigned)f2bf(hi) << 16); }
__device__ __forceinline__ float wsum(float v) {
#pragma unroll
    for (int o = 32; o > 0; o >>= 1) v += __shfl_xor(v, o);
    return v;
}
__device__ __forceinline__ float rsum16(float v) {
    v += __int_as_float(__builtin_amdgcn_update_dpp(0, __float_as_int(v), 0xB1, 0xf, 0xf, true));
    v += __int_as_float(__builtin_amdgcn_update_dpp(0, __float_as_int(v), 0x4E, 0xf, 0xf, true));
    v += __int_as_float(__builtin_amdgcn_update_dpp(0, __float_as_int(v), 0x141, 0xf, 0xf, true));
    v += __int_as_float(__builtin_amdgcn_update_dpp(0, __float_as_int(v), 0x140, 0xf, 0xf, true));
    return v;
}
__device__ __forceinline__ float wmax(float v) {
#pragma unroll
    for (int o = 32; o > 0; o >>= 1) v = fmaxf(v, __shfl_xor(v, o));
    return v;
}
__device__ __forceinline__ float gelu_tanh(float x) { return 0.5f * x * (1.f + tanhf(0.7978845608028654f * (x + 0.044715f * x * x * x))); }
__device__ __forceinline__ int tid_opaque() { int t = threadIdx.x; asm volatile("" : "+v"(t)); return t; }
#ifndef LAS3
#define LAS3 __attribute__((address_space(3)))
#endif
#define WAVE_SYNC() asm volatile("s_waitcnt lgkmcnt(0)" ::: "memory")
__device__ __forceinline__ int vblock() { return __builtin_amdgcn_readfirstlane(*(volatile LAS3 int*)(unsigned)(LDS_CTL_OFF + 8)); }

__device__ __forceinline__ void rmsnorm_rows(const float* in, const float* g, u16* out, int rows) {
    const int tid = tid_opaque(), lane = tid & 63, gw = (blockIdx.x * NT + tid) >> 6, ngw = (gridDim.x * NT) >> 6;
    for (int r = gw; r < rows; r += ngw) {
        const float4* xr = (const float4*)(in + (size_t)r * DM);
        float4 v[4]; float ss = 0.f;
#pragma unroll
        for (int j = 0; j < 4; ++j) { v[j] = xr[lane + 64 * j]; ss += v[j].x * v[j].x + v[j].y * v[j].y + v[j].z * v[j].z + v[j].w * v[j].w; }
        ss = wsum(ss);
        const float rstd = rsqrtf(ss * (1.f / DM) + EPS);
#pragma unroll
        for (int j = 0; j < 4; ++j) {
            const float4 gg = ((const float4*)g)[lane + 64 * j];
            uint2 o; o.x = pk2(v[j].x * rstd * gg.x, v[j].y * rstd * gg.y); o.y = pk2(v[j].z * rstd * gg.z, v[j].w * rstd * gg.w);
            ((uint2*)(out + (size_t)r * DM))[lane + 64 * j] = o;
        }
    }
}
__device__ __forceinline__ void cast_rows(const float* in, u16* hb, float* rs) {
    const int tid = tid_opaque(), lane = tid & 63, gw = (blockIdx.x * NT + tid) >> 6, ngw = (gridDim.x * NT) >> 6;
    for (int r = gw; r < T; r += ngw) {
        const float4* xr = (const float4*)(in + (size_t)r * DM);
        float4 v[4]; float ss = 0.f;
#pragma unroll
        for (int j = 0; j < 4; ++j) { v[j] = xr[lane + 64 * j]; ss += v[j].x * v[j].x + v[j].y * v[j].y + v[j].z * v[j].z + v[j].w * v[j].w; }
        ss = wsum(ss);
#pragma unroll
        for (int j = 0; j < 4; ++j) { uint2 o; o.x = pk2(v[j].x, v[j].y); o.y = pk2(v[j].z, v[j].w); ((uint2*)(hb + (size_t)r * DM))[lane + 64 * j] = o; }
        if (lane == 0) rs[r] = rsqrtf(ss * (1.f / DM) + EPS);
    }
}
template <bool FINAL> __device__ __forceinline__ void postnorm_rows(u16* hb, const u16* y, const float* gpost, float* rs, float* fout) {
    const int vb = vblock(), tid = tid_opaque(), lane = tid & 63, gw = (vb >> 3) * 8 + (tid >> 6), ngw = 256, rbase = (vb & 7) * SEQ, rend = rbase + SEQ;
    for (int r0 = rbase + gw; r0 < rend; r0 += 2 * ngw) {
        const bool two = r0 + ngw < rend; const int r1 = two ? r0 + ngw : r0;
        uint4 yw[2][2], hw[2][2];
#pragma unroll
        for (int q = 0; q < 2; ++q) { const size_t ro = (size_t)(q ? r1 : r0) * DM + lane * 8;
#pragma unroll
            for (int j = 0; j < 2; ++j) { yw[q][j] = *(const uint4*)(y + ro + j * 512); hw[q][j] = *(const uint4*)(hb + ro + j * 512); } }
        float4 g0[2], g1[2];
#pragma unroll
        for (int j = 0; j < 2; ++j) { g0[j] = *(const float4*)(gpost + j * 512 + lane * 8); g1[j] = *(const float4*)(gpost + j * 512 + lane * 8 + 4); }
#pragma unroll
        for (int q = 0; q < 2; ++q) {
            if (q == 1 && !two) break;
            const int r = q ? r1 : r0;
            float yv[16], hv[16]; float ss = 0.f;
#pragma unroll
            for (int j = 0; j < 2; ++j) {
                const uint4 w = yw[q][j], h4 = hw[q][j];
                yv[j * 8 + 0] = bflo(w.x); yv[j * 8 + 1] = bfhi(w.x); yv[j * 8 + 2] = bflo(w.y); yv[j * 8 + 3] = bfhi(w.y);
                yv[j * 8 + 4] = bflo(w.z); yv[j * 8 + 5] = bfhi(w.z); yv[j * 8 + 6] = bflo(w.w); yv[j * 8 + 7] = bfhi(w.w);
                hv[j * 8 + 0] = bflo(h4.x); hv[j * 8 + 1] = bfhi(h4.x); hv[j * 8 + 2] = bflo(h4.y); hv[j * 8 + 3] = bfhi(h4.y);
                hv[j * 8 + 4] = bflo(h4.z); hv[j * 8 + 5] = bfhi(h4.z); hv[j * 8 + 6] = bflo(h4.w); hv[j * 8 + 7] = bfhi(h4.w);
            }
#pragma unroll
            for (int i = 0; i < 16; ++i) ss += yv[i] * yv[i];
            ss = wsum(ss);
            const float rstd = rsqrtf(ss * (1.f / DM) + EPS);
            float s2 = 0.f;
#pragma unroll
            for (int j = 0; j < 2; ++j) {
                hv[j * 8 + 0] += yv[j * 8 + 0] * rstd * g0[j].x; hv[j * 8 + 1] += yv[j * 8 + 1] * rstd * g0[j].y; hv[j * 8 + 2] += yv[j * 8 + 2] * rstd * g0[j].z; hv[j * 8 + 3] += yv[j * 8 + 3] * rstd * g0[j].w;
                hv[j * 8 + 4] += yv[j * 8 + 4] * rstd * g1[j].x; hv[j * 8 + 5] += yv[j * 8 + 5] * rstd * g1[j].y; hv[j * 8 + 6] += yv[j * 8 + 6] * rstd * g1[j].z; hv[j * 8 + 7] += yv[j * 8 + 7] * rstd * g1[j].w;
                if constexpr (FINAL) {
                    float* o = fout + (size_t)r * DM + j * 512 + lane * 8;
                    *(float4*)o = make_float4(hv[j * 8 + 0], hv[j * 8 + 1], hv[j * 8 + 2], hv[j * 8 + 3]);
                    *(float4*)(o + 4) = make_float4(hv[j * 8 + 4], hv[j * 8 + 5], hv[j * 8 + 6], hv[j * 8 + 7]);
                } else {
                    uint4 o;
                    o.x = pk2(hv[j * 8 + 0], hv[j * 8 + 1]); o.y = pk2(hv[j * 8 + 2], hv[j * 8 + 3]); o.z = pk2(hv[j * 8 + 4], hv[j * 8 + 5]); o.w = pk2(hv[j * 8 + 6], hv[j * 8 + 7]);
                    *(uint4*)(hb + (size_t)r * DM + j * 512 + lane * 8) = o;
                }
            }
            if constexpr (!FINAL) {
#pragma unroll
                for (int i = 0; i < 16; ++i) s2 += hv[i] * hv[i];
                s2 = wsum(s2);
                if (lane == 0) rs[r] = rsqrtf(s2 * (1.f / DM) + EPS);
            }
        }
    }
}

namespace pg8 {
#define PG8_LAS __attribute__((address_space(3)))
typedef unsigned short bf16_t;
typedef short bf16x8 __attribute__((ext_vector_type(8)));
typedef float f32x4 __attribute__((ext_vector_type(4)));
typedef unsigned u32x4 __attribute__((ext_vector_type(4)));
typedef int i32x4 __attribute__((ext_vector_type(4)));
typedef int i32x8 __attribute__((ext_vector_type(8)));
constexpr int BM = 256, BK = 64, HALF = 128, HTB = HALF * BK * 2  , STAGE_BYTES = 8 * HTB, NXCD = 8, WGM = 8;

__host__ __device__ __forceinline__ int lds_byte(int r, int c) { const int st = (r >> 4) * 2 + (c >> 5), rr = r & 15, cc = c & 31, ob = rr * 64 + cc * 2; return st * 1024 + (ob ^ (((ob >> 9) & 1) << 5)); }
__host__ __device__ __forceinline__ void stage_rc(int b, int& R, int& C) { const int st = b / 1024, sb = b % 1024, swz = sb ^ (((sb >> 9) & 1) << 5); R = (st >> 1) * 16 + swz / 64; C = (st & 1) * 32 + (swz % 64) / 2; }
__host__ __device__ __forceinline__ int perm32(int rho) { const int n = rho >> 4, i = rho & 15; return 8 * (i >> 2) + 4 * n + (i & 3); }

struct Unit { int pm, pn; long aoff, boff, coff; };
struct Gemm { const bf16_t* A; const bf16_t* Bt; int M, N, K, lda, ldb; };

struct StaticOrder {
    int nM, nN, nwg, G, c;
    __host__ __device__ void init(int M, int N, int G_, int c_) { nM = M / BM; nN = N / BM; nwg = nM * nN; G = G_; c = c_; }
    __host__ __device__ bool next(int i, Unit& u) const {
        const long L = (long)i * G + c; if (L >= nwg) return false;
        int wgid = (int)L; { const int q = nwg / NXCD, r = nwg % NXCD, xcd = wgid % NXCD, off = wgid / NXCD; wgid = (xcd < r ? xcd * (q + 1) : r * (q + 1) + (xcd - r) * q) + off; }
        const int nig = WGM * nN, gid = wgid / nig, fm = gid * WGM, gsz = (nM - fm) < WGM ? (nM - fm) : WGM;
        u.pm = fm + ((wgid % nig) % gsz); u.pn = (wgid % nig) / gsz; u.aoff = 0; u.boff = 0; u.coff = 0; return true;
    }
    __device__ __forceinline__ void a_ready(const Unit&) const {}
    __device__ __forceinline__ void done(const Unit&) const {}
};
__device__ __forceinline__ unsigned cvt_pk_bf16(float lo, float hi) { unsigned r; asm volatile("v_cvt_pk_bf16_f32 %0, %1, %2" : "=v"(r) : "v"(lo), "v"(hi)); return r; }
template <class Epi, class Sched, bool ALIGN_EPI = false, bool SP2 = false, bool F8 = false>
__device__ __forceinline__ void gemm_phase(PG8_LAS unsigned char* lds, const Gemm g, const Sched& S, const Epi& E) {
    const int tid = tid_opaque(), wid = __builtin_amdgcn_readfirstlane(tid >> 6), lane = tid & 63, wr = wid >> 2, wc = wid & 3, fr = lane & 15, fq = lane >> 4;
    const int K = g.K, nt = K / BK;
    unsigned voffA[2], voffB[2];
#pragma unroll
    for (int i = 0; i < 2; ++i) { int R, C; stage_rc(tid * 16 + i * 8192, R, C); const int Rb = Epi::PERM ? ((R & ~31) + perm32(R & 31)) : R;
        voffA[i] = (unsigned)(R * g.lda + C) * 2u; voffB[i] = (unsigned)(Rb * g.ldb + C) * 2u; }
    const size_t kstep = (size_t)(BK * 2);
    const size_t hstepA = (size_t)HALF * g.lda * 2, hstepB = (size_t)HALF * g.ldb * 2;
    const size_t tstepA = 2 * hstepA, tstepB = 2 * hstepB;
    const unsigned ldsw = (unsigned)wid * 1024u;
    const int aoff = lds_byte(wr * 64 + fr, fq * 8), boff = lds_byte(wc * 32 + fr, fq * 8);
#define PG8_SA(b, h) (((b) * 2 + (h)) * HTB)
#define PG8_SB(b, h) ((4 + (b) * 2 + (h)) * HTB)
#define PG8_STAGE(bufoff, gbase, voff) do { _Pragma("unroll") for (int _i = 0; _i < 2; ++_i) \
        __builtin_amdgcn_global_load_lds((const unsigned*)((const char*)(gbase) + (voff)[_i]), (PG8_LAS unsigned*)(lds + (bufoff) + ldsw + _i * 8192), 16, 0, 0); } while (0)
#define PG8_LDA(dst, b, h) do { _Pragma("unroll") for (int m = 0; m < 4; ++m) _Pragma("unroll") for (int k = 0; k < 2; ++k) dst[m][k] = *(const PG8_LAS bf16x8*)(lds + PG8_SA(b, h) + aoff + m * 2048 + k * 1024); } while (0)
#define PG8_LDB(dst, b, h) do { _Pragma("unroll") for (int n = 0; n < 2; ++n) _Pragma("unroll") for (int k = 0; k < 2; ++k) dst[n][k] = *(const PG8_LAS bf16x8*)(lds + PG8_SB(b, h) + boff + n * 2048 + k * 1024); } while (0)
#define PG8_MMA(ai, bj, At, Bt) do { __builtin_amdgcn_s_setprio(1); _Pragma("unroll") for (int m = 0; m < 4; ++m) _Pragma("unroll") for (int n = 0; n < 2; ++n) { \
        if constexpr (F8) { const i32x8 b8_ = __builtin_shufflevector((i32x4)Bt[n][0], (i32x4)Bt[n][1], 0, 1, 2, 3, 4, 5, 6, 7), a8_ = __builtin_shufflevector((i32x4)At[m][0], (i32x4)At[m][1], 0, 1, 2, 3, 4, 5, 6, 7); \
                            asm volatile("v_mfma_f32_16x16x128_f8f6f4 %0, %1, %2, %0" : "+v"(acc[ai][bj][m][n]) : "v"(b8_), "v"(a8_)); } \
        else { _Pragma("unroll") for (int k = 0; k < 2; ++k) acc[ai][bj][m][n] = __builtin_amdgcn_mfma_f32_16x16x32_bf16(Bt[n][k], At[m][k], acc[ai][bj][m][n], 0, 0, 0); } } \
        __builtin_amdgcn_s_setprio(0); } while (0)
#define PG8_WAIT_V(n) asm volatile("s_waitcnt vmcnt(" #n ")" ::: "memory")
#define PG8_WAIT_L(n) asm volatile("s_waitcnt lgkmcnt(" #n ")" ::: "memory")
#define PG8_BAR __builtin_amdgcn_s_barrier()
#define PG8_SCHED __builtin_amdgcn_sched_barrier(0)
    Unit cur, nxt; int ui = 0;
    if (!S.next(0, cur)) return;
    f32x4 acc[2][2][4][2];
#pragma unroll
    for (int a = 0; a < 2; ++a)
#pragma unroll
        for (int b = 0; b < 2; ++b)
#pragma unroll
            for (int m = 0; m < 4; ++m)
#pragma unroll
                for (int n = 0; n < 2; ++n) acc[a][b][m][n] = (f32x4){0.f, 0.f, 0.f, 0.f};
    bf16x8 At[4][2], B0[2][2], B1[2][2];
    const char* cA = (const char*)g.A + (size_t)cur.pm * tstepA + cur.aoff * 2; const char* cB = (const char*)g.Bt + (size_t)cur.pn * tstepB + cur.boff * 2;
    S.a_ready(cur);
    if constexpr (SP2) {
        PG8_STAGE(PG8_SB(0, 0), cB, voffB); PG8_STAGE(PG8_SB(0, 1), cB + hstepB, voffB); PG8_STAGE(PG8_SA(0, 0), cA, voffA); PG8_STAGE(PG8_SA(0, 1), cA + hstepA, voffA);
        if (wr == 1) PG8_BAR;
        PG8_WAIT_V(2); PG8_BAR;
        PG8_STAGE(PG8_SB(1, 0), cB + kstep, voffB); PG8_STAGE(PG8_SA(1, 0), cA + kstep, voffA); PG8_STAGE(PG8_SB(1, 1), cB + hstepB + kstep, voffB);
        PG8_WAIT_V(6); PG8_BAR;
    } else {
        PG8_STAGE(PG8_SB(0, 0), cB, voffB); PG8_STAGE(PG8_SA(0, 0), cA, voffA); PG8_STAGE(PG8_SB(0, 1), cB + hstepB, voffB); PG8_STAGE(PG8_SA(0, 1), cA + hstepA, voffA);
        if (wr == 1) PG8_BAR;
        PG8_WAIT_V(4); PG8_BAR;
        PG8_STAGE(PG8_SB(1, 0), cB + kstep, voffB); PG8_STAGE(PG8_SA(1, 0), cA + kstep, voffA); PG8_STAGE(PG8_SB(1, 1), cB + hstepB + kstep, voffB);
        PG8_WAIT_V(6); PG8_BAR;
    }
    for (;;) {
        const bool has_next = S.next(ui + 1, nxt);
        const char* nA = has_next ? (const char*)g.A + (size_t)nxt.pm * tstepA + nxt.aoff * 2 : cA; const char* nB = has_next ? (const char*)g.Bt + (size_t)nxt.pn * tstepB + nxt.boff * 2 : cB;
        for (int t = 0; t < nt; t += 2) {
            const bool last = (t == nt - 2);
            const char* a1 = cA + (size_t)(t + 1) * kstep;
            const char* a2 = last ? nA : cA + (size_t)(t + 2) * kstep; const char* b2 = last ? nB : cB + (size_t)(t + 2) * kstep;
            const char* a3 = a2 + kstep; const char* b3 = b2 + kstep;
            if (last && has_next) S.a_ready(nxt);
            if constexpr (SP2) {
            PG8_LDB(B0, 0, 0); PG8_LDB(B1, 0, 1); PG8_SCHED; PG8_LDA(At, 0, 0); PG8_STAGE(PG8_SA(1, 1), a1 + hstepA, voffA);
            PG8_WAIT_V(8); PG8_WAIT_L(0); PG8_BAR; PG8_MMA(0, 0, At, B0); PG8_MMA(0, 1, At, B1); PG8_BAR; PG8_SCHED;
            PG8_LDA(At, 0, 1); PG8_STAGE(PG8_SB(0, 0), b2, voffB); PG8_STAGE(PG8_SB(0, 1), b2 + hstepB, voffB); PG8_STAGE(PG8_SA(0, 0), a2, voffA);
            PG8_WAIT_V(8); PG8_WAIT_L(0); PG8_BAR; PG8_MMA(1, 0, At, B0); PG8_MMA(1, 1, At, B1); PG8_BAR; PG8_SCHED;
            PG8_LDB(B0, 1, 0); PG8_LDB(B1, 1, 1); PG8_SCHED; PG8_LDA(At, 1, 0); PG8_STAGE(PG8_SA(0, 1), a2 + hstepA, voffA);
            PG8_WAIT_V(8); PG8_WAIT_L(0); PG8_BAR; PG8_MMA(0, 0, At, B0); PG8_MMA(0, 1, At, B1); PG8_BAR; PG8_SCHED;
            PG8_LDA(At, 1, 1); PG8_STAGE(PG8_SB(1, 0), b3, voffB); PG8_STAGE(PG8_SB(1, 1), b3 + hstepB, voffB); PG8_STAGE(PG8_SA(1, 0), a3, voffA);
            PG8_WAIT_V(8); PG8_WAIT_L(0); PG8_BAR; PG8_MMA(1, 0, At, B0); PG8_MMA(1, 1, At, B1); PG8_BAR; PG8_SCHED;
            } else {
            PG8_LDB(B0, 0, 0); PG8_SCHED; PG8_LDA(At, 0, 0); PG8_STAGE(PG8_SA(1, 1), a1 + hstepA, voffA);
            PG8_WAIT_L(8); PG8_BAR; PG8_WAIT_L(0); PG8_MMA(0, 0, At, B0); PG8_BAR; PG8_SCHED;
            PG8_LDB(B1, 0, 1); PG8_STAGE(PG8_SB(0, 0), b2, voffB);
            PG8_BAR; PG8_WAIT_L(0); PG8_MMA(0, 1, At, B1); PG8_BAR;
            PG8_LDA(At, 0, 1); PG8_STAGE(PG8_SA(0, 0), a2, voffA);
            PG8_BAR; PG8_WAIT_L(0); PG8_MMA(1, 0, At, B0); PG8_BAR; PG8_SCHED;
            PG8_STAGE(PG8_SB(0, 1), b2 + hstepB, voffB);
            PG8_WAIT_V(6); PG8_BAR; PG8_MMA(1, 1, At, B1); PG8_BAR;
            PG8_LDB(B0, 1, 0); PG8_SCHED; PG8_LDA(At, 1, 0); PG8_STAGE(PG8_SA(0, 1), a2 + hstepA, voffA);
            PG8_WAIT_L(8); PG8_BAR; PG8_WAIT_L(0); PG8_MMA(0, 0, At, B0); PG8_BAR; PG8_SCHED;
            PG8_LDB(B1, 1, 1); PG8_STAGE(PG8_SB(1, 0), b3, voffB);
            PG8_BAR; PG8_WAIT_L(0); PG8_MMA(0, 1, At, B1); PG8_BAR;
            PG8_LDA(At, 1, 1); PG8_STAGE(PG8_SA(1, 0), a3, voffA);
            PG8_BAR; PG8_WAIT_L(0); PG8_MMA(1, 0, At, B0); PG8_BAR; PG8_SCHED;
            PG8_STAGE(PG8_SB(1, 1), b3 + hstepB, voffB);
            PG8_WAIT_V(6); PG8_BAR; PG8_MMA(1, 1, At, B1); PG8_BAR;
            }
        }
        if constexpr (F8) asm volatile("s_nop 15\n\ts_nop 15\n\ts_nop 15\n\ts_nop 15" ::: "memory");
        if constexpr (ALIGN_EPI) { if (wr == 0) PG8_BAR; }
        if constexpr (!Epi::AFTER_DRAIN) { E(acc, cur, wr, wc, fr, fq); S.done(cur); }
        if (!has_next) break;
#pragma unroll
        for (int a = 0; a < 2; ++a)
#pragma unroll
            for (int b = 0; b < 2; ++b)
#pragma unroll
                for (int m = 0; m < 4; ++m)
#pragma unroll
                    for (int n = 0; n < 2; ++n) acc[a][b][m][n] = (f32x4){0.f, 0.f, 0.f, 0.f};
        cur = nxt; cA = nA; cB = nB; ++ui;
        if constexpr (ALIGN_EPI) { if (wr == 1) PG8_BAR; }
    }
    PG8_WAIT_V(0);
    if constexpr (!ALIGN_EPI) { if (wr == 0) PG8_BAR; }
    PG8_BAR;
    if constexpr (Epi::AFTER_DRAIN) { E.fused(acc, cur, wr, wc, fr, fq, lds, wid, lane); S.done(cur); }
#undef PG8_SA
#undef PG8_SB
#undef PG8_STAGE
#undef PG8_LDA
#undef PG8_LDB
#undef PG8_MMA
#undef PG8_WAIT_V
#undef PG8_WAIT_L
#undef PG8_BAR
#undef PG8_SCHED
}
}

struct EpiStore {
    static constexpr bool PERM = true, AFTER_DRAIN = false;
    u16* O; int ldc; int act; const float* rs;
    float osc = 1.f;
    __device__ __forceinline__ void operator()(const pg8::f32x4 (&acc)[2][2][4][2], const pg8::Unit& u, int wr, int wc, int fr, int fq) const {
        int fr_ = fr, fq_ = fq; asm volatile("" : "+v"(fr_), "+v"(fq_));
        const int row0 = u.pm * 256 + wr * 64 + fr_;
        u16* base = O + u.coff + (size_t)(u.pm * 256) * ldc + u.pn * 256;
        const int loff0 = (wr * 64 + fr_) * ldc + wc * 32 + 8 * fq_;
#pragma unroll
        for (int ai = 0; ai < 2; ++ai)
#pragma unroll
            for (int m = 0; m < 4; ++m) { u16* rowp = base + (loff0 + (ai * 128 + m * 16) * ldc);
                const float rsc = rs ? rs[row0 + ai * 128 + m * 16] : osc;
#pragma unroll
                for (int bj = 0; bj < 2; ++bj) { pg8::f32x4 v0 = acc[ai][bj][m][0] * rsc, v1 = acc[ai][bj][m][1] * rsc;
                    if (act == 1) {
#pragma unroll
                        for (int r = 0; r < 4; ++r) { const float a = fmaxf(v0[r], 0.f), b = fmaxf(v1[r], 0.f); v0[r] = a * a; v1[r] = b * b; }
                    }
                    pg8::u32x4 w; w.x = pg8::cvt_pk_bf16(v0[0], v0[1]); w.y = pg8::cvt_pk_bf16(v0[2], v0[3]); w.z = pg8::cvt_pk_bf16(v1[0], v1[1]); w.w = pg8::cvt_pk_bf16(v1[2], v1[3]);
                    *(pg8::u32x4*)(rowp + bj * 128) = w; } }
    }
};
struct EpiStoreF8 {
    static constexpr bool PERM = true, AFTER_DRAIN = false;
    unsigned char* O; int ldc; const float* rs;
    __device__ __forceinline__ void operator()(const pg8::f32x4 (&acc)[2][2][4][2], const pg8::Unit& u, int wr, int wc, int fr, int fq) const {
        int fr_ = fr, fq_ = fq; asm volatile("" : "+v"(fr_), "+v"(fq_));
        const int row0 = u.pm * 256 + wr * 64 + fr_;
        unsigned char* base = O + (size_t)(u.pm * 256) * ldc + u.pn * 256;
        const int loff0 = (wr * 64 + fr_) * ldc + wc * 32 + 8 * fq_;
#pragma unroll
        for (int ai = 0; ai < 2; ++ai)
#pragma unroll
            for (int m = 0; m < 4; ++m) { unsigned char* rowp = base + (loff0 + (ai * 128 + m * 16) * ldc);
                const float rsc = rs[row0 + ai * 128 + m * 16] * 2.8284271247461903f;
#pragma unroll
                for (int bj = 0; bj < 2; ++bj) { pg8::f32x4 v0 = acc[ai][bj][m][0] * rsc, v1 = acc[ai][bj][m][1] * rsc;
#pragma unroll
                    for (int r = 0; r < 4; ++r) { const float a = fmaxf(v0[r], 0.f), b = fmaxf(v1[r], 0.f); v0[r] = fminf(a * a, 448.f); v1[r] = fminf(b * b, 448.f); }
                    int lo8 = __builtin_amdgcn_cvt_pk_fp8_f32(v0[0], v0[1], 0, false); lo8 = __builtin_amdgcn_cvt_pk_fp8_f32(v0[2], v0[3], lo8, true);
                    int hi8 = __builtin_amdgcn_cvt_pk_fp8_f32(v1[0], v1[1], 0, false); hi8 = __builtin_amdgcn_cvt_pk_fp8_f32(v1[2], v1[3], hi8, true);
                    uint2 w; w.x = (unsigned)lo8; w.y = (unsigned)hi8;
                    *(uint2*)(rowp + bj * 128) = w; } }
    }
};
template <int TYPE> struct PreOrder {
    int b, id16, l;
    __device__ __forceinline__ bool next(int i, pg8::Unit& u) const {
        if (i > 0) return false;
        const int pt = id16 & 3, h = (id16 >> 2) & 3;
        if (TYPE == 0) { u.pm = 0; u.pn = pt; u.aoff = (long)l * 2048 * 2048 + (long)(b * 256) * 2048 + h * 256; u.boff = (long)l * DM * DM + h * 256;
                         u.coff = ((long)b * 1024 + h * 256) * 1024; }
        else { u.pm = pt; u.pn = 0; u.aoff = (long)l * DM * DM + h * 256; u.boff = (long)l * 2048 * 2048 + (long)(b * 256) * 2048 + 1024 + h * 256;
               u.coff = (long)b * 1024 * 1024 + h * 256; }
        return true;
    }
    __device__ __forceinline__ void a_ready(const pg8::Unit&) const {}
    __device__ __forceinline__ void done(const pg8::Unit&) const {}
};
struct KvOrder {
    int vb;
    __device__ __forceinline__ bool next(int i, pg8::Unit& u) const {
        const int rk = vb >> 3; if (i > 0 || rk >= 16) return false;
        const int l = rk >> 3;
        u.pm = vb & 7; u.pn = rk & 7; u.aoff = (long)l * 2048 * DM; u.boff = (long)l * 2048 * DM; u.coff = (long)l * 2048 * 2048; return true;
    }
    __device__ __forceinline__ void a_ready(const pg8::Unit&) const {}
    __device__ __forceinline__ void done(const pg8::Unit&) const {}
};
struct BatchBOrder : pg8::StaticOrder {
    __device__ __forceinline__ bool next(int i, pg8::Unit& u) const { if (!pg8::StaticOrder::next(i, u)) return false; u.boff = (long)(u.pm >> 4) * (1024 * 1024); return true; }
};
struct EpiSoftmax {
    static constexpr bool PERM = true, AFTER_DRAIN = false;
    u16* O; int ldc; const float* rs; PG8_LAS float* xl;
    __device__ __forceinline__ void operator()(pg8::f32x4 (&acc)[2][2][4][2], const pg8::Unit& u, int wr, int wc, int fr, int fq) const {
        int fr_ = fr, fq_ = fq; asm volatile("" : "+v"(fr_), "+v"(fq_));
        const int row0 = u.pm * 256 + wr * 64 + fr_;
        u16* base = O + (size_t)(u.pm * 256) * ldc + u.pn * 256;
        const int loff0 = (wr * 64 + fr_) * ldc + wc * 32 + 8 * fq_;
        float mown[2][4];
#pragma unroll
        for (int ai = 0; ai < 2; ++ai)
#pragma unroll
            for (int m = 0; m < 4; ++m) {
                const float rsc = rs[row0 + ai * 128 + m * 16] * (0.0625f * 1.4426950408889634f);
                float mx = -INFINITY;
#pragma unroll
                for (int bj = 0; bj < 2; ++bj)
#pragma unroll
                    for (int n = 0; n < 2; ++n) { acc[ai][bj][m][n] = acc[ai][bj][m][n] * rsc;
#pragma unroll
                        for (int r = 0; r < 4; ++r) mx = fmaxf(mx, acc[ai][bj][m][n][r]); }
                mx = fmaxf(mx, __shfl_xor(mx, 16)); mx = fmaxf(mx, __shfl_xor(mx, 32));
                float l = 0.f;
#pragma unroll
                for (int bj = 0; bj < 2; ++bj)
#pragma unroll
                    for (int n = 0; n < 2; ++n)
#pragma unroll
                        for (int r = 0; r < 4; ++r) { const float e = __builtin_amdgcn_exp2f(acc[ai][bj][m][n][r] - mx); acc[ai][bj][m][n][r] = e; l += e; }
                l += __shfl_xor(l, 16); l += __shfl_xor(l, 32);
                mown[ai][m] = mx;
                if (fq_ == 0) { PG8_LAS float* x = xl + ((ai * 128 + wr * 64 + m * 16 + fr_) * 4 + wc) * 2; x[0] = mx; x[1] = l; }
            }
        asm volatile("s_waitcnt lgkmcnt(0)" ::: "memory"); __builtin_amdgcn_s_barrier(); asm volatile("" ::: "memory");
#pragma unroll
        for (int ai = 0; ai < 2; ++ai)
#pragma unroll
            for (int m = 0; m < 4; ++m) {
                const PG8_LAS pg8::f32x4* x = (const PG8_LAS pg8::f32x4*)(xl + (ai * 128 + wr * 64 + m * 16 + fr_) * 8);
                const pg8::f32x4 x0 = x[0], x1 = x[1];
                const float M = fmaxf(fmaxf(x0[0], x0[2]), fmaxf(x1[0], x1[2]));
                const float L = x0[1] * __builtin_amdgcn_exp2f(x0[0] - M) + x0[3] * __builtin_amdgcn_exp2f(x0[2] - M) + x1[1] * __builtin_amdgcn_exp2f(x1[0] - M) + x1[3] * __builtin_amdgcn_exp2f(x1[2] - M);
                const float f = __builtin_amdgcn_exp2f(mown[ai][m] - M) / L;
                u16* rowp = base + (loff0 + (ai * 128 + m * 16) * ldc);
#pragma unroll
                for (int bj = 0; bj < 2; ++bj) { const pg8::f32x4 v0 = acc[ai][bj][m][0] * f, v1 = acc[ai][bj][m][1] * f;
                    pg8::u32x4 w; w.x = pg8::cvt_pk_bf16(v0[0], v0[1]); w.y = pg8::cvt_pk_bf16(v0[2], v0[3]); w.z = pg8::cvt_pk_bf16(v1[0], v1[1]); w.w = pg8::cvt_pk_bf16(v1[2], v1[3]);
                    *(pg8::u32x4*)(rowp + bj * 128) = w; }
            }
    }
};
struct EpiRope {
    static constexpr bool PERM = true, AFTER_DRAIN = false;
    u16* Z; u16* KB; u16* VB; u16* KI; const float* rs; const float2* rope;
    __device__ __forceinline__ void operator()(const pg8::f32x4 (&acc)[2][2][4][2], const pg8::Unit& u, int wr, int wc, int fr, int fq) const {
        int fr_ = fr, fq_ = fq; asm volatile("" : "+v"(fr_), "+v"(fq_));
#pragma unroll
        for (int ai = 0; ai < 2; ++ai)
#pragma unroll
            for (int m = 0; m < 4; ++m) {
                const int row = u.pm * 256 + ai * 128 + wr * 64 + m * 16 + fr_;
                const float rsc = rs[row];
#pragma unroll
                for (int bj = 0; bj < 2; ++bj) {
                    const int col = u.pn * 256 + bj * 128 + wc * 32 + 8 * fq_;
                    const pg8::f32x4 a0 = acc[ai][bj][m][0] * rsc, a1 = acc[ai][bj][m][1] * rsc;
                    float v[8] = {a0[0], a0[1], a0[2], a0[3], a1[0], a1[1], a1[2], a1[3]};
                    const bool is_v = (u.pn == 4 && bj == 1), is_tail = (u.pn == 7) && (bj == 1 || wc >= 2);
                    if (!is_v && !is_tail) {
                        const bool small = u.pn >= 5;
                        const int lc = small ? (col & 63) : (col & 127), i0 = lc >> 1;
                        const float2* tp = rope + (size_t)row * 64 + (small ? 2 * i0 : i0);
#pragma unroll
                        for (int e = 0; e < 4; ++e) {
                            const float2 cs = tp[small ? 2 * e : e];
                            const float x1 = v[2 * e], x2 = v[2 * e + 1];
                            v[2 * e] = x1 * cs.x - x2 * cs.y; v[2 * e + 1] = x2 * cs.x + x1 * cs.y;
                        }
                    }
                    pg8::u32x4 w; w.x = pg8::cvt_pk_bf16(v[0], v[1]); w.y = pg8::cvt_pk_bf16(v[2], v[3]); w.z = pg8::cvt_pk_bf16(v[4], v[5]); w.w = pg8::cvt_pk_bf16(v[6], v[7]);
                    if (u.pn < 4 || u.pn == 5 || u.pn == 6) *(pg8::u32x4*)(Z + (size_t)row * ZP1 + col) = w;
                    else if (u.pn == 4) { if (bj == 0) *(pg8::u32x4*)(KB + (size_t)row * 128 + (col - 1024)) = w; else *(pg8::u32x4*)(VB + (size_t)row * 128 + (col - 1152)) = w; }
                    else {
                        if (bj == 0 && wc < 2) { const int d = col - 1792, s = row & 4095, bb = row >> 12;
                            *(pg8::u32x4*)(KI + ((size_t)bb * 128 + (s >> 5)) * 2048 + ((d >> 4) * 2 + ((d >> 3) & 1)) * 256 + (s & 31) * 8) = w; }
                        else if (bj == 0 && wc == 2 && fq_ == 0) {
                            pg8::u32x4 ww; ww.x = pg8::cvt_pk_bf16(v[0] * 0.35355339059327373f, v[1] * 0.35355339059327373f); ww.y = pg8::cvt_pk_bf16(v[2] * 0.35355339059327373f, v[3] * 0.35355339059327373f);
                            ww.z = pg8::cvt_pk_bf16(v[4] * 0.35355339059327373f, v[5] * 0.35355339059327373f); ww.w = pg8::cvt_pk_bf16(v[6] * 0.35355339059327373f, v[7] * 0.35355339059327373f);
                            *(pg8::u32x4*)(Z + (size_t)row * ZP1 + 1856) = ww; }
                    }
                }
            }
    }
};
__device__ __forceinline__ void gemm8(const u16* A, const u16* Bt, int M, int N, int K, u16* C, int ldc, int act, const float* rs, unsigned char* smem) {
    pg8::Gemm g{A, Bt, M, N, K, K, K}; pg8::StaticOrder S; S.init(M, N, (int)gridDim.x, vblock());
    EpiStore E{C, ldc, act, rs};
    pg8::gemm_phase<EpiStore, pg8::StaticOrder, true, true>((PG8_LAS unsigned char*)smem, g, S, E);
}

__device__ __forceinline__ int rope_col_perm(int n) {
    if (n < 1152) { const int d = n & 127; return (n & ~127) + 2 * (d & 63) + (d >> 6); }
    if (n < 1280 || n >= 1856) return n;
    const int d = (n - 1280) & 63; return n - d + 2 * (d & 31) + (d >> 5);
}
template <bool ROPE_PERM = false, bool F8 = false>
__device__ __forceinline__ void transpose_item(const float* W, int K, int N, u16* WT, LAS3 unsigned char* scr, int item, int lane, int nblk, const float* gain) {
    const int kb = item / nblk, nb = item % nblk, k0 = 64 * kb, n0 = 64 * nb;
    { const int kr = lane >> 4; int n = n0 + (lane & 15) * 4; if (n + 3 >= N) n = 0;
      const float* src = W + (size_t)(k0 + kr) * N + n;
#pragma unroll 1
      for (int i = 0; i < 16; ++i) { __builtin_amdgcn_global_load_lds((const unsigned*)src, (LAS3 unsigned*)(scr + i * 1040), 16, 0, 0); src += (size_t)4 * N; } }
    const int c = lane & 7;
    float gk[8];
#pragma unroll
    for (int e = 0; e < 8; ++e) gk[e] = F8 ? 256.f : (gain ? gain[k0 + 8 * c + e] : 1.f);
    asm volatile("s_waitcnt vmcnt(0)" ::: "memory");
#pragma unroll
    for (int j = 0; j < 8; ++j) { const int nn = (lane >> 3) + 8 * j;
        const LAS3 float* s = (const LAS3 float*)(scr + (2 * c) * 1040 + nn * 4);
        float v[8];
#pragma unroll
        for (int e = 0; e < 8; ++e) v[e] = *(const LAS3 float*)((const LAS3 unsigned char*)s + (e >> 2) * 1040 + (e & 3) * 256) * gk[e];
        if constexpr (F8) {
            int lo8 = __builtin_amdgcn_cvt_pk_fp8_f32(v[0], v[1], 0, false); lo8 = __builtin_amdgcn_cvt_pk_fp8_f32(v[2], v[3], lo8, true);
            int hi8 = __builtin_amdgcn_cvt_pk_fp8_f32(v[4], v[5], 0, false); hi8 = __builtin_amdgcn_cvt_pk_fp8_f32(v[6], v[7], hi8, true);
            uint2 o8; o8.x = (unsigned)lo8; o8.y = (unsigned)hi8;
            *(uint2*)((unsigned char*)WT + (size_t)(n0 + nn) * K + k0 + 8 * c) = o8;
        } else {
        uint4 o; o.x = pk2(v[0], v[1]); o.y = pk2(v[2], v[3]); o.z = pk2(v[4], v[5]); o.w = pk2(v[6], v[7]);
        if (n0 + nn >= N) o = make_uint4(0u, 0u, 0u, 0u);
        *(uint4*)(WT + (size_t)(ROPE_PERM ? rope_col_perm(n0 + nn) : (n0 + nn)) * K + k0 + 8 * c) = o; } }
    WAVE_SYNC();
}
__device__ __forceinline__ void weight_cast(const float* W, int K, int N, u16* out, const float* gain) {
    const int tid = tid_opaque(); const size_t gt = (size_t)blockIdx.x * NT + tid, gs = (size_t)gridDim.x * NT, tot = (size_t)K * N / 4;
    for (size_t i = gt; i < tot; i += gs) {
        const float4 v = ((const float4*)W)[i]; const float gk = gain[(i * 4) / N];
        uint2 o; o.x = pk2(v.x * gk, v.y * gk); o.y = pk2(v.z * gk, v.w * gk);
        ((uint2*)out)[i] = o;
    }
}
template <bool ROPE_PERM = false, bool F8 = false>
__device__ __forceinline__ void weight_prep(const float* W, int K, int N, int Npad, u16* WT, unsigned char* smem, const float* gain = nullptr) {
    const int tid = tid_opaque(), lane = tid & 63, wid = tid >> 6, gw = (blockIdx.x * NT + tid) >> 6, ngw = (gridDim.x * NT) >> 6;
    LAS3 unsigned char* scr = (LAS3 unsigned char*)smem + wid * 16640;
    const int nblk = Npad / 64, items = (K / 64) * nblk;
    for (int it = gw; it < items; it += ngw) transpose_item<ROPE_PERM, F8>(W, K, N, WT, scr, it, lane, nblk, gain);
}

typedef float f32x16 __attribute__((ext_vector_type(16)));
typedef short s16x4 __attribute__((ext_vector_type(4)));
typedef unsigned u32x4v __attribute__((ext_vector_type(4)));
constexpr int XK_PITCH = 528, XV_PITCH = 576;
__device__ __forceinline__ s16x4 lds_tr16(unsigned addr) {
    return __builtin_bit_cast(s16x4, __builtin_amdgcn_ds_read_tr16_b64_v4i16((LAS3 s16x4*)(uintptr_t)addr));
}

__device__ __forceinline__ float gelu_fast(float x) {
    const float u = 0.7978845608028654f * (x + 0.044715f * x * x * x);
    return x * __builtin_amdgcn_rcpf(1.f + __builtin_amdgcn_exp2f(-2.8853900817779268f * u));
}
constexpr int MV_PITCH = 320, MP_PITCH = 272;
__device__ __forceinline__ void mixer_a_all(const Params& p, unsigned char* smem) {
    const int tid = tid_opaque(), lane = tid & 63, wid = __builtin_amdgcn_readfirstlane(tid >> 6), r32 = lane & 31, hi = lane >> 5, l15 = lane & 15, g4 = lane >> 4;
    LAS3 unsigned char* lds = (LAS3 unsigned char*)smem;
    const unsigned lds0 = (unsigned)(uintptr_t)lds;
    const u16* Z = (const u16*)(p.ws + WS_Z); u16* MIX = (u16*)(p.ws + WS_MIX);
    const int ct = wid & 3, tb0 = wid >> 2;
    const int vb_ = vblock();
#define MIXA_UNIT(I) ((((vb_ & 7) * 32 + 4 * (vb_ >> 5) + (I)) << 2) | ((vb_ >> 3) & 3))
    int unit = MIXA_UNIT(0);
    u32x4v vraw[4];
#pragma unroll
    for (int i = 0; i < 4; ++i) vraw[i] = *(const u32x4v*)(Z + ((size_t)(unit >> 2) * 128 + wid * 16 + 4 * i + g4) * ZP0 + 512 + (unit & 3) * 128 + l15 * 8);
    int gcur = -1;
    bf16x8 wfr[2][8]; float4 ga, gb; float biasj[2];
#pragma unroll 1
    for (int ui = 0; ui < 4; ++ui) {
    unit = MIXA_UNIT(ui);
    const int g = unit & 3, bn = unit >> 2;
    const size_t row0 = (size_t)bn * 128;
    if (g != gcur) {
        gcur = g;
        const u16* Wc = (const u16*)(p.ws + WS_WC) + (size_t)g * 16384;
#pragma unroll
        for (int j = 0; j < 2; ++j)
#pragma unroll
            for (int ks = 0; ks < 8; ++ks) wfr[j][ks] = *(const bf16x8*)(Wc + (32 * (tb0 + 2 * j) + r32) * 128 + 16 * ks + 8 * hi);
        ga = *(const float4*)(p.sgu_g + g * 128 + l15 * 8); gb = *(const float4*)(p.sgu_g + g * 128 + l15 * 8 + 4);
#pragma unroll
        for (int j = 0; j < 2; ++j) biasj[j] = p.sgu_bs[g * 128 + 32 * (tb0 + 2 * j) + r32];
    }
    uint2 uraw[2][4];
#pragma unroll
    for (int j = 0; j < 2; ++j) {
        const int t = 32 * (tb0 + 2 * j) + r32;
#pragma unroll
        for (int rq = 0; rq < 4; ++rq) uraw[j][rq] = *(const uint2*)(Z + (row0 + t) * ZP0 + g * 128 + 32 * ct + 4 * hi + 8 * rq);
    }
    __syncthreads();
    {
#pragma unroll
        for (int i = 0; i < 4; ++i) {
            const int s = wid * 16 + 4 * i + g4;
            const u32x4v w = vraw[i];
            const float a0 = gelu_fast(bflo(w.x)), a1 = gelu_fast(bfhi(w.x)), a2 = gelu_fast(bflo(w.y)), a3 = gelu_fast(bfhi(w.y)),
                        a4 = gelu_fast(bflo(w.z)), a5 = gelu_fast(bfhi(w.z)), a6 = gelu_fast(bflo(w.w)), a7 = gelu_fast(bfhi(w.w));
            const float rstd = rsqrtf(rsum16(a0 * a0 + a1 * a1 + a2 * a2 + a3 * a3 + a4 * a4 + a5 * a5 + a6 * a6 + a7 * a7) * (1.f / 128.f) + EPS);
            u32x4v o;
            o.x = pk2hw(a0 * rstd * ga.x, a1 * rstd * ga.y); o.y = pk2hw(a2 * rstd * ga.z, a3 * rstd * ga.w);
            o.z = pk2hw(a4 * rstd * gb.x, a5 * rstd * gb.y); o.w = pk2hw(a6 * rstd * gb.z, a7 * rstd * gb.w);
            *(LAS3 u32x4v*)(lds + s * MV_PITCH + l15 * 16) = o;
        }
    }
    { const int un = MIXA_UNIT(ui + 1);
      if (ui < 3) {
#pragma unroll
          for (int i = 0; i < 4; ++i) vraw[i] = *(const u32x4v*)(Z + ((size_t)(un >> 2) * 128 + wid * 16 + 4 * i + g4) * ZP0 + 512 + (un & 3) * 128 + l15 * 8);
      } }
    __syncthreads();
    f32x16 acc[2];
#pragma unroll
    for (int j = 0; j < 2; ++j)
#pragma unroll
        for (int r = 0; r < 16; ++r) acc[j][r] = 0.f;
    const unsigned va = lds0 + (8 * hi + (l15 >> 2)) * MV_PITCH + (32 * ct + 16 * (g4 & 1) + 4 * (l15 & 3)) * 2;
#pragma unroll
    for (int ks = 0; ks < 8; ++ks) {
        const s16x4 lo = lds_tr16(va + 16 * ks * MV_PITCH), hh = lds_tr16(va + (16 * ks + 4) * MV_PITCH);
        const bf16x8 vf = (bf16x8){lo[0], lo[1], lo[2], lo[3], hh[0], hh[1], hh[2], hh[3]};
#pragma unroll
        for (int j = 0; j < 2; ++j) acc[j] = __builtin_amdgcn_mfma_f32_32x32x16_bf16(vf, wfr[j][ks], acc[j], 0, 0, 0);
    }
#pragma unroll
    for (int j = 0; j < 2; ++j) {
        const int t = 32 * (tb0 + 2 * j) + r32;
        const float bias = biasj[j];
        u16* o = MIX + (row0 + t) * DM + g * 128 + 32 * ct + 4 * hi;
#pragma unroll
        for (int rq = 0; rq < 4; ++rq) {
            const uint2 uw = uraw[j][rq];
            uint2 ow;
            ow.x = pk2(gelu_fast(bflo(uw.x)) * (acc[j][4 * rq + 0] + bias), gelu_fast(bfhi(uw.x)) * (acc[j][4 * rq + 1] + bias));
            ow.y = pk2(gelu_fast(bflo(uw.y)) * (acc[j][4 * rq + 2] + bias), gelu_fast(bfhi(uw.y)) * (acc[j][4 * rq + 3] + bias));
            *(uint2*)(o + 8 * rq) = ow;
        }
    }
    }
}
#undef MIXA_UNIT
__device__ __forceinline__ void mixer_b_all(const Params& p, unsigned char* smem) {
    const int tid = tid_opaque(), lane = tid & 63, wid = __builtin_amdgcn_readfirstlane(tid >> 6), r32 = lane & 31, hi = lane >> 5;
    LAS3 unsigned char* lds = (LAS3 unsigned char*)smem;
    LAS3 unsigned char* Ps = lds + 144 * 256;
    const u16* Z = (const u16*)(p.ws + WS_Z); u16* MIX = (u16*)(p.ws + WS_MIX);
    const int dt = wid & 3, tb0 = wid >> 2;
    const int vb_ = vblock();
#define MIXB_UNIT(I) ((((vb_ & 7) * 32 + 4 * (vb_ >> 5) + (I)) << 2) | ((vb_ >> 3) & 3))
    int unit = MIXB_UNIT(0);
    u32x4v hraw[5];
#define MIXB_LOAD_HALO(UN) { const int g_ = (UN) & 3, bn_ = (UN) >> 2, n_ = bn_ & 31; \
        _Pragma("unroll") for (int i = 0; i < 5; ++i) { \
            const int idx = tid + NT * i, r = idx >> 4, c16 = idx & 15; const int tt = n_ * 128 - 16 + r; \
            hraw[i] = (u32x4v){0u, 0u, 0u, 0u}; \
            if (idx < 144 * 16 && tt >= 0) hraw[i] = *(const u32x4v*)(Z + ((size_t)bn_ * 128 - 16 + r) * ZP0 + 1024 + g_ * 128 + c16 * 8); } }
    MIXB_LOAD_HALO(unit)
    int gcur = -1;
    bf16x8 pfr[8]; float4 psc[4];
#pragma unroll 1
    for (int ui = 0; ui < 4; ++ui) {
    unit = MIXB_UNIT(ui);
    const int g = unit & 3, bn = unit >> 2, n = bn & 31;
    const size_t row0 = (size_t)bn * 128;
    const int w = 2 << g;
    if (g != gcur) {
        gcur = g;
        const u16* pwT = (const u16*)(p.ws + WS_PWT) + (size_t)g * 16384;
#pragma unroll
        for (int ks = 0; ks < 8; ++ks) pfr[ks] = *(const bf16x8*)(pwT + (32 * dt + r32) * 128 + 16 * ks + 8 * hi);
#pragma unroll
        for (int rq = 0; rq < 4; ++rq) psc[rq] = *(const float4*)(p.pool_scale + g * 128 + 32 * dt + 4 * hi + 8 * rq);
    }
    __syncthreads();
#pragma unroll
    for (int i = 0; i < 5; ++i) {
        const int idx = tid + NT * i, r = idx >> 4, c16 = idx & 15;
        if (idx < 144 * 16) *(LAS3 u32x4v*)(lds + r * 256 + c16 * 16) = hraw[i];
    }
    { const int un = MIXB_UNIT(ui + 1); if (ui < 3) MIXB_LOAD_HALO(un) }
    __syncthreads();
#pragma unroll
    for (int i = 0; i < 4; ++i) {
        const int idx = tid + NT * i, t = idx >> 4, c16 = idx & 15; const int tt = n * 128 + t;
        const int cnt = (tt + 1 < w) ? (tt + 1) : w;
        float s[8];
#pragma unroll
        for (int e = 0; e < 8; ++e) s[e] = 0.f;
        u32x4v x0 = (u32x4v){0u, 0u, 0u, 0u};
        for (int k = 0; k < w; ++k) {
            const u32x4v v = *(const LAS3 u32x4v*)(lds + (16 + t - k) * 256 + c16 * 16);
            if (k == 0) x0 = v;
            s[0] += bflo(v.x); s[1] += bfhi(v.x); s[2] += bflo(v.y); s[3] += bfhi(v.y); s[4] += bflo(v.z); s[5] += bfhi(v.z); s[6] += bflo(v.w); s[7] += bfhi(v.w);
        }
        const float ic = 1.f / (float)cnt;
        u32x4v o;
        o.x = pk2(s[0] * ic - bflo(x0.x), s[1] * ic - bfhi(x0.x)); o.y = pk2(s[2] * ic - bflo(x0.y), s[3] * ic - bfhi(x0.y));
        o.z = pk2(s[4] * ic - bflo(x0.z), s[5] * ic - bfhi(x0.z)); o.w = pk2(s[6] * ic - bflo(x0.w), s[7] * ic - bfhi(x0.w));
        *(LAS3 u32x4v*)(Ps + t * MP_PITCH + c16 * 16) = o;
    }
    __syncthreads();
    f32x16 acc[2];
#pragma unroll
    for (int j = 0; j < 2; ++j)
#pragma unroll
        for (int r = 0; r < 16; ++r) acc[j][r] = 0.f;
#pragma unroll
    for (int ks = 0; ks < 8; ++ks)
#pragma unroll
        for (int j = 0; j < 2; ++j) {
            const bf16x8 bfrag = *(const LAS3 bf16x8*)(Ps + (32 * (tb0 + 2 * j) + r32) * MP_PITCH + (16 * ks + 8 * hi) * 2);
            acc[j] = __builtin_amdgcn_mfma_f32_32x32x16_bf16(pfr[ks], bfrag, acc[j], 0, 0, 0);
        }
#pragma unroll
    for (int j = 0; j < 2; ++j) {
        const int t = 32 * (tb0 + 2 * j) + r32;
        u16* o = MIX + (row0 + t) * DM + 512 + g * 128 + 32 * dt + 4 * hi;
#pragma unroll
        for (int rq = 0; rq < 4; ++rq) {
            const float4 s4 = psc[rq];
            uint2 ow; ow.x = pk2(acc[j][4 * rq + 0] * s4.x, acc[j][4 * rq + 1] * s4.y); ow.y = pk2(acc[j][4 * rq + 2] * s4.z, acc[j][4 * rq + 3] * s4.w);
            *(uint2*)(o + 8 * rq) = ow;
        }
    }
    }
#undef MIXB_LOAD_HALO
#undef MIXB_UNIT
}

__device__ __forceinline__ void xattn_phase(const Params& p, int layer, unsigned char* smem) {
    LAS3 unsigned char* lds = (LAS3 unsigned char*)smem;
    const unsigned lds0 = (unsigned)(uintptr_t)lds;
    const u16* Q = (const u16*)(p.ws + WS_Q); const u16* KV = (const u16*)(p.ws + WS_KV) + (size_t)layer * 2048 * 2048;
    u16* MIX = (u16*)(p.ws + WS_MIX);
    for (int unit = blockIdx.x; unit < 512; unit += gridDim.x) {
        int tid = threadIdx.x; asm volatile("" : "+v"(tid));
        const int lane = tid & 63, wid = tid >> 6, r32 = lane & 31, hi = lane >> 5;
        const int qb = unit & 15, h = (unit >> 4) & 3, b = unit >> 6;
        const int m0 = b * SEQ + qb * 256 + wid * 32;
        bf16x8 qf[8];
        const u16* qrow = Q + (size_t)(m0 + r32) * DM + h * 256 + hi * 8;
#pragma unroll
        for (int ks = 0; ks < 8; ++ks) qf[ks] = *(const bf16x8*)(qrow + ks * 16);
        __syncthreads();
#pragma unroll 4
        for (int i = 0; i < 16; ++i) { const int idx = tid + 512 * i, key = idx >> 5, c = idx & 31;
            const u32x4v v = *(const u32x4v*)(KV + (size_t)(b * 256 + key) * 2048 + h * 256 + c * 8);
            *(LAS3 u32x4v*)(lds + key * XK_PITCH + c * 16) = v; }
        __syncthreads();
        f32x16 st[8];
#pragma unroll
        for (int kt = 0; kt < 8; ++kt)
#pragma unroll
            for (int r = 0; r < 16; ++r) st[kt][r] = 0.f;
#pragma unroll
        for (int dh = 0; dh < 2; ++dh) {
            if (dh == 1) {
                asm volatile("" ::: "memory");
#pragma unroll
                for (int ks = 0; ks < 8; ++ks) qf[ks] = *(const bf16x8*)(qrow + 128 + ks * 16);
            }
#pragma unroll
            for (int ks = 0; ks < 8; ++ks)
#pragma unroll
                for (int kt = 0; kt < 8; ++kt) {
                    const bf16x8 kf = *(const LAS3 bf16x8*)(lds + (32 * kt + r32) * XK_PITCH + (2 * (dh * 8 + ks) + hi) * 16);
                    st[kt] = __builtin_amdgcn_mfma_f32_32x32x16_bf16(kf, qf[ks], st[kt], 0, 0, 0);
                }
            asm volatile("" ::: "memory");
        }
        float mx = -INFINITY;
#pragma unroll
        for (int kt = 0; kt < 8; ++kt)
#pragma unroll
            for (int r = 0; r < 16; ++r) mx = fmaxf(mx, st[kt][r]);
        mx = fmaxf(mx, __shfl_xor(mx, 32));
        const float cs = 0.0625f * 1.4426950408889634f;
        float sum = 0.f; unsigned pk[8][8];
#pragma unroll
        for (int kt = 0; kt < 8; ++kt)
#pragma unroll
            for (int r = 0; r < 8; ++r) {
                const float p0 = exp2f((st[kt][2 * r] - mx) * cs), p1 = exp2f((st[kt][2 * r + 1] - mx) * cs);
                sum += p0 + p1; pk[kt][r] = pk2(p0, p1);
            }
        sum += __shfl_xor(sum, 32);
        const float inv = 1.f / sum;
        __syncthreads();
#pragma unroll 4
        for (int i = 0; i < 16; ++i) { const int idx = tid + 512 * i, key = idx >> 5, c = idx & 31;
            const u32x4v v = *(const u32x4v*)(KV + (size_t)(b * 256 + key) * 2048 + 1024 + h * 256 + c * 8);
            *(LAS3 u32x4v*)(lds + key * XV_PITCH + c * 16) = v; }
        __syncthreads();
        const unsigned vbase = lds0 + (4 * hi + ((lane & 15) >> 2)) * XV_PITCH + (2 * ((lane >> 4) & 1) + ((lane & 3) >> 1)) * 16 + 8 * (lane & 1);
#pragma unroll
        for (int half = 0; half < 2; ++half) {
            f32x16 o[4];
#pragma unroll
            for (int dt = 0; dt < 4; ++dt)
#pragma unroll
                for (int r = 0; r < 16; ++r) o[dt][r] = 0.f;
#pragma unroll
            for (int kt = 0; kt < 8; ++kt)
#pragma unroll
                for (int s = 0; s < 2; ++s) {
                    bf16x8 pf;
                    { const unsigned w0 = pk[kt][4 * s + 0], w1 = pk[kt][4 * s + 1], w2 = pk[kt][4 * s + 2], w3 = pk[kt][4 * s + 3];
                      pf[0] = (short)(w0 & 0xffff); pf[1] = (short)(w0 >> 16); pf[2] = (short)(w1 & 0xffff); pf[3] = (short)(w1 >> 16);
                      pf[4] = (short)(w2 & 0xffff); pf[5] = (short)(w2 >> 16); pf[6] = (short)(w3 & 0xffff); pf[7] = (short)(w3 >> 16); }
#pragma unroll
                    for (int dt = 0; dt < 4; ++dt) {
                        const unsigned a1 = vbase + (32 * kt + 16 * s) * XV_PITCH + (half * 4 + dt) * 64;
                        const s16x4 lo = lds_tr16(a1), hh = lds_tr16(a1 + 8 * XV_PITCH);
                        const bf16x8 vf = (bf16x8){lo[0], lo[1], lo[2], lo[3], hh[0], hh[1], hh[2], hh[3]};
                        o[dt] = __builtin_amdgcn_mfma_f32_32x32x16_bf16(vf, pf, o[dt], 0, 0, 0);
                    }
                }
            u16* orow = MIX + (size_t)(m0 + r32) * DM + h * 256 + 4 * hi;
#pragma unroll
            for (int dt = 0; dt < 4; ++dt)
#pragma unroll
                for (int rq = 0; rq < 4; ++rq) {
                    uint2 w; w.x = pk2(o[dt][4 * rq + 0] * inv, o[dt][4 * rq + 1] * inv); w.y = pk2(o[dt][4 * rq + 2] * inv, o[dt][4 * rq + 3] * inv);
                    *(uint2*)(orow + 32 * (half * 4 + dt) + 8 * rq) = w;
                }
        }
    }
}

__device__ __forceinline__ void rope_phase(const Params& p) {
    const int tid = tid_opaque(), lane = tid & 63, gw = (blockIdx.x * NT + tid) >> 6, ngw = (gridDim.x * NT) >> 6;
    u16* Z = (u16*)(p.ws + WS_Z); const float2* rope = (const float2*)(p.ws + WS_ROPE);
    u16* KB = (u16*)(p.ws + WS_KB); u16* VB = (u16*)(p.ws + WS_VB); u16* KI = (u16*)(p.ws + WS_KI);
    for (int m = gw; m < T; m += ngw) {
        u16* zr = Z + (size_t)m * ZP1;
        const float2 cs = rope[(size_t)m * 64 + lane];
#pragma unroll
        for (int hd = 0; hd < 8; ++hd) {
            const float x1 = bf2f(zr[hd * 128 + lane]), x2 = bf2f(zr[hd * 128 + 64 + lane]);
            zr[hd * 128 + lane] = f2bf(x1 * cs.x - x2 * cs.y); zr[hd * 128 + 64 + lane] = f2bf(x2 * cs.x + x1 * cs.y);
        }
        { const float x1 = bf2f(zr[1024 + lane]), x2 = bf2f(zr[1088 + lane]);
          KB[(size_t)m * 128 + lane] = f2bf(x1 * cs.x - x2 * cs.y); KB[(size_t)m * 128 + 64 + lane] = f2bf(x2 * cs.x + x1 * cs.y); }
        *(unsigned*)(VB + (size_t)m * 128 + 2 * lane) = *(const unsigned*)(zr + 1152 + 2 * lane);
#pragma unroll
        for (int i = 0; i < 4; ++i) {
            const int pp = lane + 64 * i, hd = pp >> 5, jj = pp & 31;
            const float2 c2 = rope[(size_t)m * 64 + 2 * jj];
            const float x1 = bf2f(zr[1280 + hd * 64 + jj]), x2 = bf2f(zr[1280 + hd * 64 + 32 + jj]);
            zr[1280 + hd * 64 + jj] = f2bf(x1 * c2.x - x2 * c2.y); zr[1280 + hd * 64 + 32 + jj] = f2bf(x2 * c2.x + x1 * c2.y);
        }
        if (lane < 32) {
            const float2 c2 = rope[(size_t)m * 64 + 2 * lane];
            const float x1 = bf2f(zr[1792 + lane]), x2 = bf2f(zr[1824 + lane]);
            const int s = m & 4095, bb = m >> 12;
            u16* kt = KI + ((size_t)bb * 128 + (s >> 5)) * 2048 + (s & 31) * 8;
            const int d1 = lane, d2 = lane + 32;
            kt[((d1 >> 4) * 2 + ((d1 >> 3) & 1)) * 256 + (d1 & 7)] = f2bf(x1 * c2.x - x2 * c2.y);
            kt[((d2 >> 4) * 2 + ((d2 >> 3) & 1)) * 256 + (d2 & 7)] = f2bf(x2 * c2.x + x1 * c2.y);
        }
        if (lane < 8) zr[1856 + lane] = f2bf(bf2f(zr[1856 + lane]) * 0.35355339059327373f);
    }
}

typedef float f32x4v __attribute__((ext_vector_type(4)));
constexpr int VB_PITCH = 288, KB_PITCH = 272, CAND_CAP = 256, NBIN = 512;
__device__ __forceinline__ int score_bin(float sc) { const int b = (int)floorf(sc * 64.f) + 256; return b < 0 ? 0 : (b > 511 ? 511 : b); }
__device__ __forceinline__ unsigned score_key(unsigned f) { f = __float_as_uint(__uint_as_float(f) + 0.0f); return (f & 0x80000000u) ? ~f : (f | 0x80000000u); }
__device__ __forceinline__ float minscore_for_bin(int B) { return (B <= 0) ? -INFINITY : (float)(B - 256) * 0.015625f; }
__device__ __forceinline__ unsigned minkey_for_bin(int B) {
    if (B <= 0) return 0u;
    const unsigned f = __float_as_uint((float)(B - 256) * 0.015625f);
    return (f & 0x80000000u) ? ~f : (f | 0x80000000u);
}
#define ZERO_HIST(h, ln) do { _Pragma("unroll") for (int z_ = 0; z_ < 8; ++z_) (h)[(ln) * 8 + z_] = 0u; } while (0)
__device__ __forceinline__ int wave_iscan(int v) {
    v += __builtin_amdgcn_update_dpp(0, v, 0x111, 0xf, 0xf, false);
    v += __builtin_amdgcn_update_dpp(0, v, 0x112, 0xf, 0xf, false);
    v += __builtin_amdgcn_update_dpp(0, v, 0x114, 0xf, 0xf, false);
    v += __builtin_amdgcn_update_dpp(0, v, 0x118, 0xf, 0xf, false);
    v += __builtin_amdgcn_update_dpp(0, v, 0x142, 0xa, 0xf, false);
    v += __builtin_amdgcn_update_dpp(0, v, 0x143, 0xc, 0xf, false);
    return v;
}
__device__ __forceinline__ float relu_i(float x) { const int b = __float_as_int(x); return __int_as_float(b > 0 ? b : 0); }
__device__ __forceinline__ void dsa_phase(const Params& p, unsigned char* smem) {
    LAS3 unsigned char* lds = (LAS3 unsigned char*)smem;
    const u16* Z = (const u16*)(p.ws + WS_Z); u16* MIX = (u16*)(p.ws + WS_MIX);
    const u16* KB = (const u16*)(p.ws + WS_KB); const u16* VB = (const u16*)(p.ws + WS_VB); const u16* KI = (const u16*)(p.ws + WS_KI);
    { const int t0_ = tid_opaque(); LAS3 unsigned* h0 = (LAS3 unsigned*)(lds + 131072 + (t0_ >> 6) * 3072 + 512);
      ZERO_HIST(h0, t0_ & 63); }
    for (int U = vblock(); U < 4096; U += 256) {
        const int tid = tid_opaque(), lane = tid & 63, wid = __builtin_amdgcn_readfirstlane(tid >> 6);
        const int r32 = lane & 31, hi = lane >> 5, l15 = lane & 15, g4 = lane >> 4;
        LAS3 unsigned* sck_all = (LAS3 unsigned*)lds;
        LAS3 unsigned* sck = sck_all + wid * 4096;
        LAS3 unsigned char* aux = lds + 131072 + wid * 3072;
        LAS3 u16* idx = (LAS3 u16*)aux; LAS3 unsigned* hist = (LAS3 unsigned*)(aux + 512); LAS3 u16* cand = (LAS3 u16*)(aux + 2560);
        LAS3 unsigned char* vbuf = (LAS3 unsigned char*)sck;
        const unsigned vb0 = (unsigned)(uintptr_t)vbuf + (4 * g4 + (l15 >> 2)) * VB_PITCH + 8 * (l15 & 3);
        const unsigned long long lt_mask = (lane == 0) ? 0ull : (~0ull >> (64 - lane));
        const int uj = U >> 8, uc = U & 255, b = uc & 7, uy = uc >> 3;
        const int t0 = 8 * (32 * uj + ((uj & 1) ? 31 - uy : uy));
        const size_t brow = (size_t)b * SEQ;
        bf16x8 qif[2][4]; uint2 wqw[2][4];
        {   const int tq0 = (t0 >= 256) ? t0 : 256;
#pragma unroll
            for (int rt = 0; rt < 2; ++rt) {
                const u16* zr = Z + (brow + tq0 + 4 * rt + (r32 >> 3)) * ZP1 + 1280 + (r32 & 7) * 64 + 8 * hi;
#pragma unroll
                for (int ks = 0; ks < 4; ++ks) qif[rt][ks] = *(const bf16x8*)(zr + 16 * ks);
#pragma unroll
                for (int qq = 0; qq < 4; ++qq) wqw[rt][qq] = *(const uint2*)(Z + (brow + tq0 + 4 * rt + qq) * ZP1 + 1856 + 4 * hi);
            }
        }
        __syncthreads();
        for (int rep_s = 0; rep_s < (DSA_DUP == 1 ? 2 : 1); ++rep_s)
        if (t0 >= 256) {
            if (rep_s == 1) { __syncthreads(); ZERO_HIST(hist, lane); __syncthreads(); }
            float wq[2][16];
#pragma unroll
            for (int rt = 0; rt < 2; ++rt)
#pragma unroll
                for (int qq = 0; qq < 4; ++qq) {
                    const uint2 w = wqw[rt][qq];
                    wq[rt][4 * qq + 0] = 0.125f * bflo(w.x); wq[rt][4 * qq + 1] = 0.125f * bfhi(w.x);
                    wq[rt][4 * qq + 2] = 0.125f * bflo(w.y); wq[rt][4 * qq + 3] = 0.125f * bfhi(w.y);
                }
            const int ntile = (t0 + 8 + 31) >> 5;
            bf16x8 kif[4], kn1[4];
            {
                const u16* kr = KI + ((size_t)b * 128 + wid) * 2048 + hi * 256 + r32 * 8;
#pragma unroll
                for (int ks = 0; ks < 4; ++ks) kif[ks] = *(const bf16x8*)(kr + 512 * ks);
                const int kt1 = (wid + 8 < ntile) ? wid + 8 : wid;
                const u16* kr1 = KI + ((size_t)b * 128 + kt1) * 2048 + hi * 256 + r32 * 8;
#pragma unroll
                for (int ks = 0; ks < 4; ++ks) kn1[ks] = *(const bf16x8*)(kr1 + 512 * ks);
            }
#define SCORE_STEP(CUR, DST) { \
                { const int ktn = (kt + 16 < ntile) ? kt + 16 : kt; \
                  const u16* kr = KI + ((size_t)b * 128 + ktn) * 2048 + hi * 256 + r32 * 8; \
                  _Pragma("unroll") for (int ks = 0; ks < 4; ++ks) DST[ks] = *(const bf16x8*)(kr + 512 * ks); } \
                f32x16 c0, c1; \
                _Pragma("unroll") \
                for (int r = 0; r < 16; ++r) { c0[r] = 0.f; c1[r] = 0.f; } \
                _Pragma("unroll") \
                for (int ks = 0; ks < 4; ++ks) { \
                    c0 = __builtin_amdgcn_mfma_f32_32x32x16_bf16(qif[0][ks], CUR[ks], c0, 0, 0, 0); \
                    c1 = __builtin_amdgcn_mfma_f32_32x32x16_bf16(qif[1][ks], CUR[ks], c1, 0, 0, 0); \
                } \
                _Pragma("unroll") \
                for (int qq = 0; qq < 4; ++qq) { \
                    float pa = 0.f, pb = 0.f; \
                _Pragma("unroll") \
                    for (int e = 0; e < 4; ++e) { pa = fmaf(relu_i(c0[4 * qq + e]), wq[0][4 * qq + e], pa); pb = fmaf(relu_i(c1[4 * qq + e]), wq[1][4 * qq + e], pb); } \
                    const auto rr = __builtin_amdgcn_permlane32_swap(__float_as_uint(pa), __float_as_uint(pb), false, false); \
                    const float sc = __uint_as_float(rr[0]) + __uint_as_float(rr[1]);     \
                    sck_all[(4 * hi + qq) * 4096 + 32 * kt + r32] = __float_as_uint(sc);     \
 \
 \
                    { const bool vis = (32 * kt + 31 <= t0) || (32 * kt + r32 <= t0 + 4 * hi + qq); \
                      LAS3 unsigned* hq = (LAS3 unsigned*)(lds + 131072 + (4 * hi + qq) * 3072 + 512) + score_bin(sc); \
                      __hip_atomic_fetch_add(vis ? hq : (LAS3 unsigned*)(lds + LDS_CTL_OFF + 56), 1u, __ATOMIC_RELAXED, __HIP_MEMORY_SCOPE_WORKGROUP); } \
                } \
                kt += 8; if (kt >= ntile) break; }
            bf16x8 kn2[4];
            for (int kt = wid;;) { SCORE_STEP(kif, kn2) SCORE_STEP(kn1, kif) SCORE_STEP(kn2, kn1) }
#undef SCORE_STEP
        }
        __syncthreads();
        const int t = t0 + wid, n = t + 1;
        const size_t m = brow + t;
        bf16x8 qf[4];
#pragma unroll
        for (int ks = 0; ks < 4; ++ks) {
            qf[ks] = (bf16x8){0, 0, 0, 0, 0, 0, 0, 0};
            if (l15 < 8) qf[ks] = *(const bf16x8*)(Z + m * ZP1 + l15 * 128 + 32 * ks + 8 * g4);
        }
        int count;
        for (int rep_t = 0; rep_t < (DSA_DUP == 2 ? 2 : 1); ++rep_t)
        if (n <= 256) {
            count = n;
            for (int j = lane; j < 256; j += 64) idx[j] = (u16)(j < n ? j : 0);
        } else {
            count = 256;
            int bdig, bwant, bcnt;
            {
                int cb_[8]; int tot = 0;
                { const u32x4v h0v = *(const LAS3 u32x4v*)(hist + lane * 8), h1v = *(const LAS3 u32x4v*)(hist + lane * 8 + 4);
                  cb_[0] = (int)h0v.x; cb_[1] = (int)h0v.y; cb_[2] = (int)h0v.z; cb_[3] = (int)h0v.w; cb_[4] = (int)h1v.x; cb_[5] = (int)h1v.y; cb_[6] = (int)h1v.z; cb_[7] = (int)h1v.w; }
#pragma unroll
                for (int z = 0; z < 8; ++z) tot += cb_[z];
                const int P_ = wave_iscan(tot);
                const int S = __builtin_amdgcn_readlane(P_, 63) - P_ + tot;
                const int above = S - tot;
                const bool ok = (above < 256) && (256 <= S);
                int dig = 0, nw = 0, hb = 0;
                if (ok) {
                    int cum = above; bool found = false;
#pragma unroll
                    for (int z = 7; z >= 0; --z) { if (!found) { if (cum + cb_[z] >= 256) { dig = lane * 8 + z; nw = 256 - cum; hb = cb_[z]; found = true; } else cum += cb_[z]; } }
                }
                const unsigned long long bal = __ballot(ok);
                const int src = (int)__ffsll((long long)bal) - 1;
                bdig = __shfl(dig, src); bwant = __shfl(nw, src); bcnt = __shfl(hb, src);
            }
            if (bcnt == bwant || bcnt <= CAND_CAP) {
                const int tb = (bcnt == bwant) ? bdig : bdig + 1;
                const float klo = minscore_for_bin(tb), khi = minscore_for_bin(bdig);
                const bool any_take = tb < NBIN, want_cand = tb != bdig;
                LAS3 unsigned long long* tmask = (LAS3 unsigned long long*)hist; LAS3 unsigned long long* cmask = tmask + 64;
                const int ntrip = (n + 255) >> 8;
                const float klo_ = any_take ? klo : INFINITY, khi_ = want_cand ? khi : klo_;
                const int nfull = n >> 8;
                for (int it = 0; it < nfull; ++it) {
                    const u32x4v k4 = *(const LAS3 u32x4v*)(sck + 256 * it + 4 * lane);
                    unsigned long long bt[4], bc[4];
#pragma unroll
                    for (int e = 0; e < 4; ++e) { bt[e] = __builtin_amdgcn_ballot_w64(__uint_as_float(k4[e]) >= klo_); bc[e] = __builtin_amdgcn_ballot_w64(__uint_as_float(k4[e]) >= khi_) & ~bt[e]; }
                    if (lane == 0) {
#pragma unroll
                        for (int e = 0; e < 4; ++e) { tmask[4 * it + e] = bt[e]; cmask[4 * it + e] = bc[e]; }
                    }
                }
                if (nfull < ntrip) {
                    const int it = nfull;
                    const u32x4v k4 = *(const LAS3 u32x4v*)(sck + 256 * it + 4 * lane);
                    unsigned long long bt[4], bc[4];
#pragma unroll
                    for (int e = 0; e < 4; ++e) { const bool in = 256 * it + 4 * lane + e < n;
                        bt[e] = __builtin_amdgcn_ballot_w64(in && __uint_as_float(k4[e]) >= klo_); bc[e] = __builtin_amdgcn_ballot_w64(in && __uint_as_float(k4[e]) >= khi_) & ~bt[e]; }
                    if (lane == 0) {
#pragma unroll
                        for (int e = 0; e < 4; ++e) { tmask[4 * it + e] = bt[e]; cmask[4 * it + e] = bc[e]; }
                    }
                }
                WAVE_SYNC();
                int base;
                {
                    const bool hasw = lane < 4 * ntrip;
                    unsigned long long tw = hasw ? tmask[lane] : 0ull, cw = hasw ? cmask[lane] : 0ull;
                    const int key0 = 256 * (lane >> 2) + (lane & 3);
                    int ct = __popcll(tw), cc = __popcll(cw);
                    const int st_ = wave_iscan(ct), sc_ = wave_iscan(cc);
                    base = __builtin_amdgcn_readlane(st_, 63);
                    int pt = st_ - ct, pc = sc_ - cc;
                    while (tw) { const int bb = __builtin_ctzll(tw); tw &= tw - 1; if (pt < 256) idx[pt] = (u16)(key0 + 4 * bb); ++pt; }
                    while (cw) { const int bb = __builtin_ctzll(cw); cw &= cw - 1; if (pc < CAND_CAP) cand[pc] = (u16)(key0 + 4 * bb); ++pc; }
                }
                if (tb != bdig) {
                    WAVE_SYNC();
                    if (bcnt <= 64) {
                        const bool in = lane < bcnt;
                        const int si = in ? (int)cand[lane] : 0; const float kk = in ? __uint_as_float(sck[si]) : 0.f;
                        int rank = 0;
                        for (int j = 0; j < bcnt; ++j) {
                            const float kj = __int_as_float(__builtin_amdgcn_readlane(__float_as_int(kk), j)); const int sj = __builtin_amdgcn_readlane(si, j);
                            rank += (kj > kk || (kj == kk && sj < si)) ? 1 : 0;
                        }
                        const bool take = in && (rank < bwant);
                        const unsigned long long bt = __ballot(take);
                        const int pos = base + __popcll(bt & lt_mask);
                        if (take && pos < 256) idx[pos] = (u16)si;
                        base += __popcll(bt);
                    } else
                    for (int i0 = 0; i0 < bcnt; i0 += 64) {
                        const int i = i0 + lane; const bool in = i < bcnt;
                        const int si = in ? (int)cand[i] : 0; const float kk = __uint_as_float(sck[si]);
                        int rank = 0;
                        for (int j = 0; j < bcnt; ++j) { const int sj = (int)cand[j]; const float kj = __uint_as_float(sck[sj]); rank += (kj > kk || (kj == kk && sj < si)) ? 1 : 0; }
                        const bool take = in && (rank < bwant);
                        const unsigned long long bt = __ballot(take);
                        const int pos = base + __popcll(bt & lt_mask);
                        if (take && pos < 256) idx[pos] = (u16)si;
                        base += __popcll(bt);
                    }
                }
            } else {
            unsigned prefix = 0u, mask = 0u; int want = 256;
            for (int pass = 0; pass < 4; ++pass) {
                const int shift = 24 - 8 * pass;
                hist[lane * 4 + 0] = 0u; hist[lane * 4 + 1] = 0u; hist[lane * 4 + 2] = 0u; hist[lane * 4 + 3] = 0u;
                WAVE_SYNC();
                for (int s = lane; s < n; s += 64) { const unsigned k = score_key(sck[s]); if ((k & mask) == prefix) __hip_atomic_fetch_add(&hist[(k >> shift) & 255u], 1u, __ATOMIC_RELAXED, __HIP_MEMORY_SCOPE_WORKGROUP); }
                WAVE_SYNC();
                const int c0 = (int)hist[lane * 4 + 0], c1 = (int)hist[lane * 4 + 1], c2 = (int)hist[lane * 4 + 2], c3 = (int)hist[lane * 4 + 3];
                const int tot = c0 + c1 + c2 + c3;
                int S = tot;
#pragma unroll
                for (int o = 1; o < 64; o <<= 1) { const int v = __shfl_down(S, o); if (lane + o < 64) S += v; }
                const int above = S - tot;
                const bool ok = (above < want) && (want <= S);
                int dig = 0, nw = 0;
                if (ok) {
                    int cum = above;
                    if (cum + c3 >= want) { dig = lane * 4 + 3; nw = want - cum; }
                    else { cum += c3;
                        if (cum + c2 >= want) { dig = lane * 4 + 2; nw = want - cum; }
                        else { cum += c2;
                            if (cum + c1 >= want) { dig = lane * 4 + 1; nw = want - cum; }
                            else { cum += c1; dig = lane * 4; nw = want - cum; } } }
                }
                const unsigned long long bal = __ballot(ok);
                const int src = (int)__ffsll((long long)bal) - 1;
                dig = __shfl(dig, src); nw = __shfl(nw, src);
                prefix |= ((unsigned)dig) << shift; mask |= 255u << shift; want = nw;
                WAVE_SYNC();
            }
            int base = 0, eqt = 0;
            for (int s0 = 0; s0 < n; s0 += 64) {
                const int s = s0 + lane; const bool in = s < n;
                const unsigned k = in ? score_key(sck[s]) : 0u;
                const bool gt = in && (k > prefix), eq = in && (k == prefix);
                const unsigned long long beq = __ballot(eq);
                const int rank = eqt + __popcll(beq & lt_mask);
                const bool take = gt || (eq && rank < want);
                const unsigned long long bt = __ballot(take);
                const int pos = base + __popcll(bt & lt_mask);
                if (take && pos < 256) idx[pos] = (u16)s;
                base += __popcll(bt); eqt += __popcll(beq);
            }
            }
            WAVE_SYNC();
            if (rep_t == (DSA_DUP == 2 ? 1 : 0)) { ZERO_HIST(hist, lane); }
        }
        WAVE_SYNC();
        for (int rep_a = 0; rep_a < (DSA_DUP == 3 ? 2 : 1); ++rep_a) {
        f32x4v st[16];
#pragma unroll
        for (int kt = 0; kt < 16; ++kt) st[kt] = (f32x4v){0.f, 0.f, 0.f, 0.f};
        f32x4v ot[8];
#pragma unroll
        for (int dt = 0; dt < 8; ++dt) ot[dt] = (f32x4v){0.f, 0.f, 0.f, 0.f};
        const float lsc = 0.08838834764831845f * 1.4426950408889634f;
        float inv;
#define DSA_GATHER(REG, SRC, C)                                                                                     \
        { const u32x4v iv = *(const LAS3 u32x4v*)(idx + 32 * (C) + 8 * g4);                                         \
          _Pragma("unroll") for (int i = 0; i < 8; ++i) {                                                           \
              const int ki = (int)((iv[i >> 1] >> (16 * (i & 1))) & 0xffffu);                                       \
              REG[i] = *(const u32x4v*)(SRC + (brow + ki) * 128 + l15 * 8); } }
#define DSA_KCHUNK(REG, C)                                                                                          \
        { WAVE_SYNC();                                                                                              \
          _Pragma("unroll") for (int i = 0; i < 8; ++i) *(LAS3 u32x4v*)(vbuf + (8 * g4 + i) * KB_PITCH + l15 * 16) = REG[i]; \
          WAVE_SYNC();                                                                                              \
          _Pragma("unroll") for (int a = 0; a < 2; ++a)                                                             \
          _Pragma("unroll") for (int ks = 0; ks < 4; ++ks) {                                                        \
              const bf16x8 kf = *(const LAS3 bf16x8*)(vbuf + (16 * a + l15) * KB_PITCH + (32 * ks + 8 * g4) * 2);   \
              st[2 * (C) + a] = __builtin_amdgcn_mfma_f32_16x16x32_bf16(kf, qf[ks], st[2 * (C) + a], 0, 0, 0); } }
#define DSA_VCHUNK(REG, C)                                                                                          \
        { WAVE_SYNC();                                                                                              \
          _Pragma("unroll") for (int i = 0; i < 8; ++i) *(LAS3 u32x4v*)(vbuf + (8 * g4 + i) * VB_PITCH + l15 * 16) = REG[i]; \
          WAVE_SYNC();                                                                                              \
          bf16x8 pf;                                                                                                \
          { const unsigned w0 = pk2hw(st[2 * (C)][0], st[2 * (C)][1]), w1 = pk2hw(st[2 * (C)][2], st[2 * (C)][3]),  \
                           w2 = pk2hw(st[2 * (C) + 1][0], st[2 * (C) + 1][1]), w3 = pk2hw(st[2 * (C) + 1][2], st[2 * (C) + 1][3]); \
            pf[0] = (short)(w0 & 0xffff); pf[1] = (short)(w0 >> 16); pf[2] = (short)(w1 & 0xffff); pf[3] = (short)(w1 >> 16); \
            pf[4] = (short)(w2 & 0xffff); pf[5] = (short)(w2 >> 16); pf[6] = (short)(w3 & 0xffff); pf[7] = (short)(w3 >> 16); } \
          _Pragma("unroll") for (int dt = 0; dt < 8; ++dt) {                                                        \
              const s16x4 lo = lds_tr16(vb0 + dt * 32), hh = lds_tr16(vb0 + dt * 32 + 16 * VB_PITCH);              \
              const bf16x8 vf = (bf16x8){lo[0], lo[1], lo[2], lo[3], hh[0], hh[1], hh[2], hh[3]};                   \
              ot[dt] = __builtin_amdgcn_mfma_f32_16x16x32_bf16(vf, pf, ot[dt], 0, 0, 0); } }
#define DSA_EXPSUM()                                                                                                \
        { mx = fmaxf(mx, __shfl_xor(mx, 16)); mx = fmaxf(mx, __shfl_xor(mx, 32));                                   \
          float sum = 0.f;                                                                                          \
          _Pragma("unroll") for (int kt = 0; kt < 16; ++kt)                                                         \
          _Pragma("unroll") for (int r = 0; r < 4; ++r) { const float e = __builtin_amdgcn_exp2f(st[kt][r] - mx); st[kt][r] = e; sum += e; } \
          sum += __shfl_xor(sum, 16); sum += __shfl_xor(sum, 32);                                                   \
          inv = 1.f / sum; }
        if (count == 256) {
            u32x4v ring[2][2][8];
            DSA_GATHER(ring[0][0], KB, 0) DSA_GATHER(ring[0][1], KB, 1)
#pragma unroll
            for (int s = 0; s < 4; ++s) {
                if (s < 3) { DSA_GATHER(ring[(s + 1) & 1][0], KB, 2 * s + 2) DSA_GATHER(ring[(s + 1) & 1][1], KB, 2 * s + 3) }
                DSA_KCHUNK(ring[s & 1][0], 2 * s) DSA_KCHUNK(ring[s & 1][1], 2 * s + 1)
            }
            DSA_GATHER(ring[0][0], VB, 0) DSA_GATHER(ring[0][1], VB, 1)
            float mx = -INFINITY;
#pragma unroll
            for (int kt = 0; kt < 16; ++kt)
#pragma unroll
                for (int r = 0; r < 4; ++r) { const float v = st[kt][r] * lsc; st[kt][r] = v; mx = fmaxf(mx, v); }
            DSA_EXPSUM()
#pragma unroll
            for (int s = 0; s < 4; ++s) {
                if (s < 3) { DSA_GATHER(ring[(s + 1) & 1][0], VB, 2 * s + 2) DSA_GATHER(ring[(s + 1) & 1][1], VB, 2 * s + 3) }
                DSA_VCHUNK(ring[s & 1][0], 2 * s) DSA_VCHUNK(ring[s & 1][1], 2 * s + 1)
            }
        } else {
#pragma unroll 1
            for (int c = 0; 32 * c < count; ++c) {
                u32x4v kreg[8];
                DSA_GATHER(kreg, KB, c)
                WAVE_SYNC();
#pragma unroll
                for (int i = 0; i < 8; ++i) *(LAS3 u32x4v*)(vbuf + (8 * g4 + i) * KB_PITCH + l15 * 16) = kreg[i];
                WAVE_SYNC();
                f32x4v s0 = (f32x4v){0.f, 0.f, 0.f, 0.f}, s1 = (f32x4v){0.f, 0.f, 0.f, 0.f};
#pragma unroll
                for (int ks = 0; ks < 4; ++ks) {
                    const bf16x8 kf0 = *(const LAS3 bf16x8*)(vbuf + l15 * KB_PITCH + (32 * ks + 8 * g4) * 2);
                    const bf16x8 kf1 = *(const LAS3 bf16x8*)(vbuf + (16 + l15) * KB_PITCH + (32 * ks + 8 * g4) * 2);
                    s0 = __builtin_amdgcn_mfma_f32_16x16x32_bf16(kf0, qf[ks], s0, 0, 0, 0);
                    s1 = __builtin_amdgcn_mfma_f32_16x16x32_bf16(kf1, qf[ks], s1, 0, 0, 0);
                }
#pragma unroll
                for (int cs = 0; cs < 8; ++cs) if (c == cs) { st[2 * cs] = s0; st[2 * cs + 1] = s1; }
            }
            float mx = -INFINITY;
#pragma unroll
            for (int kt = 0; kt < 16; ++kt)
#pragma unroll
                for (int r = 0; r < 4; ++r) { const int j = 16 * kt + 4 * g4 + r; const float v = (j < count) ? st[kt][r] * lsc : -INFINITY; st[kt][r] = v; mx = fmaxf(mx, v); }
            DSA_EXPSUM()
#pragma unroll
            for (int c = 0; c < 8; ++c) {
                if (32 * c < count) {
                    u32x4v vreg[8];
                    DSA_GATHER(vreg, VB, c)
                    DSA_VCHUNK(vreg, c)
                }
            }
        }
#undef DSA_GATHER
#undef DSA_KCHUNK
#undef DSA_VCHUNK
#undef DSA_EXPSUM
        if (l15 < 8) {
            u16* orow = MIX + m * DM + l15 * 128 + 4 * g4;
#pragma unroll
            for (int dt = 0; dt < 8; ++dt) {
                uint2 w; w.x = pk2hw(ot[dt][0] * inv, ot[dt][1] * inv); w.y = pk2hw(ot[dt][2] * inv, ot[dt][3] * inv);
                *(uint2*)(orow + 16 * dt) = w;
            }
        }
        }
    }
}

#define XB_TMO      128
#define XB_XCNT(j)  (256  + 64 * (j))
#define XB_XSUB(j)  (1280 + 64 * (j))
#define XB_XGEN(j)  (2304 + 64 * (j))
#define XB_TOP      3328
#define XB_TOPGEN   3392
#define XCD_BAR_WORDS 3456
#define XB_SPIN_CAP (1u << 18)

__device__ __forceinline__ unsigned xb_ld(unsigned* p)              { return __hip_atomic_load(p, __ATOMIC_RELAXED, __HIP_MEMORY_SCOPE_AGENT); }
__device__ __forceinline__ unsigned xb_add(unsigned* p, unsigned v) { return __hip_atomic_fetch_add(p, v, __ATOMIC_RELAXED, __HIP_MEMORY_SCOPE_AGENT); }
__device__ __forceinline__ unsigned xb_xcc_id() { return (unsigned)__builtin_amdgcn_s_getreg((3 << 11) | 20) & 0xFu; }
#define XB_SPIN(cond, bar) do { unsigned _sp = 0; while (cond) { __builtin_amdgcn_s_sleep(1); \
    if ((++_sp & 255u) == 0u) { if (xb_ld(&(bar)[XB_TMO])) break; if (_sp > XB_SPIN_CAP) { atomicAdd(&(bar)[XB_TMO], 1u); break; } } } } while (0)

struct XcdBarrier {
    unsigned* bar; unsigned x;
    volatile __attribute__((address_space(3))) unsigned* st;
};

__device__ __forceinline__ XcdBarrier xcd_barrier_post(unsigned* bar, volatile __attribute__((address_space(3))) unsigned* st) {
    XcdBarrier b; b.bar = bar; b.x = xb_xcc_id(); b.st = st;
    if (threadIdx.x == 0) st[4] = xb_add(&bar[XB_XCNT(b.x)], 1u);
    return b;
}
__device__ __forceinline__ void xcd_barrier_complete(unsigned* bar, unsigned x, unsigned& nloc, unsigned& nx, unsigned& uniform) {
    const unsigned G = gridDim.x * gridDim.y * gridDim.z;
    unsigned sum, cnt, mine, sp = 0u, uni = 0u;
    for (;;) {
        sum = 0u; cnt = 0u; mine = 0u; uni = (G == 256u) ? 1u : 0u;
#pragma unroll
        for (unsigned j = 0; j < 16; ++j) { const unsigned c = xb_ld(&bar[XB_XCNT(j)]); sum += c; cnt += (c > 0u) ? 1u : 0u; mine = (j == x) ? c : mine; uni = (c == (j < 8u ? 32u : 0u)) ? uni : 0u; }
        if (sum == G) break;
        uni = 0u;
        __builtin_amdgcn_s_sleep(1);
        if ((++sp & 255u) == 0u) { if (xb_ld(&bar[XB_TMO])) break; if (sp > XB_SPIN_CAP) { atomicAdd(&bar[XB_TMO], 1u); break; } }
    }
    nloc = mine > 0u ? mine : 1u; nx = cnt > 0u ? cnt : 1u; uniform = uni;
}

__device__ __forceinline__ void xcd_barrier(const XcdBarrier& b, bool allow_local = false) {
    asm volatile("s_waitcnt vmcnt(0)" ::: "memory");
    __syncthreads();
    if (threadIdx.x == 0) {
        unsigned* bar = b.bar;
        __builtin_amdgcn_s_waitcnt(0);
        unsigned nloc = b.st[0], nx = b.st[1];
        if (nloc == 0u) { unsigned uni; xcd_barrier_complete(bar, b.x, nloc, nx, uni); b.st[0] = nloc; b.st[1] = nx;
                          b.st[2] = uni ? (b.st[4] * 8u + b.x) : blockIdx.x; b.st[3] = uni; }
        const bool local = allow_local && (b.st[3] != 0u);
        const unsigned old = xb_add(&bar[XB_XSUB(b.x)], 1u);
        const unsigned gen = old / nloc;
        if (old + 1u == (gen + 1u) * nloc) {
            if (!local) {
            __builtin_amdgcn_fence(__ATOMIC_RELEASE, "agent");
            asm volatile("s_waitcnt vmcnt(0)" ::: "memory");
            const unsigned og = xb_add(&bar[XB_TOP], 1u);
            const unsigned tg = og / nx;
            if (og + 1u == (tg + 1u) * nx) xb_add(&bar[XB_TOPGEN], 1u);
            else XB_SPIN(xb_ld(&bar[XB_TOPGEN]) == tg, bar);
            }
            __builtin_amdgcn_fence(__ATOMIC_ACQUIRE, "agent");
            xb_add(&bar[XB_XGEN(b.x)], 1u);
            asm volatile("s_waitcnt vmcnt(0)" ::: "memory");
        } else {
            XB_SPIN(xb_ld(&bar[XB_XGEN(b.x)]) == gen, bar);
            __builtin_amdgcn_fence(__ATOMIC_ACQUIRE, "agent");
            asm volatile("s_waitcnt vmcnt(0)" ::: "memory");
        }
    }
    __syncthreads();
}

__device__ __forceinline__ void xattn_precompute(const Params& p, int l, unsigned char* smem) {
    const u16* KV = (const u16*)(p.ws + WS_KV);
    const int half = (int)gridDim.x >> 1;
    const int vb_ = vblock(), rk_ = vb_ >> 3;
    if (rk_ < 16) {
        pg8::Gemm g{KV, (const u16*)(p.ws + WS_WQ), 256, 1024, 256, 2048, 1024}; PreOrder<0> S{vb_ & 7, rk_, l};
        EpiStore E{(u16*)(p.ws + WS_BT1), 1024, 0, nullptr};
        pg8::gemm_phase<EpiStore, PreOrder<0>, true, true>((PG8_LAS unsigned char*)smem, g, S, E); }
    else {
        pg8::Gemm g{(const u16*)(p.ws + WS_WO), KV, 1024, 256, 256, 1024, 2048}; PreOrder<1> S{vb_ & 7, rk_ - 16, l};
        EpiStore E{(u16*)(p.ws + WS_BT2), 1024, 0, nullptr};
        pg8::gemm_phase<EpiStore, PreOrder<1>, true, true>((PG8_LAS unsigned char*)smem, g, S, E); }
}

typedef const __attribute__((address_space(4))) Params* KParams;
template <int PH> __device__ __forceinline__ void run_phase(unsigned char* smem) {
    constexpr int ph = PH;
#if defined(__HIP_DEVICE_COMPILE__)
    KParams kp = (KParams)__builtin_amdgcn_kernarg_segment_ptr(); asm volatile("" : "+s"(kp));
    Params p;
    p.x = kp->x; p.mem = kp->mem; p.pos = kp->pos; p.gains = kp->gains; p.wq = kp->wq; p.wkv = kp->wkv; p.wo = kp->wo; p.w1 = kp->w1; p.w2 = kp->w2;
    p.ev_w_in = kp->ev_w_in; p.sgu_g = kp->sgu_g; p.sgu_ws = kp->sgu_ws; p.sgu_bs = kp->sgu_bs; p.pool_w = kp->pool_w; p.pool_scale = kp->pool_scale;
    p.ev_w_out = kp->ev_w_out; p.od_w_in = kp->od_w_in; p.od_w_out = kp->od_w_out; p.out = kp->out; p.ws = kp->ws;
#else
    Params p{};
#endif
    u16* HN = (u16*)(p.ws + WS_HN); u16* Y = (u16*)(p.ws + WS_Y); u16* Z = (u16*)(p.ws + WS_Z); u16* MIX = (u16*)(p.ws + WS_MIX);
    u16* Qb = (u16*)(p.ws + WS_Q); u16* HID = (u16*)(p.ws + WS_HID); u16* MEMN = (u16*)(p.ws + WS_MEMN); u16* KV = (u16*)(p.ws + WS_KV); float* RS = (float*)(p.ws + WS_RS);
    if constexpr (ph == 0) {
        float2* rope = (float2*)(p.ws + WS_ROPE);
        const int gt = blockIdx.x * NT + tid_opaque(), gs = gridDim.x * NT;
        for (int i = gt; i < T * 64; i += gs) {
            const int m = i >> 6, j = i & 63;
            const float inv = expf(-0.14391156831212787f * (float)j);
            const float ang = (float)p.pos[m] * inv;
            rope[i] = make_float2(cosf(ang), sinf(ang));
        }
        for (int i = gt; i < 4 * 16384; i += gs) {
            const int t = (i >> 7) & 127, s = i & 127, gg = i >> 14;
            ((u16*)(p.ws + WS_WC))[i] = (s <= t) ? f2bf(p.sgu_ws[i]) : (u16)0;
            ((u16*)(p.ws + WS_PWT))[i] = f2bf(p.pool_w[(size_t)gg * 16384 + s * 128 + t]);
        }
        rmsnorm_rows(p.mem, p.gains + (0 * 7 + 6) * DM, MEMN, 2048);
        rmsnorm_rows(p.mem, p.gains + (1 * 7 + 6) * DM, MEMN + (size_t)2048 * DM, 2048);
        cast_rows(p.x, HN, RS);
#pragma unroll 1
        for (int l = 0; l < 2; ++l) {
            weight_prep(p.wkv + (size_t)l * DM * 2048, DM, 2048, 2048, (u16*)(p.ws + WS_WKV) + (size_t)l * 2048 * DM, smem);
            weight_cast(p.wq + (size_t)l * DM * DM, DM, DM, (u16*)(p.ws + WS_WQ) + (size_t)l * DM * DM, p.gains + (size_t)(l * 7 + 2) * DM);
            weight_prep(p.wo + (size_t)l * DM * DM, DM, DM, DM, (u16*)(p.ws + WS_WO) + (size_t)l * DM * DM, smem);
            weight_prep(p.w1 + (size_t)l * DM * DFF, DM, DFF, DFF, (u16*)(p.ws + WS_W1) + (size_t)l * DFF * DM, smem, p.gains + (size_t)(l * 7 + 4) * DM);
            weight_prep<false, true>(p.w2 + (size_t)l * DFF * DM, DFF, DM, DM, (u16*)(p.ws + WS_W2 + (size_t)l * DM * DFF), smem);
        }
        weight_prep(p.ev_w_in, DM, EVEN_IN, EVEN_IN, (u16*)(p.ws + WS_EVIN), smem, p.gains + 0);
        weight_prep(p.ev_w_out, DM, DM, DM, (u16*)(p.ws + WS_EVOUT), smem);
        weight_prep<true>(p.od_w_in, DM, ODD_IN, ZP1, (u16*)(p.ws + WS_ODIN), smem, p.gains + (size_t)7 * DM);
        weight_prep(p.od_w_out, DM, DM, DM, (u16*)(p.ws + WS_ODOUT), smem);
    } else if constexpr (ph == 1) {
        pg8::Gemm gm{MEMN, (const u16*)(p.ws + WS_WKV), 2048, 2048, DM, DM, DM}; KvOrder S{vblock()};
        EpiStore E{KV, 2048, 0, nullptr};
        pg8::gemm_phase<EpiStore, KvOrder, true, true>((PG8_LAS unsigned char*)smem, gm, S, E);
    } else if constexpr (ph == 2) {
        xattn_precompute(p, 0, smem);
    } else {
        constexpr int l = (ph - 3) / 12, s = (ph - 3) % 12;
        const float* g = p.gains + (size_t)l * 7 * DM;
        if constexpr (s == 0) {
            if constexpr (l == 0) { gemm8(HN, (const u16*)(p.ws + WS_EVIN), T, EVEN_IN, DM, Z, ZP0, 0, RS, smem); xattn_precompute(p, 0, smem); }
            else { pg8::Gemm gm{HN, (const u16*)(p.ws + WS_ODIN), T, ZP1, DM, DM, DM}; pg8::StaticOrder S; S.init(T, ZP1, (int)gridDim.x, vblock());
                   EpiRope E{Z, (u16*)(p.ws + WS_KB), (u16*)(p.ws + WS_VB), (u16*)(p.ws + WS_KI), RS, (const float2*)(p.ws + WS_ROPE)};
                   pg8::gemm_phase<EpiRope, pg8::StaticOrder, true, true>((PG8_LAS unsigned char*)smem, gm, S, E); }
        } else if constexpr (s == 1) {
            if constexpr (l == 0) { mixer_a_all(p, smem); mixer_b_all(p, smem); }
            else { }
        } else if constexpr (s == 2) { if constexpr (l == 1) dsa_phase(p, smem); }
        else if constexpr (s == 3) gemm8(MIX, (const u16*)(p.ws + (l == 0 ? WS_EVOUT : WS_ODOUT)), T, DM, DM, Y, DM, 0, nullptr, smem);
        else if constexpr (s == 4) { if constexpr (l == 1) xattn_precompute(p, 1, smem); postnorm_rows<false>(HN, Y, g + 1 * DM, RS, nullptr); }
        else if constexpr (s == 5) {
            pg8::Gemm g{HN, (const u16*)(p.ws + WS_BT1), T, DM, DM, DM, DM}; BatchBOrder S; S.init(T, DM, (int)gridDim.x, vblock());
            EpiSoftmax E{MIX, DM, RS, (PG8_LAS float*)((PG8_LAS unsigned char*)smem + 131072)};
            pg8::gemm_phase<EpiSoftmax, BatchBOrder, true, true>((PG8_LAS unsigned char*)smem, g, S, E); }
        else if constexpr (s == 6) { }
        else if constexpr (s == 7) {
            pg8::Gemm g{MIX, (const u16*)(p.ws + WS_BT2), T, DM, DM, DM, DM}; BatchBOrder S; S.init(T, DM, (int)gridDim.x, vblock());
            EpiStore E{Y, DM, 0, nullptr};
            pg8::gemm_phase<EpiStore, BatchBOrder, true, true>((PG8_LAS unsigned char*)smem, g, S, E); }
        else if constexpr (s == 8) postnorm_rows<false>(HN, Y, g + 3 * DM, RS, nullptr);
        else if constexpr (s == 9) {
            pg8::Gemm gm{HN, (const u16*)(p.ws + WS_W1) + (size_t)l * DFF * DM, T, DFF, DM, DM, DM}; pg8::StaticOrder S; S.init(T, DFF, (int)gridDim.x, vblock());
            EpiStoreF8 E{(unsigned char*)HID, DFF, RS};
            pg8::gemm_phase<EpiStoreF8, pg8::StaticOrder, true, true>((PG8_LAS unsigned char*)smem, gm, S, E); }
        else if constexpr (s == 10) {
            pg8::Gemm gm{HID, (const u16*)(p.ws + WS_W2 + (size_t)l * DM * DFF), T, DM, DFF / 2, DFF / 2, DFF / 2}; pg8::StaticOrder S; S.init(T, DM, (int)gridDim.x, vblock());
            EpiStore E{Y, DM, 0, nullptr, 1.f / 2048.f};
            pg8::gemm_phase<EpiStore, pg8::StaticOrder, true, true, true>((PG8_LAS unsigned char*)smem, gm, S, E); }
        else { if constexpr (l == 0) postnorm_rows<false>(HN, Y, g + 5 * DM, RS, nullptr); else postnorm_rows<true>(HN, Y, g + 5 * DM, nullptr, p.out); }
    }
}

template <int PH> __device__ __forceinline__ void run_all(unsigned char* smem, const XcdBarrier& bar) {
    if constexpr (PH < NPHASE) {
        if constexpr (PH == DUP_PH) { run_phase<PH>(smem); xcd_barrier(bar); }
        if constexpr (PH == 1) { for (int xb = 0; xb < EXTRA_BARRIERS; ++xb) xcd_barrier(bar); }
#ifdef ONLY_PH
        if constexpr (PH == ONLY_PH) {
#else
        if constexpr (PH != 2 && PH != 5 && PH != 9 && PH != 21 && PH != 16) {
#endif
            run_phase<PH>(smem);
            if constexpr (PH + 1 < NPHASE) xcd_barrier(bar, PH != 0 && PH != 14 && PH != 18);
        }
        run_all<PH + 1>(smem, bar);
    }
}
#endif
constexpr size_t WS_CTL = 0, CTL_ZERO_BYTES = 65536;
__global__ void __launch_bounds__(NT, 2) fwd_kernel(Params p) {
#if defined(__HIP_DEVICE_COMPILE__)
    extern __shared__ __attribute__((aligned(16))) unsigned char smem[];
    volatile __attribute__((address_space(3))) unsigned* st = (volatile __attribute__((address_space(3))) unsigned*)((__attribute__((address_space(3))) unsigned char*)smem + LDS_CTL_OFF);
    if (threadIdx.x < 16) st[threadIdx.x] = 0u;
    __syncthreads();
    const XcdBarrier bar = xcd_barrier_post((unsigned*)(p.ws + WS_CTL), st);
    if (p.ws == nullptr) cg::this_grid().sync();
    run_all<0>(smem, bar);
#endif
}

extern "C" void kernel_launch(void* const* d_in, const int* in_sizes, int n_in, void* d_out, int out_size, void* d_ws, size_t ws_size, hipStream_t stream) {
    static int inited = 0, cus = 256, per_cu = 1;
    if (!inited) {
        inited = 1;
        if (ws_size < WS_END) fprintf(stderr, "kernel_launch: workspace too small: %zu < %zu\n", ws_size, (size_t)WS_END);
        int dev = 0; (void)hipGetDevice(&dev); (void)hipDeviceGetAttribute(&cus, hipDeviceAttributeMultiprocessorCount, dev);
        (void)hipFuncSetAttribute((const void*)fwd_kernel, hipFuncAttributeMaxDynamicSharedMemorySize, LDS_BYTES);
        if (hipOccupancyMaxActiveBlocksPerMultiprocessor(&per_cu, (const void*)fwd_kernel, NT, LDS_BYTES) != hipSuccess || per_cu < 1) per_cu = 1;
        (void)hipGetLastError();
    }
    Params p{};
    p.x = (const float*)d_in[0]; p.mem = (const float*)d_in[1]; p.pos = (const int*)d_in[2]; p.gains = (const float*)d_in[3];
    p.wq = (const float*)d_in[4]; p.wkv = (const float*)d_in[5]; p.wo = (const float*)d_in[6]; p.w1 = (const float*)d_in[7]; p.w2 = (const float*)d_in[8];
    p.ev_w_in = (const float*)d_in[9]; p.sgu_g = (const float*)d_in[10]; p.sgu_ws = (const float*)d_in[11]; p.sgu_bs = (const float*)d_in[12];
    p.pool_w = (const float*)d_in[13]; p.pool_scale = (const float*)d_in[14]; p.ev_w_out = (const float*)d_in[15];
    p.od_w_in = (const float*)d_in[16]; p.od_w_out = (const float*)d_in[17];
    p.out = (float*)d_out; p.ws = (unsigned char*)d_ws;
    (void)hipMemsetAsync((char*)d_ws + WS_CTL, 0, CTL_ZERO_BYTES, stream);
    void* args[] = {&p};
    hipError_t e = hipLaunchCooperativeKernel((const void*)fwd_kernel, dim3(cus * per_cu), dim3(NT), args, LDS_BYTES, stream);
    if (e != hipSuccess) fprintf(stderr, "cooperative launch failed: %s\n", hipGetErrorString(e));
}
```

```cpp
#include <hip/hip_runtime.h>
#include <hip/hip_cooperative_groups.h>
#include <cstdio>
#include <cstdint>
namespace cg = cooperative_groups;


#ifndef DUP_PH
#define DUP_PH -1
#endif
#define DSA_DUP 0
#define EXTRA_BARRIERS 0
typedef unsigned short u16;
typedef short bf16x8 __attribute__((ext_vector_type(8)));
typedef float f32x4 __attribute__((ext_vector_type(4)));

constexpr int NT = 512;
constexpr int NB = 8, SEQ = 4096, T = NB * SEQ, DM = 1024, NMEM = 256, DFF = 4096;
constexpr int EVEN_IN = 1536, ODD_IN = 1864, ZP1 = 2048, ZP0 = 2048;
constexpr float EPS = 1e-6f;

constexpr size_t MiB = 1u << 20;
constexpr size_t WS_WKV = 2 * MiB, WS_WQ = 10 * MiB, WS_WO = 14 * MiB, WS_W1 = 18 * MiB, WS_W2 = 34 * MiB;
constexpr size_t WS_EVIN = 50 * MiB, WS_EVOUT = 53 * MiB, WS_ODIN = 55 * MiB, WS_ODOUT = 59 * MiB;
constexpr size_t WS_WC = 61 * MiB, WS_PWT = 61 * MiB + 131072;
constexpr size_t WS_RS = 62 * MiB;
constexpr size_t WS_ROPE = 66 * MiB;
constexpr size_t WS_MEMN = 82 * MiB;
constexpr size_t WS_KV   = 90 * MiB;
constexpr size_t WS_HN   = 122 * MiB;
constexpr size_t WS_Y    = 186 * MiB;
constexpr size_t WS_Z    = 250 * MiB;
constexpr size_t WS_MIX  = 378 * MiB;
constexpr size_t WS_Q    = 442 * MiB;
constexpr size_t WS_KB = 442 * MiB, WS_VB = 450 * MiB, WS_KI = 458 * MiB;
constexpr size_t WS_BT1 = 474 * MiB, WS_BT2 = 490 * MiB;
constexpr size_t WS_HID  = 250 * MiB;
constexpr size_t WS_END  = 506 * MiB;

constexpr int DSA_WAVE_LDS = 19 * 1024;
constexpr int NPHASE = 27;
constexpr int LDS_CTL_OFF = 8 * DSA_WAVE_LDS;
constexpr int LDS_BYTES = LDS_CTL_OFF + 64;

struct Params {
    const float* x; const float* mem; const int* pos; const float* gains;
    const float* wq; const float* wkv; const float* wo; const float* w1; const float* w2;
    const float* ev_w_in; const float* sgu_g; const float* sgu_ws; const float* sgu_bs;
    const float* pool_w; const float* pool_scale; const float* ev_w_out;
    const float* od_w_in; const float* od_w_out;
    float* out; unsigned char* ws;
};

#if defined(__HIP_DEVICE_COMPILE__)
__device__ __forceinline__ u16 f2bf(float f) { unsigned u = __float_as_uint(f); return (u16)((u + 0x7fffu + ((u >> 16) & 1u)) >> 16); }
__device__ __forceinline__ float bf2f(u16 h) { return __uint_as_float(((unsigned)h) << 16); }
__device__ __forceinline__ float bflo(unsigned w) { return __uint_as_float(w << 16); }
__device__ __forceinline__ float bfhi(unsigned w) { return __uint_as_float(w & 0xffff0000u); }
__device__ __forceinline__ unsigned pk2hw(float lo, float hi) { unsigned r; asm("v_cvt_pk_bf16_f32 %0, %1, %2" : "=v"(r) : "v"(lo), "v"(hi)); return r; }
__device__ __forceinline__ unsigned pk2(float lo, float hi) { return (unsigned)f2bf(lo) | ((unsigned)f2bf(hi) << 16); }
__device__ __forceinline__ float wsum(float v) {
#pragma unroll
    for (int o = 32; o > 0; o >>= 1) v += __shfl_xor(v, o);
    return v;
}
__device__ __forceinline__ float rsum16(float v) {
    v += __int_as_float(__builtin_amdgcn_update_dpp(0, __float_as_int(v), 0xB1, 0xf, 0xf, true));
    v += __int_as_float(__builtin_amdgcn_update_dpp(0, __float_as_int(v), 0x4E, 0xf, 0xf, true));
    v += __int_as_float(__builtin_amdgcn_update_dpp(0, __float_as_int(v), 0x141, 0xf, 0xf, true));
    v += __int_as_float(__builtin_amdgcn_update_dpp(0, __float_as_int(v), 0x140, 0xf, 0xf, true));
    return v;
}
__device__ __forceinline__ float wmax(float v) {
#pragma unroll
    for (int o = 32; o > 0; o >>= 1) v = fmaxf(v, __shfl_xor(v, o));
    return v;
}
__device__ __forceinline__ float gelu_tanh(float x) { return 0.5f * x * (1.f + tanhf(0.7978845608028654f * (x + 0.044715f * x * x * x))); }
__device__ __forceinline__ int tid_opaque() { int t = threadIdx.x; asm volatile("" : "+v"(t)); return t; }
#ifndef LAS3
#define LAS3 __attribute__((address_space(3)))
#endif
#define WAVE_SYNC() asm volatile("s_waitcnt lgkmcnt(0)" ::: "memory")
__device__ __forceinline__ int vblock() { return __builtin_amdgcn_readfirstlane(*(volatile LAS3 int*)(unsigned)(LDS_CTL_OFF + 8)); }

__device__ __forceinline__ void rmsnorm_rows(const float* in, const float* g, u16* out, int rows) {
    const int tid = tid_opaque(), lane = tid & 63, gw = (blockIdx.x * NT + tid) >> 6, ngw = (gridDim.x * NT) >> 6;
    for (int r = gw; r < rows; r += ngw) {
        const float4* xr = (const float4*)(in + (size_t)r * DM);
        float4 v[4]; float ss = 0.f;
#pragma unroll
        for (int j = 0; j < 4; ++j) { v[j] = xr[lane + 64 * j]; ss += v[j].x * v[j].x + v[j].y * v[j].y + v[j].z * v[j].z + v[j].w * v[j].w; }
        ss = wsum(ss);
        const float rstd = rsqrtf(ss * (1.f / DM) + EPS);
#pragma unroll
        for (int j = 0; j < 4; ++j) {
            const float4 gg = ((const float4*)g)[lane + 64 * j];
            uint2 o; o.x = pk2(v[j].x * rstd * gg.x, v[j].y * rstd * gg.y); o.y = pk2(v[j].z * rstd * gg.z, v[j].w * rstd * gg.w);
            ((uint2*)(out + (size_t)r * DM))[lane + 64 * j] = o;
        }
    }
}
__device__ __forceinline__ void cast_rows(const float* in, u16* hb, float* rs) {
    const int tid = tid_opaque(), lane = tid & 63, gw = (blockIdx.x * NT + tid) >> 6, ngw = (gridDim.x * NT) >> 6;
    for (int r = gw; r < T; r += ngw) {
        const float4* xr = (const float4*)(in + (size_t)r * DM);
        float4 v[4]; float ss = 0.f;
#pragma unroll
        for (int j = 0; j < 4; ++j) { v[j] = xr[lane + 64 * j]; ss += v[j].x * v[j].x + v[j].y * v[j].y + v[j].z * v[j].z + v[j].w * v[j].w; }
        ss = wsum(ss);
#pragma unroll
        for (int j = 0; j < 4; ++j) { uint2 o; o.x = pk2(v[j].x, v[j].y); o.y = pk2(v[j].z, v[j].w); ((uint2*)(hb + (size_t)r * DM))[lane + 64 * j] = o; }
        if (lane == 0) rs[r] = rsqrtf(ss * (1.f / DM) + EPS);
    }
}
template <bool FINAL> __device__ __forceinline__ void postnorm_rows(u16* hb, const u16* y, const float* gpost, float* rs, float* fout) {
    const int vb = vblock(), tid = tid_opaque(), lane = tid & 63, gw = (vb >> 3) * 8 + (tid >> 6), ngw = 256, rbase = (vb & 7) * SEQ, rend = rbase + SEQ;
    for (int r0 = rbase + gw; r0 < rend; r0 += 2 * ngw) {
        const bool two = r0 + ngw < rend; const int r1 = two ? r0 + ngw : r0;
        uint4 yw[2][2], hw[2][2];
#pragma unroll
        for (int q = 0; q < 2; ++q) { const size_t ro = (size_t)(q ? r1 : r0) * DM + lane * 8;
#pragma unroll
            for (int j = 0; j < 2; ++j) { yw[q][j] = *(const uint4*)(y + ro + j * 512); hw[q][j] = *(const uint4*)(hb + ro + j * 512); } }
        float4 g0[2], g1[2];
#pragma unroll
        for (int j = 0; j < 2; ++j) { g0[j] = *(const float4*)(gpost + j * 512 + lane * 8); g1[j] = *(const float4*)(gpost + j * 512 + lane * 8 + 4); }
#pragma unroll
        for (int q = 0; q < 2; ++q) {
            if (q == 1 && !two) break;
            const int r = q ? r1 : r0;
            float yv[16], hv[16]; float ss = 0.f;
#pragma unroll
            for (int j = 0; j < 2; ++j) {
                const uint4 w = yw[q][j], h4 = hw[q][j];
                yv[j * 8 + 0] = bflo(w.x); yv[j * 8 + 1] = bfhi(w.x); yv[j * 8 + 2] = bflo(w.y); yv[j * 8 + 3] = bfhi(w.y);
                yv[j * 8 + 4] = bflo(w.z); yv[j * 8 + 5] = bfhi(w.z); yv[j * 8 + 6] = bflo(w.w); yv[j * 8 + 7] = bfhi(w.w);
                hv[j * 8 + 0] = bflo(h4.x); hv[j * 8 + 1] = bfhi(h4.x); hv[j * 8 + 2] = bflo(h4.y); hv[j * 8 + 3] = bfhi(h4.y);
                hv[j * 8 + 4] = bflo(h4.z); hv[j * 8 + 5] = bfhi(h4.z); hv[j * 8 + 6] = bflo(h4.w); hv[j * 8 + 7] = bfhi(h4.w);
            }
#pragma unroll
            for (int i = 0; i < 16; ++i) ss += yv[i] * yv[i];
            ss = wsum(ss);
            const float rstd = rsqrtf(ss * (1.f / DM) + EPS);
            float s2 = 0.f;
#pragma unroll
            for (int j = 0; j < 2; ++j) {
                hv[j * 8 + 0] += yv[j * 8 + 0] * rstd * g0[j].x; hv[j * 8 + 1] += yv[j * 8 + 1] * rstd * g0[j].y; hv[j * 8 + 2] += yv[j * 8 + 2] * rstd * g0[j].z; hv[j * 8 + 3] += yv[j * 8 + 3] * rstd * g0[j].w;
                hv[j * 8 + 4] += yv[j * 8 + 4] * rstd * g1[j].x; hv[j * 8 + 5] += yv[j * 8 + 5] * rstd * g1[j].y; hv[j * 8 + 6] += yv[j * 8 + 6] * rstd * g1[j].z; hv[j * 8 + 7] += yv[j * 8 + 7] * rstd * g1[j].w;
                if constexpr (FINAL) {
                    float* o = fout + (size_t)r * DM + j * 512 + lane * 8;
                    *(float4*)o = make_float4(hv[j * 8 + 0], hv[j * 8 + 1], hv[j * 8 + 2], hv[j * 8 + 3]);
                    *(float4*)(o + 4) = make_float4(hv[j * 8 + 4], hv[j * 8 + 5], hv[j * 8 + 6], hv[j * 8 + 7]);
                } else {
                    uint4 o;
                    o.x = pk2(hv[j * 8 + 0], hv[j * 8 + 1]); o.y = pk2(hv[j * 8 + 2], hv[j * 8 + 3]); o.z = pk2(hv[j * 8 + 4], hv[j * 8 + 5]); o.w = pk2(hv[j * 8 + 6], hv[j * 8 + 7]);
                    *(uint4*)(hb + (size_t)r * DM + j * 512 + lane * 8) = o;
                }
            }
            if constexpr (!FINAL) {
#pragma unroll
                for (int i = 0; i < 16; ++i) s2 += hv[i] * hv[i];
                s2 = wsum(s2);
                if (lane == 0) rs[r] = rsqrtf(s2 * (1.f / DM) + EPS);
            }
        }
    }
}

namespace pg8 {
#define PG8_LAS __attribute__((address_space(3)))
typedef unsigned short bf16_t;
typedef short bf16x8 __attribute__((ext_vector_type(8)));
typedef float f32x4 __attribute__((ext_vector_type(4)));
typedef unsigned u32x4 __attribute__((ext_vector_type(4)));
typedef int i32x4 __attribute__((ext_vector_type(4)));
typedef int i32x8 __attribute__((ext_vector_type(8)));
constexpr int BM = 256, BK = 64, HALF = 128, HTB = HALF * BK * 2  , STAGE_BYTES = 8 * HTB, NXCD = 8, WGM = 8;

__host__ __device__ __forceinline__ int lds_byte(int r, int c) { const int st = (r >> 4) * 2 + (c >> 5), rr = r & 15, cc = c & 31, ob = rr * 64 + cc * 2; return st * 1024 + (ob ^ (((ob >> 9) & 1) << 5)); }
__host__ __device__ __forceinline__ void stage_rc(int b, int& R, int& C) { const int st = b / 1024, sb = b % 1024, swz = sb ^ (((sb >> 9) & 1) << 5); R = (st >> 1) * 16 + swz / 64; C = (st & 1) * 32 + (swz % 64) / 2; }
__host__ __device__ __forceinline__ int perm32(int rho) { const int n = rho >> 4, i = rho & 15; return 8 * (i >> 2) + 4 * n + (i & 3); }

struct Unit { int pm, pn; long aoff, boff, coff; };
struct Gemm { const bf16_t* A; const bf16_t* Bt; int M, N, K, lda, ldb; };

struct StaticOrder {
    int nM, nN, nwg, G, c;
    __host__ __device__ void init(int M, int N, int G_, int c_) { nM = M / BM; nN = N / BM; nwg = nM * nN; G = G_; c = c_; }
    __host__ __device__ bool next(int i, Unit& u) const {
        const long L = (long)i * G + c; if (L >= nwg) return false;
        int wgid = (int)L; { const int q = nwg / NXCD, r = nwg % NXCD, xcd = wgid % NXCD, off = wgid / NXCD; wgid = (xcd < r ? xcd * (q + 1) : r * (q + 1) + (xcd - r) * q) + off; }
        const int nig = WGM * nN, gid = wgid / nig, fm = gid * WGM, gsz = (nM - fm) < WGM ? (nM - fm) : WGM;
        u.pm = fm + ((wgid % nig) % gsz); u.pn = (wgid % nig) / gsz; u.aoff = 0; u.boff = 0; u.coff = 0; return true;
    }
    __device__ __forceinline__ void a_ready(const Unit&) const {}
    __device__ __forceinline__ void done(const Unit&) const {}
};
__device__ __forceinline__ unsigned cvt_pk_bf16(float lo, float hi) { unsigned r; asm volatile("v_cvt_pk_bf16_f32 %0, %1, %2" : "=v"(r) : "v"(lo), "v"(hi)); return r; }
template <class Epi, class Sched, bool ALIGN_EPI = false, bool SP2 = false, bool F8 = false>
__device__ __forceinline__ void gemm_phase(PG8_LAS unsigned char* lds, const Gemm g, const Sched& S, const Epi& E) {
    const int tid = tid_opaque(), wid = __builtin_amdgcn_readfirstlane(tid >> 6), lane = tid & 63, wr = wid >> 2, wc = wid & 3, fr = lane & 15, fq = lane >> 4;
    const int K = g.K, nt = K / BK;
    unsigned voffA[2], voffB[2];
#pragma unroll
    for (int i = 0; i < 2; ++i) { int R, C; stage_rc(tid * 16 + i * 8192, R, C); const int Rb = Epi::PERM ? ((R & ~31) + perm32(R & 31)) : R;
        voffA[i] = (unsigned)(R * g.lda + C) * 2u; voffB[i] = (unsigned)(Rb * g.ldb + C) * 2u; }
    const size_t kstep = (size_t)(BK * 2);
    const size_t hstepA = (size_t)HALF * g.lda * 2, hstepB = (size_t)HALF * g.ldb * 2;
    const size_t tstepA = 2 * hstepA, tstepB = 2 * hstepB;
    const unsigned ldsw = (unsigned)wid * 1024u;
    const int aoff = lds_byte(wr * 64 + fr, fq * 8), boff = lds_byte(wc * 32 + fr, fq * 8);
#define PG8_SA(b, h) (((b) * 2 + (h)) * HTB)
#define PG8_SB(b, h) ((4 + (b) * 2 + (h)) * HTB)
#define PG8_STAGE(bufoff, gbase, voff) do { _Pragma("unroll") for (int _i = 0; _i < 2; ++_i) \
        __builtin_amdgcn_global_load_lds((const unsigned*)((const char*)(gbase) + (voff)[_i]), (PG8_LAS unsigned*)(lds + (bufoff) + ldsw + _i * 8192), 16, 0, 0); } while (0)
#define PG8_LDA(dst, b, h) do { _Pragma("unroll") for (int m = 0; m < 4; ++m) _Pragma("unroll") for (int k = 0; k < 2; ++k) dst[m][k] = *(const PG8_LAS bf16x8*)(lds + PG8_SA(b, h) + aoff + m * 2048 + k * 1024); } while (0)
#define PG8_LDB(dst, b, h) do { _Pragma("unroll") for (int n = 0; n < 2; ++n) _Pragma("unroll") for (int k = 0; k < 2; ++k) dst[n][k] = *(const PG8_LAS bf16x8*)(lds + PG8_SB(b, h) + boff + n * 2048 + k * 1024); } while (0)
#define PG8_MMA(ai, bj, At, Bt) do { __builtin_amdgcn_s_setprio(1); _Pragma("unroll") for (int m = 0; m < 4; ++m) _Pragma("unroll") for (int n = 0; n < 2; ++n) { \
        if constexpr (F8) { const i32x8 b8_ = __builtin_shufflevector((i32x4)Bt[n][0], (i32x4)Bt[n][1], 0, 1, 2, 3, 4, 5, 6, 7), a8_ = __builtin_shufflevector((i32x4)At[m][0], (i32x4)At[m][1], 0, 1, 2, 3, 4, 5, 6, 7); \
                            asm volatile("v_mfma_f32_16x16x128_f8f6f4 %0, %1, %2, %0" : "+v"(acc[ai][bj][m][n]) : "v"(b8_), "v"(a8_)); } \
        else { _Pragma("unroll") for (int k = 0; k < 2; ++k) acc[ai][bj][m][n] = __builtin_amdgcn_mfma_f32_16x16x32_bf16(Bt[n][k], At[m][k], acc[ai][bj][m][n], 0, 0, 0); } } \
        __builtin_amdgcn_s_setprio(0); } while (0)
#define PG8_WAIT_V(n) asm volatile("s_waitcnt vmcnt(" #n ")" ::: "memory")
#define PG8_WAIT_L(n) asm volatile("s_waitcnt lgkmcnt(" #n ")" ::: "memory")
#define PG8_BAR __builtin_amdgcn_s_barrier()
#define PG8_SCHED __builtin_amdgcn_sched_barrier(0)
    Unit cur, nxt; int ui = 0;
    if (!S.next(0, cur)) return;
    f32x4 acc[2][2][4][2];
#pragma unroll
    for (int a = 0; a < 2; ++a)
#pragma unroll
        for (int b = 0; b < 2; ++b)
#pragma unroll
            for (int m = 0; m < 4; ++m)
#pragma unroll
                for (int n = 0; n < 2; ++n) acc[a][b][m][n] = (f32x4){0.f, 0.f, 0.f, 0.f};
    bf16x8 At[4][2], B0[2][2], B1[2][2];
    const char* cA = (const char*)g.A + (size_t)cur.pm * tstepA + cur.aoff * 2; const char* cB = (const char*)g.Bt + (size_t)cur.pn * tstepB + cur.boff * 2;
    S.a_ready(cur);
    if constexpr (SP2) {
        PG8_STAGE(PG8_SB(0, 0), cB, voffB); PG8_STAGE(PG8_SB(0, 1), cB + hstepB, voffB); PG8_STAGE(PG8_SA(0, 0), cA, voffA); PG8_STAGE(PG8_SA(0, 1), cA + hstepA, voffA);
        if (wr == 1) PG8_BAR;
        PG8_WAIT_V(2); PG8_BAR;
        PG8_STAGE(PG8_SB(1, 0), cB + kstep, voffB); PG8_STAGE(PG8_SA(1, 0), cA + kstep, voffA); PG8_STAGE(PG8_SB(1, 1), cB + hstepB + kstep, voffB);
        PG8_WAIT_V(6); PG8_BAR;
    } else {
        PG8_STAGE(PG8_SB(0, 0), cB, voffB); PG8_STAGE(PG8_SA(0, 0), cA, voffA); PG8_STAGE(PG8_SB(0, 1), cB + hstepB, voffB); PG8_STAGE(PG8_SA(0, 1), cA + hstepA, voffA);
        if (wr == 1) PG8_BAR;
        PG8_WAIT_V(4); PG8_BAR;
        PG8_STAGE(PG8_SB(1, 0), cB + kstep, voffB); PG8_STAGE(PG8_SA(1, 0), cA + kstep, voffA); PG8_STAGE(PG8_SB(1, 1), cB + hstepB + kstep, voffB);
        PG8_WAIT_V(6); PG8_BAR;
    }
    for (;;) {
        const bool has_next = S.next(ui + 1, nxt);
        const char* nA = has_next ? (const char*)g.A + (size_t)nxt.pm * tstepA + nxt.aoff * 2 : cA; const char* nB = has_next ? (const char*)g.Bt + (size_t)nxt.pn * tstepB + nxt.boff * 2 : cB;
        for (int t = 0; t < nt; t += 2) {
            const bool last = (t == nt - 2);
            const char* a1 = cA + (size_t)(t + 1) * kstep;
            const char* a2 = last ? nA : cA + (size_t)(t + 2) * kstep; const char* b2 = last ? nB : cB + (size_t)(t + 2) * kstep;
            const char* a3 = a2 + kstep; const char* b3 = b2 + kstep;
            if (last && has_next) S.a_ready(nxt);
            if constexpr (SP2) {
            PG8_LDB(B0, 0, 0); PG8_LDB(B1, 0, 1); PG8_SCHED; PG8_LDA(At, 0, 0); PG8_STAGE(PG8_SA(1, 1), a1 + hstepA, voffA);
            PG8_WAIT_V(8); PG8_WAIT_L(0); PG8_BAR; PG8_MMA(0, 0, At, B0); PG8_MMA(0, 1, At, B1); PG8_BAR; PG8_SCHED;
            PG8_LDA(At, 0, 1); PG8_STAGE(PG8_SB(0, 0), b2, voffB); PG8_STAGE(PG8_SB(0, 1), b2 + hstepB, voffB); PG8_STAGE(PG8_SA(0, 0), a2, voffA);
            PG8_WAIT_V(8); PG8_WAIT_L(0); PG8_BAR; PG8_MMA(1, 0, At, B0); PG8_MMA(1, 1, At, B1); PG8_BAR; PG8_SCHED;
            PG8_LDB(B0, 1, 0); PG8_LDB(B1, 1, 1); PG8_SCHED; PG8_LDA(At, 1, 0); PG8_STAGE(PG8_SA(0, 1), a2 + hstepA, voffA);
            PG8_WAIT_V(8); PG8_WAIT_L(0); PG8_BAR; PG8_MMA(0, 0, At, B0); PG8_MMA(0, 1, At, B1); PG8_BAR; PG8_SCHED;
            PG8_LDA(At, 1, 1); PG8_STAGE(PG8_SB(1, 0), b3, voffB); PG8_STAGE(PG8_SB(1, 1), b3 + hstepB, voffB); PG8_STAGE(PG8_SA(1, 0), a3, voffA);
            PG8_WAIT_V(8); PG8_WAIT_L(0); PG8_BAR; PG8_MMA(1, 0, At, B0); PG8_MMA(1, 1, At, B1); PG8_BAR; PG8_SCHED;
            } else {
            PG8_LDB(B0, 0, 0); PG8_SCHED; PG8_LDA(At, 0, 0); PG8_STAGE(PG8_SA(1, 1), a1 + hstepA, voffA);
            PG8_WAIT_L(8); PG8_BAR; PG8_WAIT_L(0); PG8_MMA(0, 0, At, B0); PG8_BAR; PG8_SCHED;
            PG8_LDB(B1, 0, 1); PG8_STAGE(PG8_SB(0, 0), b2, voffB);
            PG8_BAR; PG8_WAIT_L(0); PG8_MMA(0, 1, At, B1); PG8_BAR;
            PG8_LDA(At, 0, 1); PG8_STAGE(PG8_SA(0, 0), a2, voffA);
            PG8_BAR; PG8_WAIT_L(0); PG8_MMA(1, 0, At, B0); PG8_BAR; PG8_SCHED;
            PG8_STAGE(PG8_SB(0, 1), b2 + hstepB, voffB);
            PG8_WAIT_V(6); PG8_BAR; PG8_MMA(1, 1, At, B1); PG8_BAR;
            PG8_LDB(B0, 1, 0); PG8_SCHED; PG8_LDA(At, 1, 0); PG8_STAGE(PG8_SA(0, 1), a2 + hstepA, voffA);
            PG8_WAIT_L(8); PG8_BAR; PG8_WAIT_L(0); PG8_MMA(0, 0, At, B0); PG8_BAR; PG8_SCHED;
            PG8_LDB(B1, 1, 1); PG8_STAGE(PG8_SB(1, 0), b3, voffB);
            PG8_BAR; PG8_WAIT_L(0); PG8_MMA(0, 1, At, B1); PG8_BAR;
            PG8_LDA(At, 1, 1); PG8_STAGE(PG8_SA(1, 0), a3, voffA);
            PG8_BAR; PG8_WAIT_L(0); PG8_MMA(1, 0, At, B0); PG8_BAR; PG8_SCHED;
            PG8_STAGE(PG8_SB(1, 1), b3 + hstepB, voffB);
            PG8_WAIT_V(6); PG8_BAR; PG8_MMA(1, 1, At, B1); PG8_BAR;
            }
        }
        if constexpr (F8) asm volatile("s_nop 15\n\ts_nop 15\n\ts_nop 15\n\ts_nop 15" ::: "memory");
        if constexpr (ALIGN_EPI) { if (wr == 0) PG8_BAR; }
        if constexpr (!Epi::AFTER_DRAIN) { E(acc, cur, wr, wc, fr, fq); S.done(cur); }
        if (!has_next) break;
#pragma unroll
        for (int a = 0; a < 2; ++a)
#pragma unroll
            for (int b = 0; b < 2; ++b)
#pragma unroll
                for (int m = 0; m < 4; ++m)
#pragma unroll
                    for (int n = 0; n < 2; ++n) acc[a][b][m][n] = (f32x4){0.f, 0.f, 0.f, 0.f};
        cur = nxt; cA = nA; cB = nB; ++ui;
        if constexpr (ALIGN_EPI) { if (wr == 1) PG8_BAR; }
    }
    PG8_WAIT_V(0);
    if constexpr (!ALIGN_EPI) { if (wr == 0) PG8_BAR; }
    PG8_BAR;
    if constexpr (Epi::AFTER_DRAIN) { E.fused(acc, cur, wr, wc, fr, fq, lds, wid, lane); S.done(cur); }
#undef PG8_SA
#undef PG8_SB
#undef PG8_STAGE
#undef PG8_LDA
#undef PG8_LDB
#undef PG8_MMA
#undef PG8_WAIT_V
#undef PG8_WAIT_L
#undef PG8_BAR
#undef PG8_SCHED
}
}

struct EpiStore {
    static constexpr bool PERM = true, AFTER_DRAIN = false;
    u16* O; int ldc; int act; const float* rs;
    float osc = 1.f;
    __device__ __forceinline__ void operator()(const pg8::f32x4 (&acc)[2][2][4][2], const pg8::Unit& u, int wr, int wc, int fr, int fq) const {
        int fr_ = fr, fq_ = fq; asm volatile("" : "+v"(fr_), "+v"(fq_));
        const int row0 = u.pm * 256 + wr * 64 + fr_;
        u16* base = O + u.coff + (size_t)(u.pm * 256) * ldc + u.pn * 256;
        const int loff0 = (wr * 64 + fr_) * ldc + wc * 32 + 8 * fq_;
#pragma unroll
        for (int ai = 0; ai < 2; ++ai)
#pragma unroll
            for (int m = 0; m < 4; ++m) { u16* rowp = base + (loff0 + (ai * 128 + m * 16) * ldc);
                const float rsc = rs ? rs[row0 + ai * 128 + m * 16] : osc;
#pragma unroll
                for (int bj = 0; bj < 2; ++bj) { pg8::f32x4 v0 = acc[ai][bj][m][0] * rsc, v1 = acc[ai][bj][m][1] * rsc;
                    if (act == 1) {
#pragma unroll
                        for (int r = 0; r < 4; ++r) { const float a = fmaxf(v0[r], 0.f), b = fmaxf(v1[r], 0.f); v0[r] = a * a; v1[r] = b * b; }
                    }
                    pg8::u32x4 w; w.x = pg8::cvt_pk_bf16(v0[0], v0[1]); w.y = pg8::cvt_pk_bf16(v0[2], v0[3]); w.z = pg8::cvt_pk_bf16(v1[0], v1[1]); w.w = pg8::cvt_pk_bf16(v1[2], v1[3]);
                    *(pg8::u32x4*)(rowp + bj * 128) = w; } }
    }
};
struct EpiStoreF8 {
    static constexpr bool PERM = true, AFTER_DRAIN = false;
    unsigned char* O; int ldc; const float* rs;
    __device__ __forceinline__ void operator()(const pg8::f32x4 (&acc)[2][2][4][2], const pg8::Unit& u, int wr, int wc, int fr, int fq) const {
        int fr_ = fr, fq_ = fq; asm volatile("" : "+v"(fr_), "+v"(fq_));
        const int row0 = u.pm * 256 + wr * 64 + fr_;
        unsigned char* base = O + (size_t)(u.pm * 256) * ldc + u.pn * 256;
        const int loff0 = (wr * 64 + fr_) * ldc + wc * 32 + 8 * fq_;
#pragma unroll
        for (int ai = 0; ai < 2; ++ai)
#pragma unroll
            for (int m = 0; m < 4; ++m) { unsigned char* rowp = base + (loff0 + (ai * 128 + m * 16) * ldc);
                const float rsc = rs[row0 + ai * 128 + m * 16] * 2.8284271247461903f;
#pragma unroll
                for (int bj = 0; bj < 2; ++bj) { pg8::f32x4 v0 = acc[ai][bj][m][0] * rsc, v1 = acc[ai][bj][m][1] * rsc;
#pragma unroll
                    for (int r = 0; r < 4; ++r) { const float a = fmaxf(v0[r], 0.f), b = fmaxf(v1[r], 0.f); v0[r] = fminf(a * a, 448.f); v1[r] = fminf(b * b, 448.f); }
                    int lo8 = __builtin_amdgcn_cvt_pk_fp8_f32(v0[0], v0[1], 0, false); lo8 = __builtin_amdgcn_cvt_pk_fp8_f32(v0[2], v0[3], lo8, true);
                    int hi8 = __builtin_amdgcn_cvt_pk_fp8_f32(v1[0], v1[1], 0, false); hi8 = __builtin_amdgcn_cvt_pk_fp8_f32(v1[2], v1[3], hi8, true);
                    uint2 w; w.x = (unsigned)lo8; w.y = (unsigned)hi8;
                    *(uint2*)(rowp + bj * 128) = w; } }
    }
};
template <int TYPE> struct PreOrder {
    int b, id16, l;
    __device__ __forceinline__ bool next(int i, pg8::Unit& u) const {
        if (i > 0) return false;
        const int pt = id16 & 3, h = (id16 >> 2) & 3;
        if (TYPE == 0) { u.pm = 0; u.pn = pt; u.aoff = (long)l * 2048 * 2048 + (long)(b * 256) * 2048 + h * 256; u.boff = (long)l * DM * DM + h * 256;
                         u.coff = ((long)b * 1024 + h * 256) * 1024; }
        else { u.pm = pt; u.pn = 0; u.aoff = (long)l * DM * DM + h * 256; u.boff = (long)l * 2048 * 2048 + (long)(b * 256) * 2048 + 1024 + h * 256;
               u.coff = (long)b * 1024 * 1024 + h * 256; }
        return true;
    }
    __device__ __forceinline__ void a_ready(const pg8::Unit&) const {}
    __device__ __forceinline__ void done(const pg8::Unit&) const {}
};
struct KvOrder {
    int vb;
    __device__ __forceinline__ bool next(int i, pg8::Unit& u) const {
        const int rk = vb >> 3; if (i > 0 || rk >= 16) return false;
        const int l = rk >> 3;
        u.pm = vb & 7; u.pn = rk & 7; u.aoff = (long)l * 2048 * DM; u.boff = (long)l * 2048 * DM; u.coff = (long)l * 2048 * 2048; return true;
    }
    __device__ __forceinline__ void a_ready(const pg8::Unit&) const {}
    __device__ __forceinline__ void done(const pg8::Unit&) const {}
};
struct BatchBOrder : pg8::StaticOrder {
    __device__ __forceinline__ bool next(int i, pg8::Unit& u) const { if (!pg8::StaticOrder::next(i, u)) return false; u.boff = (long)(u.pm >> 4) * (1024 * 1024); return true; }
};
struct EpiSoftmax {
    static constexpr bool PERM = true, AFTER_DRAIN = false;
    u16* O; int ldc; const float* rs; PG8_LAS float* xl;
    __device__ __forceinline__ void operator()(pg8::f32x4 (&acc)[2][2][4][2], const pg8::Unit& u, int wr, int wc, int fr, int fq) const {
        int fr_ = fr, fq_ = fq; asm volatile("" : "+v"(fr_), "+v"(fq_));
        const int row0 = u.pm * 256 + wr * 64 + fr_;
        u16* base = O + (size_t)(u.pm * 256) * ldc + u.pn * 256;
        const int loff0 = (wr * 64 + fr_) * ldc + wc * 32 + 8 * fq_;
        float mown[2][4];
#pragma unroll
        for (int ai = 0; ai < 2; ++ai)
#pragma unroll
            for (int m = 0; m < 4; ++m) {
                const float rsc = rs[row0 + ai * 128 + m * 16] * (0.0625f * 1.4426950408889634f);
                float mx = -INFINITY;
#pragma unroll
                for (int bj = 0; bj < 2; ++bj)
#pragma unroll
                    for (int n = 0; n < 2; ++n) { acc[ai][bj][m][n] = acc[ai][bj][m][n] * rsc;
#pragma unroll
                        for (int r = 0; r < 4; ++r) mx = fmaxf(mx, acc[ai][bj][m][n][r]); }
                mx = fmaxf(mx, __shfl_xor(mx, 16)); mx = fmaxf(mx, __shfl_xor(mx, 32));
                float l = 0.f;
#pragma unroll
                for (int bj = 0; bj < 2; ++bj)
#pragma unroll
                    for (int n = 0; n < 2; ++n)
#pragma unroll
                        for (int r = 0; r < 4; ++r) { const float e = __builtin_amdgcn_exp2f(acc[ai][bj][m][n][r] - mx); acc[ai][bj][m][n][r] = e; l += e; }
                l += __shfl_xor(l, 16); l += __shfl_xor(l, 32);
                mown[ai][m] = mx;
                if (fq_ == 0) { PG8_LAS float* x = xl + ((ai * 128 + wr * 64 + m * 16 + fr_) * 4 + wc) * 2; x[0] = mx; x[1] = l; }
            }
        asm volatile("s_waitcnt lgkmcnt(0)" ::: "memory"); __builtin_amdgcn_s_barrier(); asm volatile("" ::: "memory");
#pragma unroll
        for (int ai = 0; ai < 2; ++ai)
#pragma unroll
            for (int m = 0; m < 4; ++m) {
                const PG8_LAS pg8::f32x4* x = (const PG8_LAS pg8::f32x4*)(xl + (ai * 128 + wr * 64 + m * 16 + fr_) * 8);
                const pg8::f32x4 x0 = x[0], x1 = x[1];
                const float M = fmaxf(fmaxf(x0[0], x0[2]), fmaxf(x1[0], x1[2]));
                const float L = x0[1] * __builtin_amdgcn_exp2f(x0[0] - M) + x0[3] * __builtin_amdgcn_exp2f(x0[2] - M) + x1[1] * __builtin_amdgcn_exp2f(x1[0] - M) + x1[3] * __builtin_amdgcn_exp2f(x1[2] - M);
                const float f = __builtin_amdgcn_exp2f(mown[ai][m] - M) / L;
                u16* rowp = base + (loff0 + (ai * 128 + m * 16) * ldc);
#pragma unroll
                for (int bj = 0; bj < 2; ++bj) { const pg8::f32x4 v0 = acc[ai][bj][m][0] * f, v1 = acc[ai][bj][m][1] * f;
                    pg8::u32x4 w; w.x = pg8::cvt_pk_bf16(v0[0], v0[1]); w.y = pg8::cvt_pk_bf16(v0[2], v0[3]); w.z = pg8::cvt_pk_bf16(v1[0], v1[1]); w.w = pg8::cvt_pk_bf16(v1[2], v1[3]);
                    *(pg8::u32x4*)(rowp + bj * 128) = w; }
            }
    }
};
struct EpiRope {
    static constexpr bool PERM = true, AFTER_DRAIN = false;
    u16* Z; u16* KB; u16* VB; u16* KI; const float* rs; const float2* rope;
    __device__ __forceinline__ void operator()(const pg8::f32x4 (&acc)[2][2][4][2], const pg8::Unit& u, int wr, int wc, int fr, int fq) const {
        int fr_ = fr, fq_ = fq; asm volatile("" : "+v"(fr_), "+v"(fq_));
#pragma unroll
        for (int ai = 0; ai < 2; ++ai)
#pragma unroll
            for (int m = 0; m < 4; ++m) {
                const int row = u.pm * 256 + ai * 128 + wr * 64 + m * 16 + fr_;
                const float rsc = rs[row];
#pragma unroll
                for (int bj = 0; bj < 2; ++bj) {
                    const int col = u.pn * 256 + bj * 128 + wc * 32 + 8 * fq_;
                    const pg8::f32x4 a0 = acc[ai][bj][m][0] * rsc, a1 = acc[ai][bj][m][1] * rsc;
                    float v[8] = {a0[0], a0[1], a0[2], a0[3], a1[0], a1[1], a1[2], a1[3]};
                    const bool is_v = (u.pn == 4 && bj == 1), is_tail = (u.pn == 7) && (bj == 1 || wc >= 2);
                    if (!is_v && !is_tail) {
                        const bool small = u.pn >= 5;
                        const int lc = small ? (col & 63) : (col & 127), i0 = lc >> 1;
                        const float2* tp = rope + (size_t)row * 64 + (small ? 2 * i0 : i0);
#pragma unroll
                        for (int e = 0; e < 4; ++e) {
                            const float2 cs = tp[small ? 2 * e : e];
                            const float x1 = v[2 * e], x2 = v[2 * e + 1];
                            v[2 * e] = x1 * cs.x - x2 * cs.y; v[2 * e + 1] = x2 * cs.x + x1 * cs.y;
                        }
                    }
                    pg8::u32x4 w; w.x = pg8::cvt_pk_bf16(v[0], v[1]); w.y = pg8::cvt_pk_bf16(v[2], v[3]); w.z = pg8::cvt_pk_bf16(v[4], v[5]); w.w = pg8::cvt_pk_bf16(v[6], v[7]);
                    if (u.pn < 4 || u.pn == 5 || u.pn == 6) *(pg8::u32x4*)(Z + (size_t)row * ZP1 + col) = w;
                    else if (u.pn == 4) { if (bj == 0) *(pg8::u32x4*)(KB + (size_t)row * 128 + (col - 1024)) = w; else *(pg8::u32x4*)(VB + (size_t)row * 128 + (col - 1152)) = w; }
                    else {
                        if (bj == 0 && wc < 2) { const int d = col - 1792, s = row & 4095, bb = row >> 12;
                            *(pg8::u32x4*)(KI + ((size_t)bb * 128 + (s >> 5)) * 2048 + ((d >> 4) * 2 + ((d >> 3) & 1)) * 256 + (s & 31) * 8) = w; }
                        else if (bj == 0 && wc == 2 && fq_ == 0) {
                            pg8::u32x4 ww; ww.x = pg8::cvt_pk_bf16(v[0] * 0.35355339059327373f, v[1] * 0.35355339059327373f); ww.y = pg8::cvt_pk_bf16(v[2] * 0.35355339059327373f, v[3] * 0.35355339059327373f);
                            ww.z = pg8::cvt_pk_bf16(v[4] * 0.35355339059327373f, v[5] * 0.35355339059327373f); ww.w = pg8::cvt_pk_bf16(v[6] * 0.35355339059327373f, v[7] * 0.35355339059327373f);
                            *(pg8::u32x4*)(Z + (size_t)row * ZP1 + 1856) = ww; }
                    }
                }
            }
    }
};
__device__ __forceinline__ void gemm8(const u16* A, const u16* Bt, int M, int N, int K, u16* C, int ldc, int act, const float* rs, unsigned char* smem) {
    pg8::Gemm g{A, Bt, M, N, K, K, K}; pg8::StaticOrder S; S.init(M, N, (int)gridDim.x, vblock());
    EpiStore E{C, ldc, act, rs};
    pg8::gemm_phase<EpiStore, pg8::StaticOrder, true, true>((PG8_LAS unsigned char*)smem, g, S, E);
}

__device__ __forceinline__ int rope_col_perm(int n) {
    if (n < 1152) { const int d = n & 127; return (n & ~127) + 2 * (d & 63) + (d >> 6); }
    if (n < 1280 || n >= 1856) return n;
    const int d = (n - 1280) & 63; return n - d + 2 * (d & 31) + (d >> 5);
}
template <bool ROPE_PERM = false, bool F8 = false>
__device__ __forceinline__ void transpose_item(const float* W, int K, int N, u16* WT, LAS3 unsigned char* scr, int item, int lane, int nblk, const float* gain) {
    const int kb = item / nblk, nb = item % nblk, k0 = 64 * kb, n0 = 64 * nb;
    { const int kr = lane >> 4; int n = n0 + (lane & 15) * 4; if (n + 3 >= N) n = 0;
      const float* src = W + (size_t)(k0 + kr) * N + n;
#pragma unroll 1
      for (int i = 0; i < 16; ++i) { __builtin_amdgcn_global_load_lds((const unsigned*)src, (LAS3 unsigned*)(scr + i * 1040), 16, 0, 0); src += (size_t)4 * N; } }
    const int c = lane & 7;
    float gk[8];
#pragma unroll
    for (int e = 0; e < 8; ++e) gk[e] = F8 ? 256.f : (gain ? gain[k0 + 8 * c + e] : 1.f);
    asm volatile("s_waitcnt vmcnt(0)" ::: "memory");
#pragma unroll
    for (int j = 0; j < 8; ++j) { const int nn = (lane >> 3) + 8 * j;
        const LAS3 float* s = (const LAS3 float*)(scr + (2 * c) * 1040 + nn * 4);
        float v[8];
#pragma unroll
        for (int e = 0; e < 8; ++e) v[e] = *(const LAS3 float*)((const LAS3 unsigned char*)s + (e >> 2) * 1040 + (e & 3) * 256) * gk[e];
        if constexpr (F8) {
            int lo8 = __builtin_amdgcn_cvt_pk_fp8_f32(v[0], v[1], 0, false); lo8 = __builtin_amdgcn_cvt_pk_fp8_f32(v[2], v[3], lo8, true);
            int hi8 = __builtin_amdgcn_cvt_pk_fp8_f32(v[4], v[5], 0, false); hi8 = __builtin_amdgcn_cvt_pk_fp8_f32(v[6], v[7], hi8, true);
            uint2 o8; o8.x = (unsigned)lo8; o8.y = (unsigned)hi8;
            *(uint2*)((unsigned char*)WT + (size_t)(n0 + nn) * K + k0 + 8 * c) = o8;
        } else {
        uint4 o; o.x = pk2(v[0], v[1]); o.y = pk2(v[2], v[3]); o.z = pk2(v[4], v[5]); o.w = pk2(v[6], v[7]);
        if (n0 + nn >= N) o = make_uint4(0u, 0u, 0u, 0u);
        *(uint4*)(WT + (size_t)(ROPE_PERM ? rope_col_perm(n0 + nn) : (n0 + nn)) * K + k0 + 8 * c) = o; } }
    WAVE_SYNC();
}
__device__ __forceinline__ void weight_cast(const float* W, int K, int N, u16* out, const float* gain) {
    const int tid = tid_opaque(); const size_t gt = (size_t)blockIdx.x * NT + tid, gs = (size_t)gridDim.x * NT, tot = (size_t)K * N / 4;
    for (size_t i = gt; i < tot; i += gs) {
        const float4 v = ((const float4*)W)[i]; const float gk = gain[(i * 4) / N];
        uint2 o; o.x = pk2(v.x * gk, v.y * gk); o.y = pk2(v.z * gk, v.w * gk);
        ((uint2*)out)[i] = o;
    }
}
template <bool ROPE_PERM = false, bool F8 = false>
__device__ __forceinline__ void weight_prep(const float* W, int K, int N, int Npad, u16* WT, unsigned char* smem, const float* gain = nullptr) {
    const int tid = tid_opaque(), lane = tid & 63, wid = tid >> 6, gw = (blockIdx.x * NT + tid) >> 6, ngw = (gridDim.x * NT) >> 6;
    LAS3 unsigned char* scr = (LAS3 unsigned char*)smem + wid * 16640;
    const int nblk = Npad / 64, items = (K / 64) * nblk;
    for (int it = gw; it < items; it += ngw) transpose_item<ROPE_PERM, F8>(W, K, N, WT, scr, it, lane, nblk, gain);
}

typedef float f32x16 __attribute__((ext_vector_type(16)));
typedef short s16x4 __attribute__((ext_vector_type(4)));
typedef unsigned u32x4v __attribute__((ext_vector_type(4)));
constexpr int XK_PITCH = 528, XV_PITCH = 576;
__device__ __forceinline__ s16x4 lds_tr16(unsigned addr) {
    return __builtin_bit_cast(s16x4, __builtin_amdgcn_ds_read_tr16_b64_v4i16((LAS3 s16x4*)(uintptr_t)addr));
}

__device__ __forceinline__ float gelu_fast(float x) {
    const float u = 0.7978845608028654f * (x + 0.044715f * x * x * x);
    return x * __builtin_amdgcn_rcpf(1.f + __builtin_amdgcn_exp2f(-2.8853900817779268f * u));
}
constexpr int MV_PITCH = 320, MP_PITCH = 272;
__device__ __forceinline__ void mixer_a_all(const Params& p, unsigned char* smem) {
    const int tid = tid_opaque(), lane = tid & 63, wid = __builtin_amdgcn_readfirstlane(tid >> 6), r32 = lane & 31, hi = lane >> 5, l15 = lane & 15, g4 = lane >> 4;
    LAS3 unsigned char* lds = (LAS3 unsigned char*)smem;
    const unsigned lds0 = (unsigned)(uintptr_t)lds;
    const u16* Z = (const u16*)(p.ws + WS_Z); u16* MIX = (u16*)(p.ws + WS_MIX);
    const int ct = wid & 3, tb0 = wid >> 2;
    const int vb_ = vblock();
#define MIXA_UNIT(I) ((((vb_ & 7) * 32 + 4 * (vb_ >> 5) + (I)) << 2) | ((vb_ >> 3) & 3))
    int unit = MIXA_UNIT(0);
    u32x4v vraw[4];
#pragma unroll
    for (int i = 0; i < 4; ++i) vraw[i] = *(const u32x4v*)(Z + ((size_t)(unit >> 2) * 128 + wid * 16 + 4 * i + g4) * ZP0 + 512 + (unit & 3) * 128 + l15 * 8);
    int gcur = -1;
    bf16x8 wfr[2][8]; float4 ga, gb; float biasj[2];
#pragma unroll 1
    for (int ui = 0; ui < 4; ++ui) {
    unit = MIXA_UNIT(ui);
    const int g = unit & 3, bn = unit >> 2;
    const size_t row0 = (size_t)bn * 128;
    if (g != gcur) {
        gcur = g;
        const u16* Wc = (const u16*)(p.ws + WS_WC) + (size_t)g * 16384;
#pragma unroll
        for (int j = 0; j < 2; ++j)
#pragma unroll
            for (int ks = 0; ks < 8; ++ks) wfr[j][ks] = *(const bf16x8*)(Wc + (32 * (tb0 + 2 * j) + r32) * 128 + 16 * ks + 8 * hi);
        ga = *(const float4*)(p.sgu_g + g * 128 + l15 * 8); gb = *(const float4*)(p.sgu_g + g * 128 + l15 * 8 + 4);
#pragma unroll
        for (int j = 0; j < 2; ++j) biasj[j] = p.sgu_bs[g * 128 + 32 * (tb0 + 2 * j) + r32];
    }
    uint2 uraw[2][4];
#pragma unroll
    for (int j = 0; j < 2; ++j) {
        const int t = 32 * (tb0 + 2 * j) + r32;
#pragma unroll
        for (int rq = 0; rq < 4; ++rq) uraw[j][rq] = *(const uint2*)(Z + (row0 + t) * ZP0 + g * 128 + 32 * ct + 4 * hi + 8 * rq);
    }
    __syncthreads();
    {
#pragma unroll
        for (int i = 0; i < 4; ++i) {
            const int s = wid * 16 + 4 * i + g4;
            const u32x4v w = vraw[i];
            const float a0 = gelu_fast(bflo(w.x)), a1 = gelu_fast(bfhi(w.x)), a2 = gelu_fast(bflo(w.y)), a3 = gelu_fast(bfhi(w.y)),
                        a4 = gelu_fast(bflo(w.z)), a5 = gelu_fast(bfhi(w.z)), a6 = gelu_fast(bflo(w.w)), a7 = gelu_fast(bfhi(w.w));
            const float rstd = rsqrtf(rsum16(a0 * a0 + a1 * a1 + a2 * a2 + a3 * a3 + a4 * a4 + a5 * a5 + a6 * a6 + a7 * a7) * (1.f / 128.f) + EPS);
            u32x4v o;
            o.x = pk2hw(a0 * rstd * ga.x, a1 * rstd * ga.y); o.y = pk2hw(a2 * rstd * ga.z, a3 * rstd * ga.w);
            o.z = pk2hw(a4 * rstd * gb.x, a5 * rstd * gb.y); o.w = pk2hw(a6 * rstd * gb.z, a7 * rstd * gb.w);
            *(LAS3 u32x4v*)(lds + s * MV_PITCH + l15 * 16) = o;
        }
    }
    { const int un = MIXA_UNIT(ui + 1);
      if (ui < 3) {
#pragma unroll
          for (int i = 0; i < 4; ++i) vraw[i] = *(const u32x4v*)(Z + ((size_t)(un >> 2) * 128 + wid * 16 + 4 * i + g4) * ZP0 + 512 + (un & 3) * 128 + l15 * 8);
      } }
    __syncthreads();
    f32x16 acc[2];
#pragma unroll
    for (int j = 0; j < 2; ++j)
#pragma unroll
        for (int r = 0; r < 16; ++r) acc[j][r] = 0.f;
    const unsigned va = lds0 + (8 * hi + (l15 >> 2)) * MV_PITCH + (32 * ct + 16 * (g4 & 1) + 4 * (l15 & 3)) * 2;
#pragma unroll
    for (int ks = 0; ks < 8; ++ks) {
        const s16x4 lo = lds_tr16(va + 16 * ks * MV_PITCH), hh = lds_tr16(va + (16 * ks + 4) * MV_PITCH);
        const bf16x8 vf = (bf16x8){lo[0], lo[1], lo[2], lo[3], hh[0], hh[1], hh[2], hh[3]};
#pragma unroll
        for (int j = 0; j < 2; ++j) acc[j] = __builtin_amdgcn_mfma_f32_32x32x16_bf16(vf, wfr[j][ks], acc[j], 0, 0, 0);
    }
#pragma unroll
    for (int j = 0; j < 2; ++j) {
        const int t = 32 * (tb0 + 2 * j) + r32;
        const float bias = biasj[j];
        u16* o = MIX + (row0 + t) * DM + g * 128 + 32 * ct + 4 * hi;
#pragma unroll
        for (int rq = 0; rq < 4; ++rq) {
            const uint2 uw = uraw[j][rq];
            uint2 ow;
            ow.x = pk2(gelu_fast(bflo(uw.x)) * (acc[j][4 * rq + 0] + bias), gelu_fast(bfhi(uw.x)) * (acc[j][4 * rq + 1] + bias));
            ow.y = pk2(gelu_fast(bflo(uw.y)) * (acc[j][4 * rq + 2] + bias), gelu_fast(bfhi(uw.y)) * (acc[j][4 * rq + 3] + bias));
            *(uint2*)(o + 8 * rq) = ow;
        }
    }
    }
}
#undef MIXA_UNIT
__device__ __forceinline__ void mixer_b_all(const Params& p, unsigned char* smem) {
    const int tid = tid_opaque(), lane = tid & 63, wid = __builtin_amdgcn_readfirstlane(tid >> 6), r32 = lane & 31, hi = lane >> 5;
    LAS3 unsigned char* lds = (LAS3 unsigned char*)smem;
    LAS3 unsigned char* Ps = lds + 144 * 256;
    const u16* Z = (const u16*)(p.ws + WS_Z); u16* MIX = (u16*)(p.ws + WS_MIX);
    const int dt = wid & 3, tb0 = wid >> 2;
    const int vb_ = vblock();
#define MIXB_UNIT(I) ((((vb_ & 7) * 32 + 4 * (vb_ >> 5) + (I)) << 2) | ((vb_ >> 3) & 3))
    int unit = MIXB_UNIT(0);
    u32x4v hraw[5];
#define MIXB_LOAD_HALO(UN) { const int g_ = (UN) & 3, bn_ = (UN) >> 2, n_ = bn_ & 31; \
        _Pragma("unroll") for (int i = 0; i < 5; ++i) { \
            const int idx = tid + NT * i, r = idx >> 4, c16 = idx & 15; const int tt = n_ * 128 - 16 + r; \
            hraw[i] = (u32x4v){0u, 0u, 0u, 0u}; \
            if (idx < 144 * 16 && tt >= 0) hraw[i] = *(const u32x4v*)(Z + ((size_t)bn_ * 128 - 16 + r) * ZP0 + 1024 + g_ * 128 + c16 * 8); } }
    MIXB_LOAD_HALO(unit)
    int gcur = -1;
    bf16x8 pfr[8]; float4 psc[4];
#pragma unroll 1
    for (int ui = 0; ui < 4; ++ui) {
    unit = MIXB_UNIT(ui);
    const int g = unit & 3, bn = unit >> 2, n = bn & 31;
    const size_t row0 = (size_t)bn * 128;
    const int w = 2 << g;
    if (g != gcur) {
        gcur = g;
        const u16* pwT = (const u16*)(p.ws + WS_PWT) + (size_t)g * 16384;
#pragma unroll
        for (int ks = 0; ks < 8; ++ks) pfr[ks] = *(const bf16x8*)(pwT + (32 * dt + r32) * 128 + 16 * ks + 8 * hi);
#pragma unroll
        for (int rq = 0; rq < 4; ++rq) psc[rq] = *(const float4*)(p.pool_scale + g * 128 + 32 * dt + 4 * hi + 8 * rq);
    }
    __syncthreads();
#pragma unroll
    for (int i = 0; i < 5; ++i) {
        const int idx = tid + NT * i, r = idx >> 4, c16 = idx & 15;
        if (idx < 144 * 16) *(LAS3 u32x4v*)(lds + r * 256 + c16 * 16) = hraw[i];
    }
    { const int un = MIXB_UNIT(ui + 1); if (ui < 3) MIXB_LOAD_HALO(un) }
    __syncthreads();
#pragma unroll
    for (int i = 0; i < 4; ++i) {
        const int idx = tid + NT * i, t = idx >> 4, c16 = idx & 15; const int tt = n * 128 + t;
        const int cnt = (tt + 1 < w) ? (tt + 1) : w;
        float s[8];
#pragma unroll
        for (int e = 0; e < 8; ++e) s[e] = 0.f;
        u32x4v x0 = (u32x4v){0u, 0u, 0u, 0u};
        for (int k = 0; k < w; ++k) {
            const u32x4v v = *(const LAS3 u32x4v*)(lds + (16 + t - k) * 256 + c16 * 16);
            if (k == 0) x0 = v;
            s[0] += bflo(v.x); s[1] += bfhi(v.x); s[2] += bflo(v.y); s[3] += bfhi(v.y); s[4] += bflo(v.z); s[5] += bfhi(v.z); s[6] += bflo(v.w); s[7] += bfhi(v.w);
        }
        const float ic = 1.f / (float)cnt;
        u32x4v o;
        o.x = pk2(s[0] * ic - bflo(x0.x), s[1] * ic - bfhi(x0.x)); o.y = pk2(s[2] * ic - bflo(x0.y), s[3] * ic - bfhi(x0.y));
        o.z = pk2(s[4] * ic - bflo(x0.z), s[5] * ic - bfhi(x0.z)); o.w = pk2(s[6] * ic - bflo(x0.w), s[7] * ic - bfhi(x0.w));
        *(LAS3 u32x4v*)(Ps + t * MP_PITCH + c16 * 16) = o;
    }
    __syncthreads();
    f32x16 acc[2];
#pragma unroll
    for (int j = 0; j < 2; ++j)
#pragma unroll
        for (int r = 0; r < 16; ++r) acc[j][r] = 0.f;
#pragma unroll
    for (int ks = 0; ks < 8; ++ks)
#pragma unroll
        for (int j = 0; j < 2; ++j) {
            const bf16x8 bfrag = *(const LAS3 bf16x8*)(Ps + (32 * (tb0 + 2 * j) + r32) * MP_PITCH + (16 * ks + 8 * hi) * 2);
            acc[j] = __builtin_amdgcn_mfma_f32_32x32x16_bf16(pfr[ks], bfrag, acc[j], 0, 0, 0);
        }
#pragma unroll
    for (int j = 0; j < 2; ++j) {
        const int t = 32 * (tb0 + 2 * j) + r32;
        u16* o = MIX + (row0 + t) * DM + 512 + g * 128 + 32 * dt + 4 * hi;
#pragma unroll
        for (int rq = 0; rq < 4; ++rq) {
            const float4 s4 = psc[rq];
            uint2 ow; ow.x = pk2(acc[j][4 * rq + 0] * s4.x, acc[j][4 * rq + 1] * s4.y); ow.y = pk2(acc[j][4 * rq + 2] * s4.z, acc[j][4 * rq + 3] * s4.w);
            *(uint2*)(o + 8 * rq) = ow;
        }
    }
    }
#undef MIXB_LOAD_HALO
#undef MIXB_UNIT
}

__device__ __forceinline__ void xattn_phase(const Params& p, int layer, unsigned char* smem) {
    LAS3 unsigned char* lds = (LAS3 unsigned char*)smem;
    const unsigned lds0 = (unsigned)(uintptr_t)lds;
    const u16* Q = (const u16*)(p.ws + WS_Q); const u16* KV = (const u16*)(p.ws + WS_KV) + (size_t)layer * 2048 * 2048;
    u16* MIX = (u16*)(p.ws + WS_MIX);
    for (int unit = blockIdx.x; unit < 512; unit += gridDim.x) {
        int tid = threadIdx.x; asm volatile("" : "+v"(tid));
        const int lane = tid & 63, wid = tid >> 6, r32 = lane & 31, hi = lane >> 5;
        const int qb = unit & 15, h = (unit >> 4) & 3, b = unit >> 6;
        const int m0 = b * SEQ + qb * 256 + wid * 32;
        bf16x8 qf[8];
        const u16* qrow = Q + (size_t)(m0 + r32) * DM + h * 256 + hi * 8;
#pragma unroll
        for (int ks = 0; ks < 8; ++ks) qf[ks] = *(const bf16x8*)(qrow + ks * 16);
        __syncthreads();
#pragma unroll 4
        for (int i = 0; i < 16; ++i) { const int idx = tid + 512 * i, key = idx >> 5, c = idx & 31;
            const u32x4v v = *(const u32x4v*)(KV + (size_t)(b * 256 + key) * 2048 + h * 256 + c * 8);
            *(LAS3 u32x4v*)(lds + key * XK_PITCH + c * 16) = v; }
        __syncthreads();
        f32x16 st[8];
#pragma unroll
        for (int kt = 0; kt < 8; ++kt)
#pragma unroll
            for (int r = 0; r < 16; ++r) st[kt][r] = 0.f;
#pragma unroll
        for (int dh = 0; dh < 2; ++dh) {
            if (dh == 1) {
                asm volatile("" ::: "memory");
#pragma unroll
                for (int ks = 0; ks < 8; ++ks) qf[ks] = *(const bf16x8*)(qrow + 128 + ks * 16);
            }
#pragma unroll
            for (int ks = 0; ks < 8; ++ks)
#pragma unroll
                for (int kt = 0; kt < 8; ++kt) {
                    const bf16x8 kf = *(const LAS3 bf16x8*)(lds + (32 * kt + r32) * XK_PITCH + (2 * (dh * 8 + ks) + hi) * 16);
                    st[kt] = __builtin_amdgcn_mfma_f32_32x32x16_bf16(kf, qf[ks], st[kt], 0, 0, 0);
                }
            asm volatile("" ::: "memory");
        }
        float mx = -INFINITY;
#pragma unroll
        for (int kt = 0; kt < 8; ++kt)
#pragma unroll
            for (int r = 0; r < 16; ++r) mx = fmaxf(mx, st[kt][r]);
        mx = fmaxf(mx, __shfl_xor(mx, 32));
        const float cs = 0.0625f * 1.4426950408889634f;
        float sum = 0.f; unsigned pk[8][8];
#pragma unroll
        for (int kt = 0; kt < 8; ++kt)
#pragma unroll
            for (int r = 0; r < 8; ++r) {
                const float p0 = exp2f((st[kt][2 * r] - mx) * cs), p1 = exp2f((st[kt][2 * r + 1] - mx) * cs);
                sum += p0 + p1; pk[kt][r] = pk2(p0, p1);
            }
        sum += __shfl_xor(sum, 32);
        const float inv = 1.f / sum;
        __syncthreads();
#pragma unroll 4
        for (int i = 0; i < 16; ++i) { const int idx = tid + 512 * i, key = idx >> 5, c = idx & 31;
            const u32x4v v = *(const u32x4v*)(KV + (size_t)(b * 256 + key) * 2048 + 1024 + h * 256 + c * 8);
            *(LAS3 u32x4v*)(lds + key * XV_PITCH + c * 16) = v; }
        __syncthreads();
        const unsigned vbase = lds0 + (4 * hi + ((lane & 15) >> 2)) * XV_PITCH + (2 * ((lane >> 4) & 1) + ((lane & 3) >> 1)) * 16 + 8 * (lane & 1);
#pragma unroll
        for (int half = 0; half < 2; ++half) {
            f32x16 o[4];
#pragma unroll
            for (int dt = 0; dt < 4; ++dt)
#pragma unroll
                for (int r = 0; r < 16; ++r) o[dt][r] = 0.f;
#pragma unroll
            for (int kt = 0; kt < 8; ++kt)
#pragma unroll
                for (int s = 0; s < 2; ++s) {
                    bf16x8 pf;
                    { const unsigned w0 = pk[kt][4 * s + 0], w1 = pk[kt][4 * s + 1], w2 = pk[kt][4 * s + 2], w3 = pk[kt][4 * s + 3];
                      pf[0] = (short)(w0 & 0xffff); pf[1] = (short)(w0 >> 16); pf[2] = (short)(w1 & 0xffff); pf[3] = (short)(w1 >> 16);
                      pf[4] = (short)(w2 & 0xffff); pf[5] = (short)(w2 >> 16); pf[6] = (short)(w3 & 0xffff); pf[7] = (short)(w3 >> 16); }
#pragma unroll
                    for (int dt = 0; dt < 4; ++dt) {
                        const unsigned a1 = vbase + (32 * kt + 16 * s) * XV_PITCH + (half * 4 + dt) * 64;
                        const s16x4 lo = lds_tr16(a1), hh = lds_tr16(a1 + 8 * XV_PITCH);
                        const bf16x8 vf = (bf16x8){lo[0], lo[1], lo[2], lo[3], hh[0], hh[1], hh[2], hh[3]};
                        o[dt] = __builtin_amdgcn_mfma_f32_32x32x16_bf16(vf, pf, o[dt], 0, 0, 0);
                    }
                }
            u16* orow = MIX + (size_t)(m0 + r32) * DM + h * 256 + 4 * hi;
#pragma unroll
            for (int dt = 0; dt < 4; ++dt)
#pragma unroll
                for (int rq = 0; rq < 4; ++rq) {
                    uint2 w; w.x = pk2(o[dt][4 * rq + 0] * inv, o[dt][4 * rq + 1] * inv); w.y = pk2(o[dt][4 * rq + 2] * inv, o[dt][4 * rq + 3] * inv);
                    *(uint2*)(orow + 32 * (half * 4 + dt) + 8 * rq) = w;
                }
        }
    }
}

__device__ __forceinline__ void rope_phase(const Params& p) {
    const int tid = tid_opaque(), lane = tid & 63, gw = (blockIdx.x * NT + tid) >> 6, ngw = (gridDim.x * NT) >> 6;
    u16* Z = (u16*)(p.ws + WS_Z); const float2* rope = (const float2*)(p.ws + WS_ROPE);
    u16* KB = (u16*)(p.ws + WS_KB); u16* VB = (u16*)(p.ws + WS_VB); u16* KI = (u16*)(p.ws + WS_KI);
    for (int m = gw; m < T; m += ngw) {
        u16* zr = Z + (size_t)m * ZP1;
        const float2 cs = rope[(size_t)m * 64 + lane];
#pragma unroll
        for (int hd = 0; hd < 8; ++hd) {
            const float x1 = bf2f(zr[hd * 128 + lane]), x2 = bf2f(zr[hd * 128 + 64 + lane]);
            zr[hd * 128 + lane] = f2bf(x1 * cs.x - x2 * cs.y); zr[hd * 128 + 64 + lane] = f2bf(x2 * cs.x + x1 * cs.y);
        }
        { const float x1 = bf2f(zr[1024 + lane]), x2 = bf2f(zr[1088 + lane]);
          KB[(size_t)m * 128 + lane] = f2bf(x1 * cs.x - x2 * cs.y); KB[(size_t)m * 128 + 64 + lane] = f2bf(x2 * cs.x + x1 * cs.y); }
        *(unsigned*)(VB + (size_t)m * 128 + 2 * lane) = *(const unsigned*)(zr + 1152 + 2 * lane);
#pragma unroll
        for (int i = 0; i < 4; ++i) {
            const int pp = lane + 64 * i, hd = pp >> 5, jj = pp & 31;
            const float2 c2 = rope[(size_t)m * 64 + 2 * jj];
            const float x1 = bf2f(zr[1280 + hd * 64 + jj]), x2 = bf2f(zr[1280 + hd * 64 + 32 + jj]);
            zr[1280 + hd * 64 + jj] = f2bf(x1 * c2.x - x2 * c2.y); zr[1280 + hd * 64 + 32 + jj] = f2bf(x2 * c2.x + x1 * c2.y);
        }
        if (lane < 32) {
            const float2 c2 = rope[(size_t)m * 64 + 2 * lane];
            const float x1 = bf2f(zr[1792 + lane]), x2 = bf2f(zr[1824 + lane]);
            const int s = m & 4095, bb = m >> 12;
            u16* kt = KI + ((size_t)bb * 128 + (s >> 5)) * 2048 + (s & 31) * 8;
            const int d1 = lane, d2 = lane + 32;
            kt[((d1 >> 4) * 2 + ((d1 >> 3) & 1)) * 256 + (d1 & 7)] = f2bf(x1 * c2.x - x2 * c2.y);
            kt[((d2 >> 4) * 2 + ((d2 >> 3) & 1)) * 256 + (d2 & 7)] = f2bf(x2 * c2.x + x1 * c2.y);
        }
        if (lane < 8) zr[1856 + lane] = f2bf(bf2f(zr[1856 + lane]) * 0.35355339059327373f);
    }
}

typedef float f32x4v __attribute__((ext_vector_type(4)));
constexpr int VB_PITCH = 288, KB_PITCH = 272, CAND_CAP = 256, NBIN = 512;
__device__ __forceinline__ int score_bin(float sc) { const int b = (int)floorf(sc * 64.f) + 256; return b < 0 ? 0 : (b > 511 ? 511 : b); }
__device__ __forceinline__ unsigned score_key(unsigned f) { f = __float_as_uint(__uint_as_float(f) + 0.0f); return (f & 0x80000000u) ? ~f : (f | 0x80000000u); }
__device__ __forceinline__ float minscore_for_bin(int B) { return (B <= 0) ? -INFINITY : (float)(B - 256) * 0.015625f; }
__device__ __forceinline__ unsigned minkey_for_bin(int B) {
    if (B <= 0) return 0u;
    const unsigned f = __float_as_uint((float)(B - 256) * 0.015625f);
    return (f & 0x80000000u) ? ~f : (f | 0x80000000u);
}
#define ZERO_HIST(h, ln) do { _Pragma("unroll") for (int z_ = 0; z_ < 8; ++z_) (h)[(ln) * 8 + z_] = 0u; } while (0)
__device__ __forceinline__ int wave_iscan(int v) {
    v += __builtin_amdgcn_update_dpp(0, v, 0x111, 0xf, 0xf, false);
    v += __builtin_amdgcn_update_dpp(0, v, 0x112, 0xf, 0xf, false);
    v += __builtin_amdgcn_update_dpp(0, v, 0x114, 0xf, 0xf, false);
    v += __builtin_amdgcn_update_dpp(0, v, 0x118, 0xf, 0xf, false);
    v += __builtin_amdgcn_update_dpp(0, v, 0x142, 0xa, 0xf, false);
    v += __builtin_amdgcn_update_dpp(0, v, 0x143, 0xc, 0xf, false);
    return v;
}
__device__ __forceinline__ float relu_i(float x) { const int b = __float_as_int(x); return __int_as_float(b > 0 ? b : 0); }
__device__ __forceinline__ void dsa_phase(const Params& p, unsigned char* smem) {
    LAS3 unsigned char* lds = (LAS3 unsigned char*)smem;
    const u16* Z = (const u16*)(p.ws + WS_Z); u16* MIX = (u16*)(p.ws + WS_MIX);
    const u16* KB = (const u16*)(p.ws + WS_KB); const u16* VB = (const u16*)(p.ws + WS_VB); const u16* KI = (const u16*)(p.ws + WS_KI);
    { const int t0_ = tid_opaque(); LAS3 unsigned* h0 = (LAS3 unsigned*)(lds + 131072 + (t0_ >> 6) * 3072 + 512);
      ZERO_HIST(h0, t0_ & 63); }
    for (int U = vblock(); U < 4096; U += 256) {
        const int tid = tid_opaque(), lane = tid & 63, wid = __builtin_amdgcn_readfirstlane(tid >> 6);
        const int r32 = lane & 31, hi = lane >> 5, l15 = lane & 15, g4 = lane >> 4;
        LAS3 unsigned* sck_all = (LAS3 unsigned*)lds;
        LAS3 unsigned* sck = sck_all + wid * 4096;
        LAS3 unsigned char* aux = lds + 131072 + wid * 3072;
        LAS3 u16* idx = (LAS3 u16*)aux; LAS3 unsigned* hist = (LAS3 unsigned*)(aux + 512); LAS3 u16* cand = (LAS3 u16*)(aux + 2560);
        LAS3 unsigned char* vbuf = (LAS3 unsigned char*)sck;
        const unsigned vb0 = (unsigned)(uintptr_t)vbuf + (4 * g4 + (l15 >> 2)) * VB_PITCH + 8 * (l15 & 3);
        const unsigned long long lt_mask = (lane == 0) ? 0ull : (~0ull >> (64 - lane));
        const int uj = U >> 8, uc = U & 255, b = uc & 7, uy = uc >> 3;
        const int t0 = 8 * (32 * uj + ((uj & 1) ? 31 - uy : uy));
        const size_t brow = (size_t)b * SEQ;
        bf16x8 qif[2][4]; uint2 wqw[2][4];
        {   const int tq0 = (t0 >= 256) ? t0 : 256;
#pragma unroll
            for (int rt = 0; rt < 2; ++rt) {
                const u16* zr = Z + (brow + tq0 + 4 * rt + (r32 >> 3)) * ZP1 + 1280 + (r32 & 7) * 64 + 8 * hi;
#pragma unroll
                for (int ks = 0; ks < 4; ++ks) qif[rt][ks] = *(const bf16x8*)(zr + 16 * ks);
#pragma unroll
                for (int qq = 0; qq < 4; ++qq) wqw[rt][qq] = *(const uint2*)(Z + (brow + tq0 + 4 * rt + qq) * ZP1 + 1856 + 4 * hi);
            }
        }
        __syncthreads();
        for (int rep_s = 0; rep_s < (DSA_DUP == 1 ? 2 : 1); ++rep_s)
        if (t0 >= 256) {
            if (rep_s == 1) { __syncthreads(); ZERO_HIST(hist, lane); __syncthreads(); }
            float wq[2][16];
#pragma unroll
            for (int rt = 0; rt < 2; ++rt)
#pragma unroll
                for (int qq = 0; qq < 4; ++qq) {
                    const uint2 w = wqw[rt][qq];
                    wq[rt][4 * qq + 0] = 0.125f * bflo(w.x); wq[rt][4 * qq + 1] = 0.125f * bfhi(w.x);
                    wq[rt][4 * qq + 2] = 0.125f * bflo(w.y); wq[rt][4 * qq + 3] = 0.125f * bfhi(w.y);
                }
            const int ntile = (t0 + 8 + 31) >> 5;
            bf16x8 kif[4], kn1[4];
            {
                const u16* kr = KI + ((size_t)b * 128 + wid) * 2048 + hi * 256 + r32 * 8;
#pragma unroll
                for (int ks = 0; ks < 4; ++ks) kif[ks] = *(const bf16x8*)(kr + 512 * ks);
                const int kt1 = (wid + 8 < ntile) ? wid + 8 : wid;
                const u16* kr1 = KI + ((size_t)b * 128 + kt1) * 2048 + hi * 256 + r32 * 8;
#pragma unroll
                for (int ks = 0; ks < 4; ++ks) kn1[ks] = *(const bf16x8*)(kr1 + 512 * ks);
            }
#define SCORE_STEP(CUR, DST) { \
                { const int ktn = (kt + 16 < ntile) ? kt + 16 : kt; \
                  const u16* kr = KI + ((size_t)b * 128 + ktn) * 2048 + hi * 256 + r32 * 8; \
                  _Pragma("unroll") for (int ks = 0; ks < 4; ++ks) DST[ks] = *(const bf16x8*)(kr + 512 * ks); } \
                f32x16 c0, c1; \
                _Pragma("unroll") \
                for (int r = 0; r < 16; ++r) { c0[r] = 0.f; c1[r] = 0.f; } \
                _Pragma("unroll") \
                for (int ks = 0; ks < 4; ++ks) { \
                    c0 = __builtin_amdgcn_mfma_f32_32x32x16_bf16(qif[0][ks], CUR[ks], c0, 0, 0, 0); \
                    c1 = __builtin_amdgcn_mfma_f32_32x32x16_bf16(qif[1][ks], CUR[ks], c1, 0, 0, 0); \
                } \
                _Pragma("unroll") \
                for (int qq = 0; qq < 4; ++qq) { \
                    float pa = 0.f, pb = 0.f; \
                _Pragma("unroll") \
                    for (int e = 0; e < 4; ++e) { pa = fmaf(relu_i(c0[4 * qq + e]), wq[0][4 * qq + e], pa); pb = fmaf(relu_i(c1[4 * qq + e]), wq[1][4 * qq + e], pb); } \
                    const auto rr = __builtin_amdgcn_permlane32_swap(__float_as_uint(pa), __float_as_uint(pb), false, false); \
                    const float sc = __uint_as_float(rr[0]) + __uint_as_float(rr[1]);     \
                    sck_all[(4 * hi + qq) * 4096 + 32 * kt + r32] = __float_as_uint(sc);     \
 \
 \
                    { const bool vis = (32 * kt + 31 <= t0) || (32 * kt + r32 <= t0 + 4 * hi + qq); \
                      LAS3 unsigned* hq = (LAS3 unsigned*)(lds + 131072 + (4 * hi + qq) * 3072 + 512) + score_bin(sc); \
                      __hip_atomic_fetch_add(vis ? hq : (LAS3 unsigned*)(lds + LDS_CTL_OFF + 56), 1u, __ATOMIC_RELAXED, __HIP_MEMORY_SCOPE_WORKGROUP); } \
                } \
                kt += 8; if (kt >= ntile) break; }
            bf16x8 kn2[4];
            for (int kt = wid;;) { SCORE_STEP(kif, kn2) SCORE_STEP(kn1, kif) SCORE_STEP(kn2, kn1) }
#undef SCORE_STEP
        }
        __syncthreads();
        const int t = t0 + wid, n = t + 1;
        const size_t m = brow + t;
        bf16x8 qf[4];
#pragma unroll
        for (int ks = 0; ks < 4; ++ks) {
            qf[ks] = (bf16x8){0, 0, 0, 0, 0, 0, 0, 0};
            if (l15 < 8) qf[ks] = *(const bf16x8*)(Z + m * ZP1 + l15 * 128 + 32 * ks + 8 * g4);
        }
        int count;
        for (int rep_t = 0; rep_t < (DSA_DUP == 2 ? 2 : 1); ++rep_t)
        if (n <= 256) {
            count = n;
            for (int j = lane; j < 256; j += 64) idx[j] = (u16)(j < n ? j : 0);
        } else {
            count = 256;
            int bdig, bwant, bcnt;
            {
                int cb_[8]; int tot = 0;
                { const u32x4v h0v = *(const LAS3 u32x4v*)(hist + lane * 8), h1v = *(const LAS3 u32x4v*)(hist + lane * 8 + 4);
                  cb_[0] = (int)h0v.x; cb_[1] = (int)h0v.y; cb_[2] = (int)h0v.z; cb_[3] = (int)h0v.w; cb_[4] = (int)h1v.x; cb_[5] = (int)h1v.y; cb_[6] = (int)h1v.z; cb_[7] = (int)h1v.w; }
#pragma unroll
                for (int z = 0; z < 8; ++z) tot += cb_[z];
                const int P_ = wave_iscan(tot);
                const int S = __builtin_amdgcn_readlane(P_, 63) - P_ + tot;
                const int above = S - tot;
                const bool ok = (above < 256) && (256 <= S);
                int dig = 0, nw = 0, hb = 0;
                if (ok) {
                    int cum = above; bool found = false;
#pragma unroll
                    for (int z = 7; z >= 0; --z) { if (!found) { if (cum + cb_[z] >= 256) { dig = lane * 8 + z; nw = 256 - cum; hb = cb_[z]; found = true; } else cum += cb_[z]; } }
                }
                const unsigned long long bal = __ballot(ok);
                const int src = (int)__ffsll((long long)bal) - 1;
                bdig = __shfl(dig, src); bwant = __shfl(nw, src); bcnt = __shfl(hb, src);
            }
            if (bcnt == bwant || bcnt <= CAND_CAP) {
                const int tb = (bcnt == bwant) ? bdig : bdig + 1;
                const float klo = minscore_for_bin(tb), khi = minscore_for_bin(bdig);
                const bool any_take = tb < NBIN, want_cand = tb != bdig;
                LAS3 unsigned long long* tmask = (LAS3 unsigned long long*)hist; LAS3 unsigned long long* cmask = tmask + 64;
                const int ntrip = (n + 255) >> 8;
                const float klo_ = any_take ? klo : INFINITY, khi_ = want_cand ? khi : klo_;
                const int nfull = n >> 8;
                for (int it = 0; it < nfull; ++it) {
                    const u32x4v k4 = *(const LAS3 u32x4v*)(sck + 256 * it + 4 * lane);
                    unsigned long long bt[4], bc[4];
#pragma unroll
                    for (int e = 0; e < 4; ++e) { bt[e] = __builtin_amdgcn_ballot_w64(__uint_as_float(k4[e]) >= klo_); bc[e] = __builtin_amdgcn_ballot_w64(__uint_as_float(k4[e]) >= khi_) & ~bt[e]; }
                    if (lane == 0) {
#pragma unroll
                        for (int e = 0; e < 4; ++e) { tmask[4 * it + e] = bt[e]; cmask[4 * it + e] = bc[e]; }
                    }
                }
                if (nfull < ntrip) {
                    const int it = nfull;
                    const u32x4v k4 = *(const LAS3 u32x4v*)(sck + 256 * it + 4 * lane);
                    unsigned long long bt[4], bc[4];
#pragma unroll
                    for (int e = 0; e < 4; ++e) { const bool in = 256 * it + 4 * lane + e < n;
                        bt[e] = __builtin_amdgcn_ballot_w64(in && __uint_as_float(k4[e]) >= klo_); bc[e] = __builtin_amdgcn_ballot_w64(in && __uint_as_float(k4[e]) >= khi_) & ~bt[e]; }
                    if (lane == 0) {
#pragma unroll
                        for (int e = 0; e < 4; ++e) { tmask[4 * it + e] = bt[e]; cmask[4 * it + e] = bc[e]; }
                    }
                }
                WAVE_SYNC();
                int base;
                {
                    const bool hasw = lane < 4 * ntrip;
                    unsigned long long tw = hasw ? tmask[lane] : 0ull, cw = hasw ? cmask[lane] : 0ull;
                    const int key0 = 256 * (lane >> 2) + (lane & 3);
                    int ct = __popcll(tw), cc = __popcll(cw);
                    const int st_ = wave_iscan(ct), sc_ = wave_iscan(cc);
                    base = __builtin_amdgcn_readlane(st_, 63);
                    int pt = st_ - ct, pc = sc_ - cc;
                    while (tw) { const int bb = __builtin_ctzll(tw); tw &= tw - 1; if (pt < 256) idx[pt] = (u16)(key0 + 4 * bb); ++pt; }
                    while (cw) { const int bb = __builtin_ctzll(cw); cw &= cw - 1; if (pc < CAND_CAP) cand[pc] = (u16)(key0 + 4 * bb); ++pc; }
                }
                if (tb != bdig) {
                    WAVE_SYNC();
                    if (bcnt <= 64) {
                        const bool in = lane < bcnt;
                        const int si = in ? (int)cand[lane] : 0; const float kk = in ? __uint_as_float(sck[si]) : 0.f;
                        int rank = 0;
                        for (int j = 0; j < bcnt; ++j) {
                            const float kj = __int_as_float(__builtin_amdgcn_readlane(__float_as_int(kk), j)); const int sj = __builtin_amdgcn_readlane(si, j);
                            rank += (kj > kk || (kj == kk && sj < si)) ? 1 : 0;
                        }
                        const bool take = in && (rank < bwant);
                        const unsigned long long bt = __ballot(take);
                        const int pos = base + __popcll(bt & lt_mask);
                        if (take && pos < 256) idx[pos] = (u16)si;
                        base += __popcll(bt);
                    } else
                    for (int i0 = 0; i0 < bcnt; i0 += 64) {
                        const int i = i0 + lane; const bool in = i < bcnt;
                        const int si = in ? (int)cand[i] : 0; const float kk = __uint_as_float(sck[si]);
                        int rank = 0;
                        for (int j = 0; j < bcnt; ++j) { const int sj = (int)cand[j]; const float kj = __uint_as_float(sck[sj]); rank += (kj > kk || (kj == kk && sj < si)) ? 1 : 0; }
                        const bool take = in && (rank < bwant);
                        const unsigned long long bt = __ballot(take);
                        const int pos = base + __popcll(bt & lt_mask);
                        if (take && pos < 256) idx[pos] = (u16)si;
                        base += __popcll(bt);
                    }
                }
            } else {
            unsigned prefix = 0u, mask = 0u; int want = 256;
            for (int pass = 0; pass < 4; ++pass) {
                const int shift = 24 - 8 * pass;
                hist[lane * 4 + 0] = 0u; hist[lane * 4 + 1] = 0u; hist[lane * 4 + 2] = 0u; hist[lane * 4 + 3] = 0u;
                WAVE_SYNC();
                for (int s = lane; s < n; s += 64) { const unsigned k = score_key(sck[s]); if ((k & mask) == prefix) __hip_atomic_fetch_add(&hist[(k >> shift) & 255u], 1u, __ATOMIC_RELAXED, __HIP_MEMORY_SCOPE_WORKGROUP); }
                WAVE_SYNC();
                const int c0 = (int)hist[lane * 4 + 0], c1 = (int)hist[lane * 4 + 1], c2 = (int)hist[lane * 4 + 2], c3 = (int)hist[lane * 4 + 3];
                const int tot = c0 + c1 + c2 + c3;
                int S = tot;
#pragma unroll
                for (int o = 1; o < 64; o <<= 1) { const int v = __shfl_down(S, o); if (lane + o < 64) S += v; }
                const int above = S - tot;
                const bool ok = (above < want) && (want <= S);
                int dig = 0, nw = 0;
                if (ok) {
                    int cum = above;
                    if (cum + c3 >= want) { dig = lane * 4 + 3; nw = want - cum; }
                    else { cum += c3;
                        if (cum + c2 >= want) { dig = lane * 4 + 2; nw = want - cum; }
                        else { cum += c2;
                            if (cum + c1 >= want) { dig = lane * 4 + 1; nw = want - cum; }
                            else { cum += c1; dig = lane * 4; nw = want - cum; } } }
                }
                const unsigned long long bal = __ballot(ok);
                const int src = (int)__ffsll((long long)bal) - 1;
                dig = __shfl(dig, src); nw = __shfl(nw, src);
                prefix |= ((unsigned)dig) << shift; mask |= 255u << shift; want = nw;
                WAVE_SYNC();
            }
            int base = 0, eqt = 0;
            for (int s0 = 0; s0 < n; s0 += 64) {
                const int s = s0 + lane; const bool in = s < n;
                const unsigned k = in ? score_key(sck[s]) : 0u;
                const bool gt = in && (k > prefix), eq = in && (k == prefix);
                const unsigned long long beq = __ballot(eq);
                const int rank = eqt + __popcll(beq & lt_mask);
                const bool take = gt || (eq && rank < want);
                const unsigned long long bt = __ballot(take);
                const int pos = base + __popcll(bt & lt_mask);
                if (take && pos < 256) idx[pos] = (u16)s;
                base += __popcll(bt); eqt += __popcll(beq);
            }
            }
            WAVE_SYNC();
            if (rep_t == (DSA_DUP == 2 ? 1 : 0)) { ZERO_HIST(hist, lane); }
        }
        WAVE_SYNC();
        for (int rep_a = 0; rep_a < (DSA_DUP == 3 ? 2 : 1); ++rep_a) {
        f32x4v st[16];
#pragma unroll
        for (int kt = 0; kt < 16; ++kt) st[kt] = (f32x4v){0.f, 0.f, 0.f, 0.f};
        f32x4v ot[8];
#pragma unroll
        for (int dt = 0; dt < 8; ++dt) ot[dt] = (f32x4v){0.f, 0.f, 0.f, 0.f};
        const float lsc = 0.08838834764831845f * 1.4426950408889634f;
        float inv;
#define DSA_GATHER(REG, SRC, C)                                                                                     \
        { const u32x4v iv = *(const LAS3 u32x4v*)(idx + 32 * (C) + 8 * g4);                                         \
          _Pragma("unroll") for (int i = 0; i < 8; ++i) {                                                           \
              const int ki = (int)((iv[i >> 1] >> (16 * (i & 1))) & 0xffffu);                                       \
              REG[i] = *(const u32x4v*)(SRC + (brow + ki) * 128 + l15 * 8); } }
#define DSA_KCHUNK(REG, C)                                                                                          \
        { WAVE_SYNC();                                                                                              \
          _Pragma("unroll") for (int i = 0; i < 8; ++i) *(LAS3 u32x4v*)(vbuf + (8 * g4 + i) * KB_PITCH + l15 * 16) = REG[i]; \
          WAVE_SYNC();                                                                                              \
          _Pragma("unroll") for (int a = 0; a < 2; ++a)                                                             \
          _Pragma("unroll") for (int ks = 0; ks < 4; ++ks) {                                                        \
              const bf16x8 kf = *(const LAS3 bf16x8*)(vbuf + (16 * a + l15) * KB_PITCH + (32 * ks + 8 * g4) * 2);   \
              st[2 * (C) + a] = __builtin_amdgcn_mfma_f32_16x16x32_bf16(kf, qf[ks], st[2 * (C) + a], 0, 0, 0); } }
#define DSA_VCHUNK(REG, C)                                                                                          \
        { WAVE_SYNC();                                                                                              \
          _Pragma("unroll") for (int i = 0; i < 8; ++i) *(LAS3 u32x4v*)(vbuf + (8 * g4 + i) * VB_PITCH + l15 * 16) = REG[i]; \
          WAVE_SYNC();                                                                                              \
          bf16x8 pf;                                                                                                \
          { const unsigned w0 = pk2hw(st[2 * (C)][0], st[2 * (C)][1]), w1 = pk2hw(st[2 * (C)][2], st[2 * (C)][3]),  \
                           w2 = pk2hw(st[2 * (C) + 1][0], st[2 * (C) + 1][1]), w3 = pk2hw(st[2 * (C) + 1][2], st[2 * (C) + 1][3]); \
            pf[0] = (short)(w0 & 0xffff); pf[1] = (short)(w0 >> 16); pf[2] = (short)(w1 & 0xffff); pf[3] = (short)(w1 >> 16); \
            pf[4] = (short)(w2 & 0xffff); pf[5] = (short)(w2 >> 16); pf[6] = (short)(w3 & 0xffff); pf[7] = (short)(w3 >> 16); } \
          _Pragma("unroll") for (int dt = 0; dt < 8; ++dt) {                                                        \
              const s16x4 lo = lds_tr16(vb0 + dt * 32), hh = lds_tr16(vb0 + dt * 32 + 16 * VB_PITCH);              \
              const bf16x8 vf = (bf16x8){lo[0], lo[1], lo[2], lo[3], hh[0], hh[1], hh[2], hh[3]};                   \
              ot[dt] = __builtin_amdgcn_mfma_f32_16x16x32_bf16(vf, pf, ot[dt], 0, 0, 0); } }
#define DSA_EXPSUM()                                                                                                \
        { mx = fmaxf(mx, __shfl_xor(mx, 16)); mx = fmaxf(mx, __shfl_xor(mx, 32));                                   \
          float sum = 0.f;                                                                                          \
          _Pragma("unroll") for (int kt = 0; kt < 16; ++kt)                                                         \
          _Pragma("unroll") for (int r = 0; r < 4; ++r) { const float e = __builtin_amdgcn_exp2f(st[kt][r] - mx); st[kt][r] = e; sum += e; } \
          sum += __shfl_xor(sum, 16); sum += __shfl_xor(sum, 32);                                                   \
          inv = 1.f / sum; }
        if (count == 256) {
            u32x4v ring[2][2][8];
            DSA_GATHER(ring[0][0], KB, 0) DSA_GATHER(ring[0][1], KB, 1)
#pragma unroll
            for (int s = 0; s < 4; ++s) {
                if (s < 3) { DSA_GATHER(ring[(s + 1) & 1][0], KB, 2 * s + 2) DSA_GATHER(ring[(s + 1) & 1][1], KB, 2 * s + 3) }
                DSA_KCHUNK(ring[s & 1][0], 2 * s) DSA_KCHUNK(ring[s & 1][1], 2 * s + 1)
            }
            DSA_GATHER(ring[0][0], VB, 0) DSA_GATHER(ring[0][1], VB, 1)
            float mx = -INFINITY;
#pragma unroll
            for (int kt = 0; kt < 16; ++kt)
#pragma unroll
                for (int r = 0; r < 4; ++r) { const float v = st[kt][r] * lsc; st[kt][r] = v; mx = fmaxf(mx, v); }
            DSA_EXPSUM()
#pragma unroll
            for (int s = 0; s < 4; ++s) {
                if (s < 3) { DSA_GATHER(ring[(s + 1) & 1][0], VB, 2 * s + 2) DSA_GATHER(ring[(s + 1) & 1][1], VB, 2 * s + 3) }
                DSA_VCHUNK(ring[s & 1][0], 2 * s) DSA_VCHUNK(ring[s & 1][1], 2 * s + 1)
            }
        } else {
#pragma unroll 1
            for (int c = 0; 32 * c < count; ++c) {
                u32x4v kreg[8];
                DSA_GATHER(kreg, KB, c)
                WAVE_SYNC();
#pragma unroll
                for (int i = 0; i < 8; ++i) *(LAS3 u32x4v*)(vbuf + (8 * g4 + i) * KB_PITCH + l15 * 16) = kreg[i];
                WAVE_SYNC();
                f32x4v s0 = (f32x4v){0.f, 0.f, 0.f, 0.f}, s1 = (f32x4v){0.f, 0.f, 0.f, 0.f};
#pragma unroll
                for (int ks = 0; ks < 4; ++ks) {
                    const bf16x8 kf0 = *(const LAS3 bf16x8*)(vbuf + l15 * KB_PITCH + (32 * ks + 8 * g4) * 2);
                    const bf16x8 kf1 = *(const LAS3 bf16x8*)(vbuf + (16 + l15) * KB_PITCH + (32 * ks + 8 * g4) * 2);
                    s0 = __builtin_amdgcn_mfma_f32_16x16x32_bf16(kf0, qf[ks], s0, 0, 0, 0);
                    s1 = __builtin_amdgcn_mfma_f32_16x16x32_bf16(kf1, qf[ks], s1, 0, 0, 0);
                }
#pragma unroll
                for (int cs = 0; cs < 8; ++cs) if (c == cs) { st[2 * cs] = s0; st[2 * cs + 1] = s1; }
            }
            float mx = -INFINITY;
#pragma unroll
            for (int kt = 0; kt < 16; ++kt)
#pragma unroll
                for (int r = 0; r < 4; ++r) { const int j = 16 * kt + 4 * g4 + r; const float v = (j < count) ? st[kt][r] * lsc : -INFINITY; st[kt][r] = v; mx = fmaxf(mx, v); }
            DSA_EXPSUM()
#pragma unroll
            for (int c = 0; c < 8; ++c) {
                if (32 * c < count) {
                    u32x4v vreg[8];
                    DSA_GATHER(vreg, VB, c)
                    DSA_VCHUNK(vreg, c)
                }
            }
        }
#undef DSA_GATHER
#undef DSA_KCHUNK
#undef DSA_VCHUNK
#undef DSA_EXPSUM
        if (l15 < 8) {
            u16* orow = MIX + m * DM + l15 * 128 + 4 * g4;
#pragma unroll
            for (int dt = 0; dt < 8; ++dt) {
                uint2 w; w.x = pk2hw(ot[dt][0] * inv, ot[dt][1] * inv); w.y = pk2hw(ot[dt][2] * inv, ot[dt][3] * inv);
                *(uint2*)(orow + 16 * dt) = w;
            }
        }
        }
    }
}

#define XB_TMO      128
#define XB_XCNT(j)  (256  + 64 * (j))
#define XB_XSUB(j)  (1280 + 64 * (j))
#define XB_XGEN(j)  (2304 + 64 * (j))
#define XB_TOP      3328
#define XB_TOPGEN   3392
#define XCD_BAR_WORDS 3456
#define XB_SPIN_CAP (1u << 18)

__device__ __forceinline__ unsigned xb_ld(unsigned* p)              { return __hip_atomic_load(p, __ATOMIC_RELAXED, __HIP_MEMORY_SCOPE_AGENT); }
__device__ __forceinline__ unsigned xb_add(unsigned* p, unsigned v) { return __hip_atomic_fetch_add(p, v, __ATOMIC_RELAXED, __HIP_MEMORY_SCOPE_AGENT); }
__device__ __forceinline__ unsigned xb_xcc_id() { return (unsigned)__builtin_amdgcn_s_getreg((3 << 11) | 20) & 0xFu; }
#define XB_SPIN(cond, bar) do { unsigned _sp = 0; while (cond) { __builtin_amdgcn_s_sleep(1); \
    if ((++_sp & 255u) == 0u) { if (xb_ld(&(bar)[XB_TMO])) break; if (_sp > XB_SPIN_CAP) { atomicAdd(&(bar)[XB_TMO], 1u); break; } } } } while (0)

struct XcdBarrier {
    unsigned* bar; unsigned x;
    volatile __attribute__((address_space(3))) unsigned* st;
};

__device__ __forceinline__ XcdBarrier xcd_barrier_post(unsigned* bar, volatile __attribute__((address_space(3))) unsigned* st) {
    XcdBarrier b; b.bar = bar; b.x = xb_xcc_id(); b.st = st;
    if (threadIdx.x == 0) st[4] = xb_add(&bar[XB_XCNT(b.x)], 1u);
    return b;
}
__device__ __forceinline__ void xcd_barrier_complete(unsigned* bar, unsigned x, unsigned& nloc, unsigned& nx, unsigned& uniform) {
    const unsigned G = gridDim.x * gridDim.y * gridDim.z;
    unsigned sum, cnt, mine, sp = 0u, uni = 0u;
    for (;;) {
        sum = 0u; cnt = 0u; mine = 0u; uni = (G == 256u) ? 1u : 0u;
#pragma unroll
        for (unsigned j = 0; j < 16; ++j) { const unsigned c = xb_ld(&bar[XB_XCNT(j)]); sum += c; cnt += (c > 0u) ? 1u : 0u; mine = (j == x) ? c : mine; uni = (c == (j < 8u ? 32u : 0u)) ? uni : 0u; }
        if (sum == G) break;
        uni = 0u;
        __builtin_amdgcn_s_sleep(1);
        if ((++sp & 255u) == 0u) { if (xb_ld(&bar[XB_TMO])) break; if (sp > XB_SPIN_CAP) { atomicAdd(&bar[XB_TMO], 1u); break; } }
    }
    nloc = mine > 0u ? mine : 1u; nx = cnt > 0u ? cnt : 1u; uniform = uni;
}

__device__ __forceinline__ void xcd_barrier(const XcdBarrier& b, bool allow_local = false) {
    asm volatile("s_waitcnt vmcnt(0)" ::: "memory");
    __syncthreads();
    if (threadIdx.x == 0) {
        unsigned* bar = b.bar;
        __builtin_amdgcn_s_waitcnt(0);
        unsigned nloc = b.st[0], nx = b.st[1];
        if (nloc == 0u) { unsigned uni; xcd_barrier_complete(bar, b.x, nloc, nx, uni); b.st[0] = nloc; b.st[1] = nx;
                          b.st[2] = uni ? (b.st[4] * 8u + b.x) : blockIdx.x; b.st[3] = uni; }
        const bool local = allow_local && (b.st[3] != 0u);
        const unsigned old = xb_add(&bar[XB_XSUB(b.x)], 1u);
        const unsigned gen = old / nloc;
        if (old + 1u == (gen + 1u) * nloc) {
            if (!local) {
            __builtin_amdgcn_fence(__ATOMIC_RELEASE, "agent");
            asm volatile("s_waitcnt vmcnt(0)" ::: "memory");
            const unsigned og = xb_add(&bar[XB_TOP], 1u);
            const unsigned tg = og / nx;
            if (og + 1u == (tg + 1u) * nx) xb_add(&bar[XB_TOPGEN], 1u);
            else XB_SPIN(xb_ld(&bar[XB_TOPGEN]) == tg, bar);
            }
            __builtin_amdgcn_fence(__ATOMIC_ACQUIRE, "agent");
            xb_add(&bar[XB_XGEN(b.x)], 1u);
            asm volatile("s_waitcnt vmcnt(0)" ::: "memory");
        } else {
            XB_SPIN(xb_ld(&bar[XB_XGEN(b.x)]) == gen, bar);
            __builtin_amdgcn_fence(__ATOMIC_ACQUIRE, "agent");
            asm volatile("s_waitcnt vmcnt(0)" ::: "memory");
        }
    }
    __syncthreads();
}

__device__ __forceinline__ void xattn_precompute(const Params& p, int l, unsigned char* smem) {
    const u16* KV = (const u16*)(p.ws + WS_KV);
    const int half = (int)gridDim.x >> 1;
    const int vb_ = vblock(), rk_ = vb_ >> 3;
    if (rk_ < 16) {
        pg8::Gemm g{KV, (const u16*)(p.ws + WS_WQ), 256, 1024, 256, 2048, 1024}; PreOrder<0> S{vb_ & 7, rk_, l};
        EpiStore E{(u16*)(p.ws + WS_BT1), 1024, 0, nullptr};
        pg8::gemm_phase<EpiStore, PreOrder<0>, true, true>((PG8_LAS unsigned char*)smem, g, S, E); }
    else {
        pg8::Gemm g{(const u16*)(p.ws + WS_WO), KV, 1024, 256, 256, 1024, 2048}; PreOrder<1> S{vb_ & 7, rk_ - 16, l};
        EpiStore E{(u16*)(p.ws + WS_BT2), 1024, 0, nullptr};
        pg8::gemm_phase<EpiStore, PreOrder<1>, true, true>((PG8_LAS unsigned char*)smem, g, S, E); }
}

typedef const __attribute__((address_space(4))) Params* KParams;
template <int PH> __device__ __forceinline__ void run_phase(unsigned char* smem) {
    constexpr int ph = PH;
#if defined(__HIP_DEVICE_COMPILE__)
    KParams kp = (KParams)__builtin_amdgcn_kernarg_segment_ptr(); asm volatile("" : "+s"(kp));
    Params p;
    p.x = kp->x; p.mem = kp->mem; p.pos = kp->pos; p.gains = kp->gains; p.wq = kp->wq; p.wkv = kp->wkv; p.wo = kp->wo; p.w1 = kp->w1; p.w2 = kp->w2;
    p.ev_w_in = kp->ev_w_in; p.sgu_g = kp->sgu_g; p.sgu_ws = kp->sgu_ws; p.sgu_bs = kp->sgu_bs; p.pool_w = kp->pool_w; p.pool_scale = kp->pool_scale;
    p.ev_w_out = kp->ev_w_out; p.od_w_in = kp->od_w_in; p.od_w_out = kp->od_w_out; p.out = kp->out; p.ws = kp->ws;
#else
    Params p{};
#endif
    u16* HN = (u16*)(p.ws + WS_HN); u16* Y = (u16*)(p.ws + WS_Y); u16* Z = (u16*)(p.ws + WS_Z); u16* MIX = (u16*)(p.ws + WS_MIX);
    u16* Qb = (u16*)(p.ws + WS_Q); u16* HID = (u16*)(p.ws + WS_HID); u16* MEMN = (u16*)(p.ws + WS_MEMN); u16* KV = (u16*)(p.ws + WS_KV); float* RS = (float*)(p.ws + WS_RS);
    if constexpr (ph == 0) {
        float2* rope = (float2*)(p.ws + WS_ROPE);
        const int gt = blockIdx.x * NT + tid_opaque(), gs = gridDim.x * NT;
        for (int i = gt; i < T * 64; i += gs) {
            const int m = i >> 6, j = i & 63;
            const float inv = expf(-0.14391156831212787f * (float)j);
            const float ang = (float)p.pos[m] * inv;
            rope[i] = make_float2(cosf(ang), sinf(ang));
        }
        for (int i = gt; i < 4 * 16384; i += gs) {
            const int t = (i >> 7) & 127, s = i & 127, gg = i >> 14;
            ((u16*)(p.ws + WS_WC))[i] = (s <= t) ? f2bf(p.sgu_ws[i]) : (u16)0;
            ((u16*)(p.ws + WS_PWT))[i] = f2bf(p.pool_w[(size_t)gg * 16384 + s * 128 + t]);
        }
        rmsnorm_rows(p.mem, p.gains + (0 * 7 + 6) * DM, MEMN, 2048);
        rmsnorm_rows(p.mem, p.gains + (1 * 7 + 6) * DM, MEMN + (size_t)2048 * DM, 2048);
        cast_rows(p.x, HN, RS);
#pragma unroll 1
        for (int l = 0; l < 2; ++l) {
            weight_prep(p.wkv + (size_t)l * DM * 2048, DM, 2048, 2048, (u16*)(p.ws + WS_WKV) + (size_t)l * 2048 * DM, smem);
            weight_cast(p.wq + (size_t)l * DM * DM, DM, DM, (u16*)(p.ws + WS_WQ) + (size_t)l * DM * DM, p.gains + (size_t)(l * 7 + 2) * DM);
            weight_prep(p.wo + (size_t)l * DM * DM, DM, DM, DM, (u16*)(p.ws + WS_WO) + (size_t)l * DM * DM, smem);
            weight_prep(p.w1 + (size_t)l * DM * DFF, DM, DFF, DFF, (u16*)(p.ws + WS_W1) + (size_t)l * DFF * DM, smem, p.gains + (size_t)(l * 7 + 4) * DM);
            weight_prep<false, true>(p.w2 + (size_t)l * DFF * DM, DFF, DM, DM, (u16*)(p.ws + WS_W2 + (size_t)l * DM * DFF), smem);
        }
        weight_prep(p.ev_w_in, DM, EVEN_IN, EVEN_IN, (u16*)(p.ws + WS_EVIN), smem, p.gains + 0);
        weight_prep(p.ev_w_out, DM, DM, DM, (u16*)(p.ws + WS_EVOUT), smem);
        weight_prep<true>(p.od_w_in, DM, ODD_IN, ZP1, (u16*)(p.ws + WS_ODIN), smem, p.gains + (size_t)7 * DM);
        weight_prep(p.od_w_out, DM, DM, DM, (u16*)(p.ws + WS_ODOUT), smem);
    } else if constexpr (ph == 1) {
        pg8::Gemm gm{MEMN, (const u16*)(p.ws + WS_WKV), 2048, 2048, DM, DM, DM}; KvOrder S{vblock()};
        EpiStore E{KV, 2048, 0, nullptr};
        pg8::gemm_phase<EpiStore, KvOrder, true, true>((PG8_LAS unsigned char*)smem, gm, S, E);
    } else if constexpr (ph == 2) {
        xattn_precompute(p, 0, smem);
    } else {
        constexpr int l = (ph - 3) / 12, s = (ph - 3) % 12;
        const float* g = p.gains + (size_t)l * 7 * DM;
        if constexpr (s == 0) {
            if constexpr (l == 0) { gemm8(HN, (const u16*)(p.ws + WS_EVIN), T, EVEN_IN, DM, Z, ZP0, 0, RS, smem); xattn_precompute(p, 0, smem); }
            else { pg8::Gemm gm{HN, (const u16*)(p.ws + WS_ODIN), T, ZP1, DM, DM, DM}; pg8::StaticOrder S; S.init(T, ZP1, (int)gridDim.x, vblock());
                   EpiRope E{Z, (u16*)(p.ws + WS_KB), (u16*)(p.ws + WS_VB), (u16*)(p.ws + WS_KI), RS, (const float2*)(p.ws + WS_ROPE)};
                   pg8::gemm_phase<EpiRope, pg8::StaticOrder, true, true>((PG8_LAS unsigned char*)smem, gm, S, E); }
        } else if constexpr (s == 1) {
            if constexpr (l == 0) { mixer_a_all(p, smem); mixer_b_all(p, smem); }
            else { }
        } else if constexpr (s == 2) { if constexpr (l == 1) dsa_phase(p, smem); }
        else if constexpr (s == 3) gemm8(MIX, (const u16*)(p.ws + (l == 0 ? WS_EVOUT : WS_ODOUT)), T, DM, DM, Y, DM, 0, nullptr, smem);
        else if constexpr (s == 4) { if constexpr (l == 1) xattn_precompute(p, 1, smem); postnorm_rows<false>(HN, Y, g + 1 * DM, RS, nullptr); }
        else if constexpr (s == 5) {
            pg8::Gemm g{HN, (const u16*)(p.ws + WS_BT1), T, DM, DM, DM, DM}; BatchBOrder S; S.init(T, DM, (int)gridDim.x, vblock());
            EpiSoftmax E{MIX, DM, RS, (PG8_LAS float*)((PG8_LAS unsigned char*)smem + 131072)};
            pg8::gemm_phase<EpiSoftmax, BatchBOrder, true, true>((PG8_LAS unsigned char*)smem, g, S, E); }
        else if constexpr (s == 6) { }
        else if constexpr (s == 7) {
            pg8::Gemm g{MIX, (const u16*)(p.ws + WS_BT2), T, DM, DM, DM, DM}; BatchBOrder S; S.init(T, DM, (int)gridDim.x, vblock());
            EpiStore E{Y, DM, 0, nullptr};
            pg8::gemm_phase<EpiStore, BatchBOrder, true, true>((PG8_LAS unsigned char*)smem, g, S, E); }
        else if constexpr (s == 8) postnorm_rows<false>(HN, Y, g + 3 * DM, RS, nullptr);
        else if constexpr (s == 9) {
            pg8::Gemm gm{HN, (const u16*)(p.ws + WS_W1) + (size_t)l * DFF * DM, T, DFF, DM, DM, DM}; pg8::StaticOrder S; S.init(T, DFF, (int)gridDim.x, vblock());
            EpiStoreF8 E{(unsigned char*)HID, DFF, RS};
            pg8::gemm_phase<EpiStoreF8, pg8::StaticOrder, true, true>((PG8_LAS unsigned char*)smem, gm, S, E); }
        else if constexpr (s == 10) {
            pg8::Gemm gm{HID, (const u16*)(p.ws + WS_W2 + (size_t)l * DM * DFF), T, DM, DFF / 2, DFF / 2, DFF / 2}; pg8::StaticOrder S; S.init(T, DM, (int)gridDim.x, vblock());
            EpiStore E{Y, DM, 0, nullptr, 1.f / 2048.f};
            pg8::gemm_phase<EpiStore, pg8::StaticOrder, true, true, true>((PG8_LAS unsigned char*)smem, gm, S, E); }
        else { if constexpr (l == 0) postnorm_rows<false>(HN, Y, g + 5 * DM, RS, nullptr); else postnorm_rows<true>(HN, Y, g + 5 * DM, nullptr, p.out); }
    }
}

template <int PH> __device__ __forceinline__ void run_all(unsigned char* smem, const XcdBarrier& bar) {
    if constexpr (PH < NPHASE) {
        if constexpr (PH == DUP_PH) { run_phase<PH>(smem); xcd_barrier(bar); }
        if constexpr (PH == 1) { for (int xb = 0; xb < EXTRA_BARRIERS; ++xb) xcd_barrier(bar); }
#ifdef ONLY_PH
        if constexpr (PH == ONLY_PH) {
#else
        if constexpr (PH != 2 && PH != 5 && PH != 9 && PH != 21 && PH != 16) {
#endif
            run_phase<PH>(smem);
            if constexpr (PH + 1 < NPHASE) xcd_barrier(bar, PH != 0);
        }
        run_all<PH + 1>(smem, bar);
    }
}
#endif
constexpr size_t WS_CTL = 0, CTL_ZERO_BYTES = 65536;
__global__ void __launch_bounds__(NT, 2) fwd_kernel(Params p) {
#if defined(__HIP_DEVICE_COMPILE__)
    extern __shared__ __attribute__((aligned(16))) unsigned char smem[];
    volatile __attribute__((address_space(3))) unsigned* st = (volatile __attribute__((address_space(3))) unsigned*)((__attribute__((address_space(3))) unsigned char*)smem + LDS_CTL_OFF);
    if (threadIdx.x < 16) st[threadIdx.x] = 0u;
    __syncthreads();
    const XcdBarrier bar = xcd_barrier_post((unsigned*)(p.ws + WS_CTL), st);
    if (p.ws == nullptr) cg::this_grid().sync();
    run_all<0>(smem, bar);
#endif
}

extern "C" void kernel_launch(void* const* d_in, const int* in_sizes, int n_in, void* d_out, int out_size, void* d_ws, size_t ws_size, hipStream_t stream) {
    static int inited = 0, cus = 256, per_cu = 1;
    if (!inited) {
        inited = 1;
        if (ws_size < WS_END) fprintf(stderr, "kernel_launch: workspace too small: %zu < %zu\n", ws_size, (size_t)WS_END);
        int dev = 0; (void)hipGetDevice(&dev); (void)hipDeviceGetAttribute(&cus, hipDeviceAttributeMultiprocessorCount, dev);
        (void)hipFuncSetAttribute((const void*)fwd_kernel, hipFuncAttributeMaxDynamicSharedMemorySize, LDS_BYTES);
        if (hipOccupancyMaxActiveBlocksPerMultiprocessor(&per_cu, (const void*)fwd_kernel, NT, LDS_BYTES) != hipSuccess || per_cu < 1) per_cu = 1;
        (void)hipGetLastError();
    }
    Params p{};
    p.x = (const float*)d_in[0]; p.mem = (const float*)d_in[1]; p.pos = (const int*)d_in[2]; p.gains = (const float*)d_in[3];
    p.wq = (const float*)d_in[4]; p.wkv = (const float*)d_in[5]; p.wo = (const float*)d_in[6]; p.w1 = (const float*)d_in[7]; p.w2 = (const float*)d_in[8];
    p.ev_w_in = (const float*)d_in[9]; p.sgu_g = (const float*)d_in[10]; p.sgu_ws = (const float*)d_in[11]; p.sgu_bs = (const float*)d_in[12];
    p.pool_w = (const float*)d_in[13]; p.pool_scale = (const float*)d_in[14]; p.ev_w_out = (const float*)d_in[15];
    p.od_w_in = (const float*)d_in[16]; p.od_w_out = (const float*)d_in[17];
    p.out = (float*)d_out; p.ws = (unsigned char*)d_ws;
    (void)hipMemsetAsync((char*)d_ws + WS_CTL, 0, CTL_ZERO_BYTES, stream);
    void* args[] = {&p};
    hipError_t e = hipLaunchCooperativeKernel((const void*)fwd_kernel, dim3(cus * per_cu), dim3(NT), args, LDS_BYTES, stream);
    if (e != hipSuccess) fprintf(stderr, "cooperative launch failed: %s\n", hipGetErrorString(e));
}
```
